# Optimizing an MI355X kernel written in HIP

```python
import jax, jax.numpy as jnp
from jax import lax
import numpy as np

D_MODEL = 1024
BATCH = 8
SEQ = 2048
DEPTH = 2
DEC_BATCH = 128
DEC_SEQ = 1
PAST_LEN = 16384
PAGE_SIZE = 128

N_MIXERS = 4
D_MIX = D_MODEL
D_GROUP = D_MIX // N_MIXERS
D_IN_PROJ = 8 * D_GROUP
GMLP_HEADS = 4
GMLP_HEAD_DIM = D_GROUP // GMLP_HEADS
CHUNK = 128
CONF_WIDTH = 31
SC_WIDTH = 3
POOL_WINDOWS = (2, 4, 8, 16)
POOL_GROUPS = len(POOL_WINDOWS)
POOL_GROUP_DIM = D_GROUP // POOL_GROUPS
POOL_BUF = max(POOL_WINDOWS) - 1
MEM_LEN = 256
XATTN_HEADS = 4
XATTN_HEAD_DIM = D_MODEL // XATTN_HEADS
D_FF = 4 * D_MODEL
EPS = 1e-6

kernel_name = 'hybrid_headgroup_decoder_step'


def rms_norm(x, g):
    xf = x.astype(jnp.float32)
    y = xf * lax.rsqrt(jnp.mean(xf * xf, axis=-1, keepdims=True) + EPS)
    return (y * g.astype(jnp.float32)).astype(x.dtype)


def layer_norm(x, g, b):
    xf = x.astype(jnp.float32)
    xc = xf - jnp.mean(xf, axis=-1, keepdims=True)
    y = xc * lax.rsqrt(jnp.mean(xc * xc, axis=-1, keepdims=True) + EPS)
    return (y * g.astype(jnp.float32) + b.astype(jnp.float32)).astype(x.dtype)


def causal_depthwise_conv(buf, x, w):
    xx = jnp.concatenate([buf.astype(x.dtype), x], axis=1)
    out = lax.conv_general_dilated(xx, w[:, None, :].astype(x.dtype), window_strides=(1,), padding='VALID',
                                   dimension_numbers=('NWC', 'WIO', 'NWC'), feature_group_count=x.shape[-1])
    return out, xx[:, -(w.shape[0] - 1):]


def chunk_spatial_gate(v, ws, bs):
    bsz, t, c = v.shape
    n_chunks = -(-t // CHUNK)
    vp = jnp.pad(v, ((0, 0), (0, n_chunks * CHUNK - t), (0, 0)))
    vp = vp.reshape(bsz, n_chunks, CHUNK, GMLP_HEADS, GMLP_HEAD_DIM)
    mask = jnp.tril(jnp.ones((CHUNK, CHUNK), dtype=bool))
    wsm = jnp.where(mask[None], ws, jnp.zeros_like(ws)).astype(v.dtype)
    z = jnp.einsum('hts,bcshd->bcthd', wsm, vp) + bs.T.astype(v.dtype)[None, None, :, :, None]
    return z.reshape(bsz, n_chunks * CHUNK, c)[:, :t]


def multiscale_pool(buf, x, pos0, w_pool, scale):
    bsz, t, c = x.shape
    xx = jnp.concatenate([buf.astype(x.dtype), x], axis=1)
    cs = jnp.cumsum(xx.astype(jnp.float32), axis=1)
    cs = jnp.concatenate([jnp.zeros((bsz, 1, c), jnp.float32), cs], axis=1)
    ends = cs[:, POOL_BUF + 1:POOL_BUF + 1 + t]
    pos = pos0 + jnp.arange(t, dtype=jnp.int32)
    outs = []
    for g, w in enumerate(POOL_WINDOWS):
        lo, hi = g * POOL_GROUP_DIM, (g + 1) * POOL_GROUP_DIM
        starts = cs[:, POOL_BUF + 1 - w:POOL_BUF + 1 - w + t, lo:hi]
        cnt = jnp.minimum(w, pos + 1).astype(jnp.float32)[None, :, None]
        outs.append((ends[..., lo:hi] - starts) / cnt)
    pooled = (jnp.concatenate(outs, axis=-1) - x.astype(jnp.float32)).astype(x.dtype)
    pooled = pooled.reshape(bsz, t, POOL_GROUPS, POOL_GROUP_DIM)
    y = jnp.einsum('btgc,gcd->btgd', pooled, w_pool).reshape(bsz, t, c) * scale
    return y, xx[:, -POOL_BUF:]


def token_mixers(h, buf_glu, buf_short, buf_pool, pos0, w_in, gmlp_ln_g, gmlp_ln_b, gmlp_ws, gmlp_bs,
                 conf_dw, conf_dw_b, conf_ln_g, conf_ln_b, sc_dw, pool_w, pool_scale, mix_out_g, w_out):
    bsz, t, _ = h.shape
    z = h @ w_in
    u, v, glu_a, glu_g, sc_b, sc_c, sc_x, pool_x = jnp.split(z, 8, axis=-1)
    vn = layer_norm(v, gmlp_ln_g, gmlp_ln_b)
    y_a = u * chunk_spatial_gate(vn, gmlp_ws, gmlp_bs)
    glu = glu_a * jax.nn.sigmoid(glu_g)
    conv_b, new_glu = causal_depthwise_conv(buf_glu, glu, conf_dw)
    y_b = jax.nn.silu(layer_norm(conv_b + conf_dw_b, conf_ln_g, conf_ln_b))
    conv_c, new_short = causal_depthwise_conv(buf_short, sc_c * sc_x, sc_dw)
    y_c = sc_b * conv_c
    y_d, new_pool = multiscale_pool(buf_pool, pool_x, pos0, pool_w, pool_scale)
    y = jnp.stack([y_a, y_b, y_c, y_d], axis=2)
    y = rms_norm(y, mix_out_g.reshape(N_MIXERS, D_GROUP)).reshape(bsz, t, D_MIX)
    return y @ w_out, vn, new_glu, new_short, new_pool


def mem_kv(mem, g_mem, w_k, w_v):
    bsz = mem.shape[0]
    m = rms_norm(mem, g_mem)
    k = (m @ w_k).reshape(bsz, MEM_LEN, XATTN_HEADS, XATTN_HEAD_DIM)
    v = (m @ w_v).reshape(bsz, MEM_LEN, XATTN_HEADS, XATTN_HEAD_DIM)
    return k, v


def cross_attend(h, k, v, w_q, w_o):
    bsz, t, _ = h.shape
    q = (h @ w_q).reshape(bsz, t, XATTN_HEADS, XATTN_HEAD_DIM)
    s = jnp.einsum('bthd,bmhd->bhtm', q, k.astype(h.dtype)).astype(jnp.float32) * (XATTN_HEAD_DIM ** -0.5)
    p = jax.nn.softmax(s, axis=-1).astype(h.dtype)
    o = jnp.einsum('bhtm,bmhd->bthd', p, v.astype(h.dtype)).reshape(bsz, t, XATTN_HEADS * XATTN_HEAD_DIM)
    return o @ w_o


def sq_relu_mlp(h, w1, w2):
    a = jax.nn.relu(h @ w1)
    return (a * a) @ w2


def nrm(k, shape, scale):
    return jax.random.normal(k, shape, jnp.float32) * scale


def gain(k, shape):
    return 1.0 + 0.02 * jax.random.normal(k, shape, jnp.float32)


def setup_inputs(seed: int = 0) -> dict:
    key = jax.random.key(seed)
    ks = jax.random.split(key, 33)
    hd = XATTN_HEADS * XATTN_HEAD_DIM
    return {
        'x_prompt': nrm(ks[0], (BATCH, SEQ, D_MODEL), 1.0),
        'x_sample': nrm(ks[1], (DEC_BATCH, DEC_SEQ, D_MODEL), 1.0),
        'mem_prompt': nrm(ks[2], (BATCH, MEM_LEN, D_MODEL), 1.0),
        'cache_mem_k': nrm(ks[3], (DEPTH, DEC_BATCH, MEM_LEN, XATTN_HEADS, XATTN_HEAD_DIM), 1.0),
        'cache_mem_v': nrm(ks[4], (DEPTH, DEC_BATCH, MEM_LEN, XATTN_HEADS, XATTN_HEAD_DIM), 1.0),
        'state_conv_glu': nrm(ks[5], (DEPTH, DEC_BATCH, CONF_WIDTH - 1, D_GROUP), 0.5),
        'state_conv_short': nrm(ks[6], (DEPTH, DEC_BATCH, SC_WIDTH - 1, D_GROUP), 0.5),
        'state_pool': nrm(ks[7], (DEPTH, DEC_BATCH, POOL_BUF, D_GROUP), 1.0),
        'norm_mix': gain(ks[8], (DEPTH, D_MODEL)),
        'w_in': nrm(ks[9], (DEPTH, D_MODEL, D_IN_PROJ), D_MODEL ** -0.5),
        'gmlp_ln_g': gain(ks[10], (DEPTH, D_GROUP)),
        'gmlp_ln_b': nrm(ks[11], (DEPTH, D_GROUP), 0.02),
        'gmlp_ws': nrm(ks[12], (DEPTH, GMLP_HEADS, CHUNK, CHUNK), 0.5 * CHUNK ** -0.5),
        'gmlp_bs': gain(ks[13], (DEPTH, GMLP_HEADS, CHUNK)),
        'conf_dw': nrm(ks[14], (DEPTH, CONF_WIDTH, D_GROUP), CONF_WIDTH ** -0.5),
        'conf_dw_b': nrm(ks[15], (DEPTH, D_GROUP), 0.02),
        'conf_ln_g': gain(ks[16], (DEPTH, D_GROUP)),
        'conf_ln_b': nrm(ks[17], (DEPTH, D_GROUP), 0.02),
        'sc_dw': nrm(ks[18], (DEPTH, SC_WIDTH, D_GROUP), SC_WIDTH ** -0.5),
        'pool_w': nrm(ks[19], (DEPTH, POOL_GROUPS, POOL_GROUP_DIM, POOL_GROUP_DIM), POOL_GROUP_DIM ** -0.5),
        'pool_scale': gain(ks[20], (DEPTH, D_GROUP)),
        'mix_out_g': gain(ks[21], (DEPTH, D_MIX)),
        'w_out': nrm(ks[22], (DEPTH, D_MIX, D_MODEL), D_MIX ** -0.5),
        'norm_xattn': gain(ks[23], (DEPTH, D_MODEL)),
        'norm_mem': gain(ks[24], (DEPTH, D_MODEL)),
        'w_xq': nrm(ks[25], (DEPTH, D_MODEL, hd), D_MODEL ** -0.5),
        'w_xk': nrm(ks[26], (DEPTH, D_MODEL, hd), D_MODEL ** -0.5),
        'w_xv': nrm(ks[27], (DEPTH, D_MODEL, hd), D_MODEL ** -0.5),
        'w_xo': nrm(ks[28], (DEPTH, hd, D_MODEL), hd ** -0.5),
        'norm_ffn': gain(ks[29], (DEPTH, D_MODEL)),
        'w_ff1': nrm(ks[30], (DEPTH, D_MODEL, D_FF), D_MODEL ** -0.5),
        'w_ff2': nrm(ks[31], (DEPTH, D_FF, D_MODEL), D_FF ** -0.5),
        'norm_final': gain(ks[32], (D_MODEL,)),
    }


def reference(x_prompt, x_sample, mem_prompt, cache_mem_k, cache_mem_v, state_conv_glu, state_conv_short,
              state_pool, norm_mix, w_in, gmlp_ln_g, gmlp_ln_b, gmlp_ws, gmlp_bs, conf_dw, conf_dw_b,
              conf_ln_g, conf_ln_b, sc_dw, pool_w, pool_scale, mix_out_g, w_out, norm_xattn, norm_mem,
              w_xq, w_xk, w_xv, w_xo, norm_ffn, w_ff1, w_ff2, norm_final):
    xp, xs = x_prompt, x_sample
    bp = xp.shape[0]
    mk_p, mv_p, glu_p, glu_s, sh_p, sh_s, pl_p, pl_s, v_s = [], [], [], [], [], [], [], [], []
    for l in range(DEPTH):
        mix_l = (w_in[l], gmlp_ln_g[l], gmlp_ln_b[l], gmlp_ws[l], gmlp_bs[l], conf_dw[l], conf_dw_b[l],
                 conf_ln_g[l], conf_ln_b[l], sc_dw[l], pool_w[l], pool_scale[l], mix_out_g[l], w_out[l])
        zb_glu = jnp.zeros((bp, CONF_WIDTH - 1, D_GROUP), xp.dtype)
        zb_sh = jnp.zeros((bp, SC_WIDTH - 1, D_GROUP), xp.dtype)
        zb_pl = jnp.zeros((bp, POOL_BUF, D_GROUP), xp.dtype)
        m_out, _, ng, nsh, npl = token_mixers(rms_norm(xp, norm_mix[l]), zb_glu, zb_sh, zb_pl, 0, *mix_l)
        xp = xp + m_out
        k_p, v_p = mem_kv(mem_prompt, norm_mem[l], w_xk[l], w_xv[l])
        xp = xp + cross_attend(rms_norm(xp, norm_xattn[l]), k_p, v_p, w_xq[l], w_xo[l])
        xp = xp + sq_relu_mlp(rms_norm(xp, norm_ffn[l]), w_ff1[l], w_ff2[l])
        mk_p.append(k_p); mv_p.append(v_p); glu_p.append(ng); sh_p.append(nsh); pl_p.append(npl)
        m_out, vn_s, ng, nsh, npl = token_mixers(rms_norm(xs, norm_mix[l]), state_conv_glu[l],
                                                 state_conv_short[l], state_pool[l], PAST_LEN, *mix_l)
        xs = xs + m_out
        xs = xs + cross_attend(rms_norm(xs, norm_xattn[l]), cache_mem_k[l], cache_mem_v[l], w_xq[l], w_xo[l])
        xs = xs + sq_relu_mlp(rms_norm(xs, norm_ffn[l]), w_ff1[l], w_ff2[l])
        glu_s.append(ng); sh_s.append(nsh); pl_s.append(npl); v_s.append(vn_s)
    y_prompt = rms_norm(xp, norm_final)
    y_sample = rms_norm(xs, norm_final)
    new_mem_k_prompt = jnp.stack(mk_p, axis=0)
    new_mem_v_prompt = jnp.stack(mv_p, axis=0)
    new_conv_glu_prompt = jnp.stack(glu_p, axis=0)
    new_conv_glu_sample = jnp.stack(glu_s, axis=0)
    new_conv_short_prompt = jnp.stack(sh_p, axis=0)
    new_conv_short_sample = jnp.stack(sh_s, axis=0)
    new_pool_prompt = jnp.stack(pl_p, axis=0)
    new_pool_sample = jnp.stack(pl_s, axis=0)
    new_gmlp_v_sample = jnp.stack(v_s, axis=0)
    return (y_prompt, y_sample, new_mem_k_prompt, new_mem_v_prompt, new_conv_glu_prompt, new_conv_glu_sample,
            new_conv_short_prompt, new_conv_short_sample, new_pool_prompt, new_pool_sample, new_gmlp_v_sample)
```

```cpp
#include <hip/hip_runtime.h>
#include <hip/hip_cooperative_groups.h>
#include <cstdio>
#include <cstdint>
namespace cg = cooperative_groups;
namespace pg8 {
#define PG8_LAS __attribute__((address_space(3)))
typedef unsigned short bf16_t;
typedef short bf16x8 __attribute__((ext_vector_type(8)));
typedef float f32x4 __attribute__((ext_vector_type(4)));
typedef unsigned u32x4 __attribute__((ext_vector_type(4)));
constexpr int BM = 256, BK = 64, HALF = 128, HTB = HALF * BK * 2  , STAGE_BYTES = 8 * HTB, NXCD = 8, WGM = 8;

__host__ __device__ __forceinline__ int lds_byte(int r, int c) { const int st = (r >> 4) * 2 + (c >> 5), rr = r & 15, cc = c & 31, ob = rr * 64 + cc * 2; return st * 1024 + (ob ^ (((ob >> 9) & 1) << 5)); }
__host__ __device__ __forceinline__ void stage_rc(int b, int& R, int& C) { const int st = b / 1024, sb = b % 1024, swz = sb ^ (((sb >> 9) & 1) << 5); R = (st >> 1) * 16 + swz / 64; C = (st & 1) * 32 + (swz % 64) / 2; }
__host__ __device__ __forceinline__ int perm32(int rho) { const int n = rho >> 4, i = rho & 15; return 8 * (i >> 2) + 4 * n + (i & 3); }

struct Unit { int pm, pn; };
struct Gemm { const bf16_t* A; const bf16_t* Bt; int M, N, K; };

struct StaticOrder {
    int nM, nN, nwg, G, c;
    __host__ __device__ void init(int M, int N, int G_, int c_) { nM = M / BM; nN = N / BM; nwg = nM * nN; G = G_; c = c_; }
    __host__ __device__ bool next(int i, Unit& u) const {
        const long L = (long)i * G + c; if (L >= nwg) return false;
        int wgid = (int)L; { const int q = nwg / NXCD, r = nwg % NXCD, xcd = wgid % NXCD, off = wgid / NXCD; wgid = (xcd < r ? xcd * (q + 1) : r * (q + 1) + (xcd - r) * q) + off; }
        const int nig = WGM * nN, gid = wgid / nig, fm = gid * WGM, gsz = (nM - fm) < WGM ? (nM - fm) : WGM;
        u.pm = fm + ((wgid % nig) % gsz); u.pn = (wgid % nig) / gsz; return true;
    }
    __device__ __forceinline__ void a_ready(const Unit&) const {}
    __device__ __forceinline__ void done(const Unit&) const {}
};

__device__ __forceinline__ unsigned cvt_pk_bf16(float lo, float hi) { unsigned r; asm volatile("v_cvt_pk_bf16_f32 %0, %1, %2" : "=v"(r) : "v"(lo), "v"(hi)); return r; }
typedef float f32x2 __attribute__((ext_vector_type(2)));
template <class Epi, class Sched, bool ALIGN_EPI = false, bool SP2 = false>
__device__ __forceinline__ void gemm_phase(PG8_LAS unsigned char* lds, const Gemm g, const Sched& S, const Epi& E) {
    int tid = threadIdx.x; asm volatile("" : "+v"(tid)); const int wid = __builtin_amdgcn_readfirstlane(tid >> 6), lane = tid & 63, wr = wid >> 2, wc = wid & 3, fr = lane & 15, fq = lane >> 4;
    const int K = g.K, nt = K / BK;
    unsigned voffA[2], voffB[2];
#pragma unroll
    for (int i = 0; i < 2; ++i) { int R, C; stage_rc(tid * 16 + i * 8192, R, C); const int Rb = Epi::PERM ? ((R & ~31) + perm32(R & 31)) : R;
        voffA[i] = (unsigned)(R * K + C) * 2u; voffB[i] = (unsigned)(Rb * K + C) * 2u; }
    const size_t kstep = (size_t)(BK * 2);
    const size_t hstep = (size_t)HALF * K * 2;
    const size_t tstep = 2 * hstep;
    const unsigned ldsw = (unsigned)wid * 1024u;
    const int aoff = lds_byte(wr * 64 + fr, fq * 8), boff = lds_byte(wc * 32 + fr, fq * 8);
#define PG8_SA(b, h) (((b) * 2 + (h)) * HTB)
#define PG8_SB(b, h) ((4 + (b) * 2 + (h)) * HTB)
#define PG8_STAGE(bufoff, gbase, voff) do { _Pragma("unroll") for (int _i = 0; _i < 2; ++_i) \
        __builtin_amdgcn_global_load_lds((const unsigned*)((const char*)(gbase) + (voff)[_i]), (PG8_LAS unsigned*)(lds + (bufoff) + ldsw + _i * 8192), 16, 0, 0); } while (0)
#define PG8_LDA(dst, b, h) do { _Pragma("unroll") for (int m = 0; m < 4; ++m) _Pragma("unroll") for (int k = 0; k < 2; ++k) dst[m][k] = *(const PG8_LAS bf16x8*)(lds + PG8_SA(b, h) + aoff + m * 2048 + k * 1024); } while (0)
#define PG8_LDB(dst, b, h) do { _Pragma("unroll") for (int n = 0; n < 2; ++n) _Pragma("unroll") for (int k = 0; k < 2; ++k) dst[n][k] = *(const PG8_LAS bf16x8*)(lds + PG8_SB(b, h) + boff + n * 2048 + k * 1024); } while (0)
#define PG8_MMA(ai, bj, At, Bt) do { __builtin_amdgcn_s_setprio(1); _Pragma("unroll") for (int m = 0; m < 4; ++m) _Pragma("unroll") for (int n = 0; n < 2; ++n) _Pragma("unroll") for (int k = 0; k < 2; ++k) \
        acc[ai][bj][m][n] = __builtin_amdgcn_mfma_f32_16x16x32_bf16(Bt[n][k], At[m][k], acc[ai][bj][m][n], 0, 0, 0); __builtin_amdgcn_s_setprio(0); } while (0)
#define PG8_WAIT_V(n) asm volatile("s_waitcnt vmcnt(" #n ")" ::: "memory")
#define PG8_WAIT_L(n) asm volatile("s_waitcnt lgkmcnt(" #n ")" ::: "memory")
#define PG8_BAR __builtin_amdgcn_s_barrier()
#define PG8_SCHED __builtin_amdgcn_sched_barrier(0)
    Unit cur, nxt; int ui = 0;
    if (!S.next(0, cur)) return;
    f32x4 acc[2][2][4][2];
#pragma unroll
    for (int a = 0; a < 2; ++a)
#pragma unroll
        for (int b = 0; b < 2; ++b)
#pragma unroll
            for (int m = 0; m < 4; ++m)
#pragma unroll
                for (int n = 0; n < 2; ++n) acc[a][b][m][n] = (f32x4){0.f, 0.f, 0.f, 0.f};
    bf16x8 At[4][2], B0[2][2], B1[2][2];
    const char* cA = (const char*)g.A + (size_t)cur.pm * tstep; const char* cB = (const char*)g.Bt + (size_t)cur.pn * tstep;
    S.a_ready(cur);
    if constexpr (SP2) {
        PG8_STAGE(PG8_SB(0, 0), cB, voffB); PG8_STAGE(PG8_SB(0, 1), cB + hstep, voffB); PG8_STAGE(PG8_SA(0, 0), cA, voffA); PG8_STAGE(PG8_SA(0, 1), cA + hstep, voffA);
        if (wr == 1) PG8_BAR;
        PG8_WAIT_V(2); PG8_BAR;
        PG8_STAGE(PG8_SB(1, 0), cB + kstep, voffB); PG8_STAGE(PG8_SA(1, 0), cA + kstep, voffA); PG8_STAGE(PG8_SB(1, 1), cB + hstep + kstep, voffB);
        PG8_WAIT_V(6); PG8_BAR;
    } else {
        PG8_STAGE(PG8_SB(0, 0), cB, voffB); PG8_STAGE(PG8_SA(0, 0), cA, voffA); PG8_STAGE(PG8_SB(0, 1), cB + hstep, voffB); PG8_STAGE(PG8_SA(0, 1), cA + hstep, voffA);
        if (wr == 1) PG8_BAR;
        PG8_WAIT_V(4); PG8_BAR;
        PG8_STAGE(PG8_SB(1, 0), cB + kstep, voffB); PG8_STAGE(PG8_SA(1, 0), cA + kstep, voffA); PG8_STAGE(PG8_SB(1, 1), cB + hstep + kstep, voffB);
        PG8_WAIT_V(6); PG8_BAR;
    }
    for (;;) {
        const bool has_next = S.next(ui + 1, nxt);
        const char* nA = has_next ? (const char*)g.A + (size_t)nxt.pm * tstep : cA; const char* nB = has_next ? (const char*)g.Bt + (size_t)nxt.pn * tstep : cB;
        for (int t = 0; t < nt; t += 2) {
            const bool last = (t == nt - 2);
            const char* a1 = cA + (size_t)(t + 1) * kstep;
            const char* a2 = last ? nA : cA + (size_t)(t + 2) * kstep; const char* b2 = last ? nB : cB + (size_t)(t + 2) * kstep;
            const char* a3 = a2 + kstep; const char* b3 = b2 + kstep;
            if (last && has_next) S.a_ready(nxt);
            if constexpr (SP2) {
            PG8_LDB(B0, 0, 0); PG8_LDB(B1, 0, 1); PG8_SCHED; PG8_LDA(At, 0, 0); PG8_STAGE(PG8_SA(1, 1), a1 + hstep, voffA);
            PG8_WAIT_V(8); PG8_WAIT_L(0); PG8_BAR; PG8_MMA(0, 0, At, B0); PG8_MMA(0, 1, At, B1); PG8_BAR; PG8_SCHED;
            PG8_LDA(At, 0, 1); PG8_STAGE(PG8_SB(0, 0), b2, voffB); PG8_STAGE(PG8_SB(0, 1), b2 + hstep, voffB); PG8_STAGE(PG8_SA(0, 0), a2, voffA);
            PG8_WAIT_V(8); PG8_WAIT_L(0); PG8_BAR; PG8_MMA(1, 0, At, B0); PG8_MMA(1, 1, At, B1); PG8_BAR; PG8_SCHED;
            PG8_LDB(B0, 1, 0); PG8_LDB(B1, 1, 1); PG8_SCHED; PG8_LDA(At, 1, 0); PG8_STAGE(PG8_SA(0, 1), a2 + hstep, voffA);
            PG8_WAIT_V(8); PG8_WAIT_L(0); PG8_BAR; PG8_MMA(0, 0, At, B0); PG8_MMA(0, 1, At, B1); PG8_BAR; PG8_SCHED;
            PG8_LDA(At, 1, 1); PG8_STAGE(PG8_SB(1, 0), b3, voffB); PG8_STAGE(PG8_SB(1, 1), b3 + hstep, voffB); PG8_STAGE(PG8_SA(1, 0), a3, voffA);
            PG8_WAIT_V(8); PG8_WAIT_L(0); PG8_BAR; PG8_MMA(1, 0, At, B0); PG8_MMA(1, 1, At, B1); PG8_BAR; PG8_SCHED;
            } else {
            PG8_LDB(B0, 0, 0); PG8_SCHED; PG8_LDA(At, 0, 0); PG8_STAGE(PG8_SA(1, 1), a1 + hstep, voffA);
            PG8_WAIT_L(8); PG8_BAR; PG8_WAIT_L(0); PG8_MMA(0, 0, At, B0); PG8_BAR; PG8_SCHED;
            PG8_LDB(B1, 0, 1); PG8_STAGE(PG8_SB(0, 0), b2, voffB);
            PG8_BAR; PG8_WAIT_L(0); PG8_MMA(0, 1, At, B1); PG8_BAR;
            PG8_LDA(At, 0, 1); PG8_STAGE(PG8_SA(0, 0), a2, voffA);
            PG8_BAR; PG8_WAIT_L(0); PG8_MMA(1, 0, At, B0); PG8_BAR; PG8_SCHED;
            PG8_STAGE(PG8_SB(0, 1), b2 + hstep, voffB);
            PG8_WAIT_V(6); PG8_BAR; PG8_MMA(1, 1, At, B1); PG8_BAR;
            PG8_LDB(B0, 1, 0); PG8_SCHED; PG8_LDA(At, 1, 0); PG8_STAGE(PG8_SA(0, 1), a2 + hstep, voffA);
            PG8_WAIT_L(8); PG8_BAR; PG8_WAIT_L(0); PG8_MMA(0, 0, At, B0); PG8_BAR; PG8_SCHED;
            PG8_LDB(B1, 1, 1); PG8_STAGE(PG8_SB(1, 0), b3, voffB);
            PG8_BAR; PG8_WAIT_L(0); PG8_MMA(0, 1, At, B1); PG8_BAR;
            PG8_LDA(At, 1, 1); PG8_STAGE(PG8_SA(1, 0), a3, voffA);
            PG8_BAR; PG8_WAIT_L(0); PG8_MMA(1, 0, At, B0); PG8_BAR; PG8_SCHED;
            PG8_STAGE(PG8_SB(1, 1), b3 + hstep, voffB);
            PG8_WAIT_V(6); PG8_BAR; PG8_MMA(1, 1, At, B1); PG8_BAR;
            }
        }
        if constexpr (ALIGN_EPI) { if (wr == 0) PG8_BAR; }
        if constexpr (!Epi::AFTER_DRAIN) { E(acc, cur, wr, wc, fr, fq); S.done(cur); }
        if (!has_next) break;
#pragma unroll
        for (int a = 0; a < 2; ++a)
#pragma unroll
            for (int b = 0; b < 2; ++b)
#pragma unroll
                for (int m = 0; m < 4; ++m)
#pragma unroll
                    for (int n = 0; n < 2; ++n) acc[a][b][m][n] = (f32x4){0.f, 0.f, 0.f, 0.f};
        cur = nxt; cA = nA; cB = nB; ++ui;
        if constexpr (ALIGN_EPI) { if (wr == 1) PG8_BAR; }
    }
    PG8_WAIT_V(0);
    if constexpr (!ALIGN_EPI) { if (wr == 0) PG8_BAR; }
    PG8_BAR;
    if constexpr (Epi::AFTER_DRAIN) { E.fused(acc, cur, wr, wc, fr, fq, lds, wid, lane); S.done(cur); }
#undef PG8_SA
#undef PG8_SB
#undef PG8_STAGE
#undef PG8_LDA
#undef PG8_LDB
#undef PG8_MMA
#undef PG8_WAIT_V
#undef PG8_WAIT_L
#undef PG8_BAR
#undef PG8_SCHED
}
}

#define DI __device__ __forceinline__
#define LAS __attribute__((address_space(3)))
typedef unsigned short bf16_t;
typedef short bf16x8 __attribute__((ext_vector_type(8)));
typedef float f32x4 __attribute__((ext_vector_type(4)));
typedef float f32x16 __attribute__((ext_vector_type(16)));
typedef unsigned u32x4 __attribute__((ext_vector_type(4)));
typedef unsigned u32x2 __attribute__((ext_vector_type(2)));
typedef float f32x2_t __attribute__((ext_vector_type(2)));
typedef __bf16 bf16x2_t __attribute__((ext_vector_type(2)));

constexpr int DM = 1024, NB = 8, SEQ = 2048, MP = NB * SEQ, NL = 2, NS = 128, MEM = 256, MM = NB * MEM, DG = 256, DIN = 2048, DFF = 4096;
constexpr float EPS = 1e-6f;
constexpr int NWAVES = 8, NTHR = 512;
constexpr int LDS_BYTES = 147456;

constexpr size_t MiB = 1u << 20;
constexpr size_t WS_W = 2 * MiB, W_LSTRIDE = 28 * MiB;
constexpr size_t W_IN = 0, W_OUT = 4 * MiB, W_Q = 6 * MiB, W_O = 8 * MiB, W_F1 = 10 * MiB, W_F2 = 18 * MiB, W_GWS = 26 * MiB, W_PWT = 26 * MiB + 512 * 1024;
constexpr size_t WS_WKV = 58 * MiB;
constexpr size_t WS_MEMB = 66 * MiB;
constexpr size_t WS_MEMSS = 70 * MiB;
constexpr size_t WS_SS = 71 * MiB;
constexpr size_t WS_XB = 72 * MiB;
constexpr size_t WS_Z = 104 * MiB;
constexpr size_t WS_Y = 168 * MiB;
constexpr size_t WS_Q = 200 * MiB;
constexpr size_t WS_O = 232 * MiB;
constexpr size_t WS_H = 264 * MiB;
constexpr size_t WS_KP = 392 * MiB;
constexpr size_t WS_VT = 400 * MiB;
constexpr size_t WS_XS = 408 * MiB, WS_ZS = 409 * MiB, WS_YS = 410 * MiB, WS_QS = 411 * MiB, WS_OS = 412 * MiB, WS_HS = 413 * MiB, WS_END = 415 * MiB;

constexpr size_t O_YP = 0, O_YS = O_YP + (size_t)MP * DM, O_MK = O_YS + (size_t)NS * DM, O_MV = O_MK + (size_t)NL * MM * DM, O_GLUP = O_MV + (size_t)NL * MM * DM,
                 O_GLUS = O_GLUP + (size_t)NL * NB * 30 * DG, O_SHP = O_GLUS + (size_t)NL * NS * 30 * DG, O_SHS = O_SHP + (size_t)NL * NB * 2 * DG,
                 O_PLP = O_SHS + (size_t)NL * NS * 2 * DG, O_PLS = O_PLP + (size_t)NL * NB * 15 * DG, O_GV = O_PLS + (size_t)NL * NS * 15 * DG, O_END = O_GV + (size_t)NL * NS * DG;

enum { I_XP = 0, I_XS, I_MEM, I_CK, I_CV, I_SGLU, I_SSH, I_SPL, I_NMIX, I_WIN, I_LNG, I_LNB, I_GWS, I_GBS, I_CDW, I_CDWB, I_CLNG, I_CLNB, I_SCDW, I_PW, I_PSC, I_MOG, I_WOUT,
       I_NXA, I_NMEM, I_WQ, I_WK, I_WV, I_WO, I_NFF, I_WF1, I_WF2, I_NFIN, N_IN };

DI unsigned pk2(float lo, float hi) { f32x2_t v = {lo, hi}; bf16x2_t b = __builtin_convertvector(v, bf16x2_t); return __builtin_bit_cast(unsigned, b); }
DI float bf2f(unsigned short u) { return __uint_as_float((unsigned)u << 16); }
DI float bflo(unsigned u) { return __uint_as_float(u << 16); }
DI float bfhi(unsigned u) { return __uint_as_float(u & 0xffff0000u); }
DI f32x4 ld_bf4(const bf16_t* p) { const u32x2 w = *(const u32x2*)p; return (f32x4){bflo(w.x), bfhi(w.x), bflo(w.y), bfhi(w.y)}; }
DI void st_bf4(bf16_t* p, f32x4 v) { u32x2 w; w.x = pk2(v.x, v.y); w.y = pk2(v.z, v.w); *(u32x2*)p = w; }
DI float wave_sum(float v) {
#pragma unroll
    for (int o = 1; o < 64; o <<= 1) v += __shfl_xor(v, o);
    return v;
}
DI float hsum4(f32x4 v) { return (v.x + v.y) + (v.z + v.w); }
DI float hsq4(f32x4 v) { return (v.x * v.x + v.y * v.y) + (v.z * v.z + v.w * v.w); }
DI float sigmoidf_(float x) { return 1.0f / (1.0f + __expf(-x)); }
DI float row_rs(const float* ss16) {
    const f32x4* sp = (const f32x4*)ss16; const f32x4 a = sp[0], b = sp[1], c = sp[2], d = sp[3];
    const float s = (hsum4(a) + hsum4(b)) + (hsum4(c) + hsum4(d));
    return rsqrtf(s * (1.0f / DM) + EPS);
}

template <int MODE  > struct EpiScale {
    static constexpr bool PERM = true, AFTER_DRAIN = false;
    bf16_t* O; int ldc; const float* ss;
    DI void operator()(const f32x4 (&acc)[2][2][4][2], const pg8::Unit& u, int wr, int wc, int fr, int fq) const {
        const int row0 = u.pm * 256 + wr * 64 + fr, col0 = u.pn * 256 + wc * 32 + 8 * fq;
#pragma unroll
        for (int ai = 0; ai < 2; ++ai)
#pragma unroll
            for (int m = 0; m < 4; ++m) {
                const int row = row0 + ai * 128 + m * 16;
                float rs = row_rs(ss + (size_t)row * 16); if (MODE == 1) rs *= 0.0625f;
                bf16_t* rowp = O + (size_t)row * ldc + col0;
#pragma unroll
                for (int bj = 0; bj < 2; ++bj) {
                    f32x4 v0 = acc[ai][bj][m][0] * rs, v1 = acc[ai][bj][m][1] * rs;
                    if (MODE == 2) {
#pragma unroll
                        for (int j = 0; j < 4; ++j) { float a = fmaxf(v0[j], 0.f), b = fmaxf(v1[j], 0.f); v0[j] = a * a; v1[j] = b * b; }
                    }
                    u32x4 w; w.x = pk2(v0[0], v0[1]); w.y = pk2(v0[2], v0[3]); w.z = pk2(v1[0], v1[1]); w.w = pk2(v1[2], v1[3]);
                    *(u32x4*)(rowp + bj * 128) = w;
                }
            }
    }
};
struct EpiKV {
    static constexpr bool PERM = true, AFTER_DRAIN = false;
    const float* mss; float* outK; float* outV; bf16_t* KP; bf16_t* VT;
    DI void operator()(const f32x4 (&acc)[2][2][4][2], const pg8::Unit& u, int wr, int wc, int fr, int fq) const {
        const int l = u.pn >> 3, w8 = u.pn & 7, isV = w8 >> 2, h = w8 & 3, b = u.pm;
        const int row0 = u.pm * 256 + wr * 64 + fr, colh0 = h * 256 + wc * 32 + 8 * fq;
        float* outp = (isV ? outV : outK) + (size_t)l * MM * DM;
#pragma unroll
        for (int ai = 0; ai < 2; ++ai)
#pragma unroll
            for (int m = 0; m < 4; ++m) {
                const int row = row0 + ai * 128 + m * 16;
                const float rs = rsqrtf(mss[row] * (1.0f / DM) + EPS);
#pragma unroll
                for (int bj = 0; bj < 2; ++bj) {
                    const int colh = colh0 + bj * 128;
                    const f32x4 v0 = acc[ai][bj][m][0] * rs, v1 = acc[ai][bj][m][1] * rs;
                    *(f32x4*)(outp + (size_t)row * DM + colh) = v0; *(f32x4*)(outp + (size_t)row * DM + colh + 4) = v1;
                    if (!isV) {
                        u32x4 w; w.x = pk2(v0[0], v0[1]); w.y = pk2(v0[2], v0[3]); w.z = pk2(v1[0], v1[1]); w.w = pk2(v1[2], v1[3]);
                        *(u32x4*)(KP + ((size_t)l * MM + row) * DM + colh) = w;
                    } else {
                        bf16_t* vt = VT + ((size_t)((l * NB + b) * 4 + h) * 256 + (colh & 255)) * 256 + (row & 255);
#pragma unroll
                        for (int j = 0; j < 4; ++j) { vt[(size_t)j * 256] = (bf16_t)(pk2(v0[j], 0.f) & 0xffffu); vt[(size_t)(j + 4) * 256] = (bf16_t)(pk2(v1[j], 0.f) & 0xffffu); }
                    }
                }
            }
    }
};
struct EpiRes {
    static constexpr bool PERM = false, AFTER_DRAIN = false;
    const float* xold; float* xnew; bf16_t* xb; float* ss;
    DI void operator()(const f32x4 (&acc)[2][2][4][2], const pg8::Unit& u, int wr, int wc, int fr, int fq) const {
        const int row0 = u.pm * 256 + wr * 64 + fr, col0 = u.pn * 256 + wc * 32 + 4 * fq;
#pragma unroll
        for (int ai = 0; ai < 2; ++ai)
#pragma unroll
            for (int m = 0; m < 4; ++m) {
                const int row = row0 + ai * 128 + m * 16; const size_t off = (size_t)row * DM + col0;
                float sq = 0.f;
#pragma unroll
                for (int bj = 0; bj < 2; ++bj)
#pragma unroll
                    for (int n = 0; n < 2; ++n) {
                        const f32x4 o = *(const f32x4*)(xold + off + bj * 128 + n * 16) + acc[ai][bj][m][n];
                        *(f32x4*)(xnew + off + bj * 128 + n * 16) = o; st_bf4(xb + off + bj * 128 + n * 16, o); sq += hsq4(o);
                    }
                sq += __shfl_xor(sq, 16); sq += __shfl_xor(sq, 32);
                if (fq == 0) ss[(size_t)row * 16 + u.pn * 4 + wc] = sq;
                asm volatile("" ::: "memory");
            }
    }
};

template <int MODE> DI void sgemm_slice(const float* A, int K, const bf16_t* Bt, int n0, float* Out, int ldo, int wave, int lane) {
    const int r = lane & 15, q = lane >> 4;
    const float* ap = A + (size_t)(16 * wave + r) * K + 16 * q;
    const bf16_t* bp = Bt + (size_t)(n0 + r) * K + 16 * q;
    f32x4 acc = {0.f, 0.f, 0.f, 0.f}; float ssq = 0.f;
#pragma unroll 4
    for (int k0 = 0; k0 < K; k0 += 64) {
        const f32x4 a0 = *(const f32x4*)(ap + k0), a1 = *(const f32x4*)(ap + k0 + 4), a2 = *(const f32x4*)(ap + k0 + 8), a3 = *(const f32x4*)(ap + k0 + 12);
        const bf16x8 b0 = *(const bf16x8*)(bp + k0), b1 = *(const bf16x8*)(bp + k0 + 8);
        if (MODE != 3) ssq += (hsq4(a0) + hsq4(a1)) + (hsq4(a2) + hsq4(a3));
        u32x4 p0, p1; p0.x = pk2(a0.x, a0.y); p0.y = pk2(a0.z, a0.w); p0.z = pk2(a1.x, a1.y); p0.w = pk2(a1.z, a1.w);
        p1.x = pk2(a2.x, a2.y); p1.y = pk2(a2.z, a2.w); p1.z = pk2(a3.x, a3.y); p1.w = pk2(a3.z, a3.w);
        acc = __builtin_amdgcn_mfma_f32_16x16x32_bf16(__builtin_bit_cast(bf16x8, p0), b0, acc, 0, 0, 0);
        acc = __builtin_amdgcn_mfma_f32_16x16x32_bf16(__builtin_bit_cast(bf16x8, p1), b1, acc, 0, 0, 0);
    }
    float rs = 1.f;
    if (MODE != 3) { ssq += __shfl_xor(ssq, 16); ssq += __shfl_xor(ssq, 32); rs = rsqrtf(ssq / (float)K + EPS); if (MODE == 1) rs *= 0.0625f; }
#pragma unroll
    for (int j = 0; j < 4; ++j) {
        const int row = 16 * wave + 4 * q + j; float* o = Out + (size_t)row * ldo + n0 + r;
        if (MODE == 3) { *o = *o + acc[j]; }
        else { const float rj = __shfl(rs, 4 * q + j); float v = acc[j] * rj; if (MODE == 2) { v = fmaxf(v, 0.f); v = v * v; } *o = v; }
    }
}
template <int MODE> DI void sgemm_phase(const float* A, int K, const bf16_t* Bt, int N, float* Out, int ldo, int wave, int lane) {
    const int nsl = N / 16;
    for (int s = blockIdx.x; s < nsl; s += gridDim.x) sgemm_slice<MODE>(A, K, Bt, s * 16, Out, ldo, wave, lane);
}

DI void p0_transpose_item(const float* W, const float* g, int K, int N, bf16_t* WT, int row_off, LAS float* scr, int item, int lane) {
    const int nblk = N / 32, kb = item / nblk, nb = item % nblk, k0 = 64 * kb, n0 = 32 * nb;
#pragma unroll 8
    for (int i = 0; i < 32; ++i) { const int kk = 2 * i + (lane >> 5); const float gv = g ? g[k0 + kk] : 1.f; scr[kk * 33 + (lane & 31)] = W[(size_t)(k0 + kk) * N + n0 + (lane & 31)] * gv; }
    asm volatile("s_waitcnt lgkmcnt(0)" ::: "memory");
    const int c = lane & 7;
#pragma unroll
    for (int j = 0; j < 4; ++j) { const int n = (lane >> 3) + 8 * j; const LAS float* s = scr + (8 * c) * 33 + n;
        u32x4 o; o.x = pk2(s[0 * 33], s[1 * 33]); o.y = pk2(s[2 * 33], s[3 * 33]); o.z = pk2(s[4 * 33], s[5 * 33]); o.w = pk2(s[6 * 33], s[7 * 33]);
        *(u32x4*)(WT + (size_t)(row_off + n0 + n) * K + k0 + 8 * c) = o; }
    asm volatile("s_waitcnt lgkmcnt(0)" ::: "memory");
}
DI float row_to_bf16(const float* xrow, bf16_t* orow, int lane) {
    const f32x4* xr = (const f32x4*)xrow + lane; float s = 0.f;
#pragma unroll
    for (int j = 0; j < 4; ++j) { const f32x4 v = xr[64 * j]; s += hsq4(v); st_bf4(orow + 4 * lane + 256 * j, v); }
    return wave_sum(s);
}

struct Args { const float* in[N_IN]; float* out; unsigned char* ws; int ph_lo, ph_hi; };
typedef const __attribute__((address_space(4))) Args* AP;

DI void prologue(AP a, LAS unsigned char* lds, int wave, int lane) {
    unsigned char* ws = a->ws;
    LAS float* scr = (LAS float*)(lds + wave * 16384);
    const int gw = blockIdx.x * NWAVES + wave, NGW = gridDim.x * NWAVES;
    constexpr int IT_IN = 16 * 64, IT_SQ = 16 * 32, IT_F1 = 16 * 128, IT_F2 = 64 * 32, IT_L = IT_IN + 5 * IT_SQ + IT_F1 + IT_F2;
    for (int it = gw; it < NL * IT_L; it += NGW) {
        const int l = it / IT_L; int r = it % IT_L;
        unsigned char* wl = ws + WS_W + (size_t)l * W_LSTRIDE;
        if (r < IT_IN) { p0_transpose_item(a->in[I_WIN] + (size_t)l * DM * DIN, a->in[I_NMIX] + l * DM, DM, DIN, (bf16_t*)(wl + W_IN), 0, scr, r, lane); continue; } r -= IT_IN;
        if (r < IT_SQ) { p0_transpose_item(a->in[I_WOUT] + (size_t)l * DM * DM, nullptr, DM, DM, (bf16_t*)(wl + W_OUT), 0, scr, r, lane); continue; } r -= IT_SQ;
        if (r < IT_SQ) { p0_transpose_item(a->in[I_WQ] + (size_t)l * DM * DM, a->in[I_NXA] + l * DM, DM, DM, (bf16_t*)(wl + W_Q), 0, scr, r, lane); continue; } r -= IT_SQ;
        if (r < IT_SQ) { p0_transpose_item(a->in[I_WK] + (size_t)l * DM * DM, a->in[I_NMEM] + l * DM, DM, DM, (bf16_t*)(ws + WS_WKV), l * 2048, scr, r, lane); continue; } r -= IT_SQ;
        if (r < IT_SQ) { p0_transpose_item(a->in[I_WV] + (size_t)l * DM * DM, a->in[I_NMEM] + l * DM, DM, DM, (bf16_t*)(ws + WS_WKV), l * 2048 + 1024, scr, r, lane); continue; } r -= IT_SQ;
        if (r < IT_SQ) { p0_transpose_item(a->in[I_WO] + (size_t)l * DM * DM, nullptr, DM, DM, (bf16_t*)(wl + W_O), 0, scr, r, lane); continue; } r -= IT_SQ;
        if (r < IT_F1) { p0_transpose_item(a->in[I_WF1] + (size_t)l * DM * DFF, a->in[I_NFF] + l * DM, DM, DFF, (bf16_t*)(wl + W_F1), 0, scr, r, lane); continue; } r -= IT_F1;
        p0_transpose_item(a->in[I_WF2] + (size_t)l * DFF * DM, nullptr, DFF, DM, (bf16_t*)(wl + W_F2), 0, scr, r, lane);
    }
    {
        bf16_t* XB = (bf16_t*)(ws + WS_XB); float* SS = (float*)(ws + WS_SS);
        for (int m = gw; m < MP; m += NGW) { const float s = row_to_bf16(a->in[I_XP] + (size_t)m * DM, XB + (size_t)m * DM, lane); if (lane < 16) SS[(size_t)m * 16 + lane] = lane == 0 ? s : 0.f; }
        bf16_t* MB = (bf16_t*)(ws + WS_MEMB); float* MS = (float*)(ws + WS_MEMSS);
        for (int m = gw; m < MM; m += NGW) { const float s = row_to_bf16(a->in[I_MEM] + (size_t)m * DM, MB + (size_t)m * DM, lane); if (lane == 0) MS[m] = s; }
    }
    {
        const int gt = blockIdx.x * NTHR + wave * 64 + lane, NGT = gridDim.x * NTHR;
        for (int i = gt; i < NL * 4 * 128 * 128; i += NGT) { const int l = i >> 16, r = i & 65535, t = (r >> 7) & 127, s = r & 127;
            ((bf16_t*)(ws + WS_W + (size_t)l * W_LSTRIDE + W_GWS))[r] = (bf16_t)(pk2(s <= t ? a->in[I_GWS][i] : 0.f, 0.f) & 0xffffu); }
        for (int i = gt; i < NL * 4 * 64 * 64; i += NGT) { const int l = i >> 14, r = i & 16383, g = r >> 12, d = (r >> 6) & 63, c = r & 63;
            ((bf16_t*)(ws + WS_W + (size_t)l * W_LSTRIDE + W_PWT))[r] = (bf16_t)(pk2(a->in[I_PW][(size_t)l * 16384 + g * 4096 + c * 64 + d], 0.f) & 0xffffu); }
        for (int i = gt; i < NS * DM / 4; i += NGT) ((f32x4*)(ws + WS_XS))[i] = ((const f32x4*)a->in[I_XS])[i];
    }
}

#ifndef MIXP
#define MIXP 15
#endif
constexpr int VNT_P = 136;
constexpr int TT_OFF = 69632, TT_P = 260;
constexpr int CW_OFF = 96256;
constexpr int PL_P = 264;

DI void tt_rows_out(LAS unsigned char* lds, bf16_t* Yrow0, const float* mog, int wave, int lane) {
    const LAS float* TT = (const LAS float*)(lds + TT_OFF);
    const f32x4 g = *(const f32x4*)(mog + 4 * lane);
#pragma unroll
    for (int i = 0; i < 8; ++i) {
        const int tt = 8 * wave + i;
        const f32x4 v = *(const LAS f32x4*)(TT + tt * TT_P + 4 * lane);
        const float r = rsqrtf(wave_sum(hsq4(v)) * (1.0f / DG) + EPS);
        st_bf4(Yrow0 + (size_t)tt * DM + 4 * lane, v * r * g);
    }
}

DI void mixer_unit(AP a, int l, int uidx, LAS unsigned char* lds, int wave, int lane) {
    unsigned char* ws = a->ws;
    const int b = uidx >> 5, ju = uidx & 31, t0 = ju * 64, off = t0 & 127, tc = t0 - off;
    const size_t R0 = (size_t)b * SEQ + t0;
    const bf16_t* Z = (const bf16_t*)(ws + WS_Z);
    bf16_t* Y = (bf16_t*)(ws + WS_Y);
    const float* mog = a->in[I_MOG] + l * DM;
    if (MIXP & 1) {
        int lq_ = lane; asm volatile("" : "+v"(lq_)); const int lane = lq_; const int fr = lane & 15, fq = lane >> 4; (void)fr; (void)fq;
        LAS bf16_t* VNT = (LAS bf16_t*)lds;
        const f32x4 lg = *(const f32x4*)(a->in[I_LNG] + l * DG + 4 * lane), lb = *(const f32x4*)(a->in[I_LNB] + l * DG + 4 * lane);
        const int nrow = off + 64;
        for (int s = wave; s < nrow; s += NWAVES) {
            const f32x4 v = ld_bf4(Z + ((size_t)b * SEQ + tc + s) * DIN + 256 + 4 * lane);
            const float mean = wave_sum(hsum4(v)) * (1.0f / DG); const f32x4 d = v - mean;
            const float rstd = rsqrtf(wave_sum(hsq4(d)) * (1.0f / DG) + EPS);
            const f32x4 vn = d * rstd * lg + lb;
#pragma unroll
            for (int i = 0; i < 4; ++i) VNT[(4 * lane + i) * VNT_P + s] = (bf16_t)(pk2(vn[i], 0.f) & 0xffffu);
        }
        __syncthreads();
        const int mt = wave & 3, hp = wave >> 2, tl0 = off + 16 * mt, nks = (tl0 + 16 + 31) >> 5;
        const bf16_t* GW = (const bf16_t*)(ws + WS_W + (size_t)l * W_LSTRIDE + W_GWS);
        LAS float* TT = (LAS float*)(lds + TT_OFF);
#pragma unroll
        for (int hh = 0; hh < 2; ++hh) {
            const int h = 2 * hp + hh;
            f32x4 acc[4];
#pragma unroll
            for (int dt = 0; dt < 4; ++dt) acc[dt] = (f32x4){0.f, 0.f, 0.f, 0.f};
            for (int ks = 0; ks < nks; ++ks) {
                const bf16x8 af = *(const bf16x8*)(GW + ((size_t)h * 128 + tl0 + fr) * 128 + 32 * ks + 8 * fq);
#pragma unroll
                for (int dt = 0; dt < 4; ++dt) {
                    const bf16x8 bfr = *(const LAS bf16x8*)(VNT + (h * 64 + dt * 16 + fr) * VNT_P + 32 * ks + 8 * fq);
                    acc[dt] = __builtin_amdgcn_mfma_f32_16x16x32_bf16(af, bfr, acc[dt], 0, 0, 0);
                }
            }
#pragma unroll
            for (int dt = 0; dt < 4; ++dt)
#pragma unroll
                for (int j = 0; j < 4; ++j) {
                    const int tl = 16 * mt + 4 * fq + j, d = h * 64 + dt * 16 + fr;
                    const float bs = a->in[I_GBS][(l * 4 + h) * 128 + off + tl];
                    const float uu = bf2f(Z[(R0 + tl) * DIN + d]);
                    TT[tl * TT_P + d] = uu * (acc[dt][j] + bs);
                }
        }
        __syncthreads();
        tt_rows_out(lds, Y + R0 * DM + 0 * DG, mog + 0 * DG, wave, lane);
        __syncthreads();
    }
    if (MIXP & 2) {
        int lq_ = lane; asm volatile("" : "+v"(lq_)); const int lane = lq_; const int fr = lane & 15, fq = lane >> 4; (void)fr; (void)fq;
        LAS float* G = (LAS float*)lds; LAS float* CW = (LAS float*)(lds + CW_OFF);
        for (int rr = wave; rr < 94; rr += NWAVES) {
            const int t = t0 - 30 + rr; f32x4 gl = {0.f, 0.f, 0.f, 0.f};
            if (t >= 0) { const bf16_t* zr = Z + ((size_t)b * SEQ + t) * DIN; const f32x4 ga = ld_bf4(zr + 512 + 4 * lane), gg = ld_bf4(zr + 768 + 4 * lane);
#pragma unroll
                for (int i = 0; i < 4; ++i) gl[i] = ga[i] * sigmoidf_(gg[i]); }
            *(LAS f32x4*)(G + rr * 256 + 4 * lane) = gl;
            if (ju == 31 && rr >= 64) *(f32x4*)(a->out + O_GLUP + ((size_t)(l * NB + b) * 30 + (rr - 64)) * DG + 4 * lane) = gl;
        }
        for (int i = wave * 64 + lane; i < 31 * 64; i += NTHR) ((LAS f32x4*)CW)[i] = ((const f32x4*)(a->in[I_CDW] + (size_t)l * 31 * DG))[i];
        __syncthreads();
        f32x4 acc[8];
#pragma unroll
        for (int i = 0; i < 8; ++i) acc[i] = (f32x4){0.f, 0.f, 0.f, 0.f};
        f32x4 wj[8];
#pragma unroll
        for (int i = 0; i < 38; ++i) {
            const f32x4 g = *(const LAS f32x4*)(G + (8 * wave + i) * 256 + 4 * lane);
            if (i <= 30) wj[i & 7] = *(const LAS f32x4*)(CW + i * 256 + 4 * lane);
#pragma unroll
            for (int tt = 0; tt < 8; ++tt) { const int j = i - tt; if (j >= 0 && j <= 30) acc[tt] += wj[j & 7] * g; }
            if (i & 1) asm volatile("" ::: "memory");
        }
        const f32x4 cb = *(const f32x4*)(a->in[I_CDWB] + l * DG + 4 * lane), lg = *(const f32x4*)(a->in[I_CLNG] + l * DG + 4 * lane), lb = *(const f32x4*)(a->in[I_CLNB] + l * DG + 4 * lane);
        const f32x4 mg = *(const f32x4*)(mog + 1 * DG + 4 * lane);
#pragma unroll
        for (int tt = 0; tt < 8; ++tt) {
            const f32x4 x = acc[tt] + cb;
            const float mean = wave_sum(hsum4(x)) * (1.0f / DG); const f32x4 d = x - mean;
            const float rstd = rsqrtf(wave_sum(hsq4(d)) * (1.0f / DG) + EPS);
            f32x4 y = d * rstd * lg + lb;
#pragma unroll
            for (int i = 0; i < 4; ++i) y[i] = y[i] * sigmoidf_(y[i]);
            const float r = rsqrtf(wave_sum(hsq4(y)) * (1.0f / DG) + EPS);
            st_bf4(Y + (R0 + 8 * wave + tt) * DM + 1 * DG + 4 * lane, y * r * mg);
        }
        __syncthreads();
    }
    asm volatile("" ::: "memory");
    if (MIXP & 4) {
        int lq_ = lane; asm volatile("" : "+v"(lq_)); const int lane = lq_; const int fr = lane & 15, fq = lane >> 4; (void)fr; (void)fq;
        const float* sw = a->in[I_SCDW] + (size_t)l * 3 * DG;
        const f32x4 w0 = *(const f32x4*)(sw + 4 * lane), w1 = *(const f32x4*)(sw + DG + 4 * lane), w2 = *(const f32x4*)(sw + 2 * DG + 4 * lane);
        const f32x4 mg = *(const f32x4*)(mog + 2 * DG + 4 * lane);
        f32x4 s[10];
#pragma unroll
        for (int i = 0; i < 10; ++i) {
            const int t = t0 + 8 * wave - 2 + i; s[i] = (f32x4){0.f, 0.f, 0.f, 0.f};
            if (t >= 0) { const bf16_t* zr = Z + ((size_t)b * SEQ + t) * DIN; s[i] = ld_bf4(zr + 1280 + 4 * lane) * ld_bf4(zr + 1536 + 4 * lane); }
        }
#pragma unroll
        for (int tt = 0; tt < 8; ++tt) {
            const int tl = 8 * wave + tt;
            const f32x4 sb = ld_bf4(Z + (R0 + tl) * DIN + 1024 + 4 * lane);
            const f32x4 y = sb * (w0 * s[tt] + w1 * s[tt + 1] + w2 * s[tt + 2]);
            const float r = rsqrtf(wave_sum(hsq4(y)) * (1.0f / DG) + EPS);
            st_bf4(Y + (R0 + tl) * DM + 2 * DG + 4 * lane, y * r * mg);
            if (ju == 31 && tl >= 62) *(f32x4*)(a->out + O_SHP + ((size_t)(l * NB + b) * 2 + (tl - 62)) * DG + 4 * lane) = s[tt + 2];
        }
    }
    asm volatile("s_waitcnt vmcnt(0)" ::: "memory");
    if (MIXP & 8) {
        int lq_ = lane; asm volatile("" : "+v"(lq_)); const int lane = lq_; const int fr = lane & 15, fq = lane >> 4; (void)fr; (void)fq;
        LAS bf16_t* PL = (LAS bf16_t*)lds; LAS float* TT = (LAS float*)(lds + TT_OFF);
        const int g = lane >> 4, w = 2 << g;
        f32x4 px[23];
#pragma unroll
        for (int i = 0; i < 23; ++i) {
            const int t = t0 + 8 * wave - 15 + i; px[i] = (f32x4){0.f, 0.f, 0.f, 0.f};
            if (t >= 0) px[i] = ld_bf4(Z + ((size_t)b * SEQ + t) * DIN + 1792 + 4 * lane);
        }
#pragma unroll
        for (int tt = 0; tt < 8; ++tt) {
            const int tl = 8 * wave + tt, t = t0 + tl;
            f32x4 sum = {0.f, 0.f, 0.f, 0.f};
#pragma unroll
            for (int i = 0; i < 16; ++i) if (i < w) sum += px[15 + tt - i];
            const float cnt = (float)min(w, t + 1);
            const f32x4 pooled = sum / cnt - px[15 + tt];
            u32x2 pw; pw.x = pk2(pooled.x, pooled.y); pw.y = pk2(pooled.z, pooled.w);
            *(LAS u32x2*)(PL + tl * PL_P + 4 * lane) = pw;
            if (ju == 31 && tl >= 49) *(f32x4*)(a->out + O_PLP + ((size_t)(l * NB + b) * 15 + (tl - 49)) * DG + 4 * lane) = px[15 + tt];
        }
        __syncthreads();
        const int mt = wave & 3, gp = wave >> 2;
        const bf16_t* PWT = (const bf16_t*)(ws + WS_W + (size_t)l * W_LSTRIDE + W_PWT);
#pragma unroll
        for (int gg = 0; gg < 2; ++gg) {
            const int gi = 2 * gp + gg;
#pragma unroll
            for (int nt = 0; nt < 4; ++nt) {
                f32x4 acc = {0.f, 0.f, 0.f, 0.f};
#pragma unroll
                for (int ks = 0; ks < 2; ++ks) {
                    const bf16x8 af = *(const LAS bf16x8*)(PL + (16 * mt + fr) * PL_P + gi * 64 + 32 * ks + 8 * fq);
                    const bf16x8 bfr = *(const bf16x8*)(PWT + ((size_t)gi * 64 + 16 * nt + fr) * 64 + 32 * ks + 8 * fq);
                    acc = __builtin_amdgcn_mfma_f32_16x16x32_bf16(af, bfr, acc, 0, 0, 0);
                }
                const int d = gi * 64 + 16 * nt + fr; const float sc = a->in[I_PSC][l * DG + d];
#pragma unroll
                for (int j = 0; j < 4; ++j) TT[(16 * mt + 4 * fq + j) * TT_P + d] = acc[j] * sc;
            }
        }
        __syncthreads();
        tt_rows_out(lds, Y + R0 * DM + 3 * DG, mog + 3 * DG, wave, lane);
        __syncthreads();
    }
}

DI void mixer_sample(AP a, int l, int bs, LAS unsigned char* lds, int wave, int lane) {
    unsigned char* ws = a->ws;
    const float* z = (const float*)(ws + WS_ZS) + (size_t)bs * DIN;
    float* ys = (float*)(ws + WS_YS) + (size_t)bs * DM;
    const float* mog = a->in[I_MOG] + l * DM;
    const int c4 = 4 * lane;
    {
        const f32x4 u = *(const f32x4*)(z + c4), v = *(const f32x4*)(z + 256 + c4);
        const f32x4 lg = *(const f32x4*)(a->in[I_LNG] + l * DG + c4), lb = *(const f32x4*)(a->in[I_LNB] + l * DG + c4);
        const float mean = wave_sum(hsum4(v)) * (1.0f / DG); const f32x4 d = v - mean;
        const float rstd = rsqrtf(wave_sum(hsq4(d)) * (1.0f / DG) + EPS);
        const f32x4 vn = d * rstd * lg + lb;
        *(f32x4*)(a->out + O_GV + ((size_t)l * NS + bs) * DG + c4) = vn;
        const int h = lane >> 4;
        const float w00 = a->in[I_GWS][((size_t)(l * 4 + h) * 128) * 128], b0 = a->in[I_GBS][(l * 4 + h) * 128];
        const f32x4 y = u * (vn * w00 + b0);
        const float r = rsqrtf(wave_sum(hsq4(y)) * (1.0f / DG) + EPS);
        *(f32x4*)(ys + c4) = y * r * *(const f32x4*)(mog + c4);
    }
    {
        const f32x4 ga = *(const f32x4*)(z + 512 + c4), gg = *(const f32x4*)(z + 768 + c4);
        f32x4 glu;
#pragma unroll
        for (int i = 0; i < 4; ++i) glu[i] = ga[i] * sigmoidf_(gg[i]);
        const float* st = a->in[I_SGLU] + ((size_t)(l * NS + bs) * 30) * DG + c4;
        float* so = a->out + O_GLUS + ((size_t)(l * NS + bs) * 30) * DG + c4;
        const float* cw = a->in[I_CDW] + (size_t)l * 31 * DG + c4;
        f32x4 acc = *(const f32x4*)(cw + 30 * DG) * glu;
#pragma unroll 6
        for (int j = 0; j < 30; ++j) { const f32x4 sv = *(const f32x4*)(st + j * DG); acc += *(const f32x4*)(cw + j * DG) * sv; if (j >= 1) *(f32x4*)(so + (j - 1) * DG) = sv; }
        *(f32x4*)(so + 29 * DG) = glu;
        const f32x4 x = acc + *(const f32x4*)(a->in[I_CDWB] + l * DG + c4);
        const float mean = wave_sum(hsum4(x)) * (1.0f / DG); const f32x4 d = x - mean;
        const float rstd = rsqrtf(wave_sum(hsq4(d)) * (1.0f / DG) + EPS);
        f32x4 y = d * rstd * *(const f32x4*)(a->in[I_CLNG] + l * DG + c4) + *(const f32x4*)(a->in[I_CLNB] + l * DG + c4);
#pragma unroll
        for (int i = 0; i < 4; ++i) y[i] = y[i] * sigmoidf_(y[i]);
        const float r = rsqrtf(wave_sum(hsq4(y)) * (1.0f / DG) + EPS);
        *(f32x4*)(ys + DG + c4) = y * r * *(const f32x4*)(mog + DG + c4);
    }
    {
        const f32x4 sb = *(const f32x4*)(z + 1024 + c4), s = *(const f32x4*)(z + 1280 + c4) * *(const f32x4*)(z + 1536 + c4);
        const float* st = a->in[I_SSH] + ((size_t)(l * NS + bs) * 2) * DG + c4;
        float* so = a->out + O_SHS + ((size_t)(l * NS + bs) * 2) * DG + c4;
        const float* sw = a->in[I_SCDW] + (size_t)l * 3 * DG + c4;
        const f32x4 s0 = *(const f32x4*)st, s1 = *(const f32x4*)(st + DG);
        const f32x4 y = sb * (*(const f32x4*)sw * s0 + *(const f32x4*)(sw + DG) * s1 + *(const f32x4*)(sw + 2 * DG) * s);
        *(f32x4*)so = s1; *(f32x4*)(so + DG) = s;
        const float r = rsqrtf(wave_sum(hsq4(y)) * (1.0f / DG) + EPS);
        *(f32x4*)(ys + 2 * DG + c4) = y * r * *(const f32x4*)(mog + 2 * DG + c4);
    }
    {
        const f32x4 px = *(const f32x4*)(z + 1792 + c4);
        const float* st = a->in[I_SPL] + ((size_t)(l * NS + bs) * 15) * DG + c4;
        float* so = a->out + O_PLS + ((size_t)(l * NS + bs) * 15) * DG + c4;
        const int g = lane >> 4, w = 2 << g;
        f32x4 sum = px;
#pragma unroll
        for (int j = 0; j < 15; ++j) { const f32x4 sv = *(const f32x4*)(st + j * DG); if (15 - j < w) sum += sv; if (j >= 1) *(f32x4*)(so + (j - 1) * DG) = sv; }
        *(f32x4*)(so + 14 * DG) = px;
        const f32x4 pooled = sum / (float)w - px;
        LAS float* PLs = (LAS float*)(lds + wave * 1024);
        *(LAS f32x4*)(PLs + c4) = pooled;
        asm volatile("s_waitcnt lgkmcnt(0)" ::: "memory");
        const float* pw = a->in[I_PW] + (size_t)l * 16384 + (size_t)g * 4096 + 4 * (lane & 15);
        f32x4 acc = {0.f, 0.f, 0.f, 0.f};
#pragma unroll 8
        for (int c = 0; c < 64; ++c) acc += *(const f32x4*)(pw + c * 64) * PLs[g * 64 + c];
        const f32x4 y = acc * *(const f32x4*)(a->in[I_PSC] + l * DG + c4);
        const float r = rsqrtf(wave_sum(hsq4(y)) * (1.0f / DG) + EPS);
        *(f32x4*)(ys + 3 * DG + c4) = y * r * *(const f32x4*)(mog + 3 * DG + c4);
        asm volatile("s_waitcnt lgkmcnt(0)" ::: "memory");
    }
}

DI void attn_unit(AP a, int l, int uidx, int wave, int lane) {
    unsigned char* ws = a->ws;
    const int b = uidx >> 5, h = (uidx >> 3) & 3, qt = uidx & 7;
    const int r32 = lane & 31, hi = lane >> 5;
    const size_t q0 = (size_t)b * SEQ + qt * 256 + 32 * wave;
    const bf16_t* Qp = (const bf16_t*)(ws + WS_Q) + (q0 + r32) * DM + h * 256 + 8 * hi;
    const bf16_t* Kp = (const bf16_t*)(ws + WS_KP) + ((size_t)l * MM + b * 256 + r32) * DM + h * 256 + 8 * hi;
    const bf16_t* Vp = (const bf16_t*)(ws + WS_VT) + ((size_t)((l * NB + b) * 4 + h) * 256 + r32) * 256 + 4 * hi;
    bf16x8 qf[16];
#pragma unroll
    for (int ks = 0; ks < 16; ++ks) qf[ks] = *(const bf16x8*)(Qp + 16 * ks);
    f32x16 S[8];
#pragma unroll
    for (int kt = 0; kt < 8; ++kt) {
#pragma unroll
        for (int i = 0; i < 16; ++i) S[kt][i] = 0.f;
#pragma unroll
        for (int ks = 0; ks < 16; ++ks) {
            const bf16x8 kf = *(const bf16x8*)(Kp + (size_t)kt * 32 * DM + 16 * ks);
            S[kt] = __builtin_amdgcn_mfma_f32_32x32x16_bf16(kf, qf[ks], S[kt], 0, 0, 0);
        }
    }
    float mx = -3.0e38f;
#pragma unroll
    for (int kt = 0; kt < 8; ++kt)
#pragma unroll
        for (int i = 0; i < 16; ++i) mx = fmaxf(mx, S[kt][i]);
    mx = fmaxf(mx, __shfl_xor(mx, 32));
    float sum = 0.f; const float mxl = mx * 1.4426950408889634f;
#pragma unroll
    for (int kt = 0; kt < 8; ++kt)
#pragma unroll
        for (int i = 0; i < 16; ++i) { const float p = exp2f(S[kt][i] * 1.4426950408889634f - mxl); S[kt][i] = p; sum += p; }
    sum += __shfl_xor(sum, 32);
    const float inv = 1.0f / sum;
    bf16x8 pf[16];
#pragma unroll
    for (int kt = 0; kt < 8; ++kt)
#pragma unroll
        for (int c = 0; c < 2; ++c) {
            u32x4 p; p.x = pk2(S[kt][8 * c + 0], S[kt][8 * c + 1]); p.y = pk2(S[kt][8 * c + 2], S[kt][8 * c + 3]); p.z = pk2(S[kt][8 * c + 4], S[kt][8 * c + 5]); p.w = pk2(S[kt][8 * c + 6], S[kt][8 * c + 7]);
            pf[2 * kt + c] = __builtin_bit_cast(bf16x8, p);
        }
    bf16_t* Op = (bf16_t*)(ws + WS_O) + (q0 + r32) * DM + h * 256 + 4 * hi;
#pragma unroll
    for (int dt = 0; dt < 8; ++dt) {
        f32x16 o;
#pragma unroll
        for (int i = 0; i < 16; ++i) o[i] = 0.f;
#pragma unroll
        for (int kc = 0; kc < 16; ++kc) {
            const bf16_t* vp = Vp + (size_t)dt * 32 * 256 + 16 * kc;
            const u32x2 v0 = *(const u32x2*)vp, v1 = *(const u32x2*)(vp + 8);
            u32x4 vv; vv.x = v0.x; vv.y = v0.y; vv.z = v1.x; vv.w = v1.y;
            o = __builtin_amdgcn_mfma_f32_32x32x16_bf16(__builtin_bit_cast(bf16x8, vv), pf[kc], o, 0, 0, 0);
        }
#pragma unroll
        for (int rg = 0; rg < 4; ++rg) {
            u32x2 w; w.x = pk2(o[4 * rg] * inv, o[4 * rg + 1] * inv); w.y = pk2(o[4 * rg + 2] * inv, o[4 * rg + 3] * inv);
            *(u32x2*)(Op + 32 * dt + 8 * rg) = w;
        }
    }
}

DI void attn_sample_unit(AP a, int l, int uidx, LAS unsigned char* lds, int wave, int lane) {
    unsigned char* ws = a->ws;
    const int bs = uidx >> 1, hp = uidx & 1;
    LAS float* SC = (LAS float*)lds;
    LAS float* RED = (LAS float*)(lds + 4096);
    const float* qp = (const float*)(ws + WS_QS) + (size_t)bs * DM + hp * 512 + 8 * lane;
    const f32x4 q0 = *(const f32x4*)qp, q1 = *(const f32x4*)(qp + 4);
    const float* Kb = a->in[I_CK] + ((size_t)(l * NS + bs) * MEM) * DM + hp * 512 + 8 * lane;
    const float* Vb = a->in[I_CV] + ((size_t)(l * NS + bs) * MEM) * DM + hp * 512 + 8 * lane;
#pragma unroll 8
    for (int mi = 0; mi < 32; ++mi) {
        const int m = wave + 8 * mi;
        const f32x4 k0 = *(const f32x4*)(Kb + (size_t)m * DM), k1 = *(const f32x4*)(Kb + (size_t)m * DM + 4);
        float d = hsum4(k0 * q0) + hsum4(k1 * q1);
        d += __shfl_xor(d, 1); d += __shfl_xor(d, 2); d += __shfl_xor(d, 4); d += __shfl_xor(d, 8); d += __shfl_xor(d, 16);
        if ((lane & 31) == 0) SC[(lane >> 5) * 256 + m] = d;
    }
    __syncthreads();
    if (wave < 2) {
        const f32x4 v = *(const LAS f32x4*)(SC + wave * 256 + 4 * lane);
        float mx = fmaxf(fmaxf(v.x, v.y), fmaxf(v.z, v.w));
#pragma unroll
        for (int o = 1; o < 64; o <<= 1) mx = fmaxf(mx, __shfl_xor(mx, o));
        f32x4 e; e.x = __expf(v.x - mx); e.y = __expf(v.y - mx); e.z = __expf(v.z - mx); e.w = __expf(v.w - mx);
        const float inv = 1.0f / wave_sum(hsum4(e));
        *(LAS f32x4*)(SC + wave * 256 + 4 * lane) = e * inv;
    }
    __syncthreads();
    f32x4 o0 = {0.f, 0.f, 0.f, 0.f}, o1 = {0.f, 0.f, 0.f, 0.f};
#pragma unroll 8
    for (int mi = 0; mi < 32; ++mi) {
        const int m = wave + 8 * mi;
        const f32x4 v0 = *(const f32x4*)(Vb + (size_t)m * DM), v1 = *(const f32x4*)(Vb + (size_t)m * DM + 4);
        const float p = SC[(lane >> 5) * 256 + m];
        o0 += v0 * p; o1 += v1 * p;
    }
    *(LAS f32x4*)(RED + wave * 512 + 8 * lane) = o0; *(LAS f32x4*)(RED + wave * 512 + 8 * lane + 4) = o1;
    __syncthreads();
    {
        const int t = wave * 64 + lane; float s = 0.f;
#pragma unroll
        for (int w = 0; w < 8; ++w) s += RED[w * 512 + t];
        ((float*)(ws + WS_OS))[(size_t)bs * DM + hp * 512 + t] = s;
    }
    __syncthreads();
}

#ifndef PMASK
#define PMASK 0xffff
#endif
constexpr int N_PHASES = 18;
__global__ void __launch_bounds__(NTHR, 2) fwd_kernel(Args a_) {
    extern __shared__ __attribute__((aligned(16))) unsigned char lds_raw[];
    LAS unsigned char* lds = (LAS unsigned char*)lds_raw;
    cg::grid_group grid = cg::this_grid();
    const int ph_lo = a_.ph_lo, ph_hi = a_.ph_hi;
    for (int ph = ph_lo; ph < ph_hi; ++ph) {
        AP a = (AP)__builtin_amdgcn_kernarg_segment_ptr();
        asm volatile("" : "+s"(a));
        int tid = threadIdx.x; asm volatile("" : "+v"(tid));
        const int lane = tid & 63, wave = __builtin_amdgcn_readfirstlane(tid >> 6);
        int bx = blockIdx.x; asm volatile("" : "+s"(bx));
        const int G = gridDim.x;
        unsigned char* ws = a->ws;
        bf16_t* XB = (bf16_t*)(ws + WS_XB); float* SS = (float*)(ws + WS_SS); float* XF = a->out + O_YP;
        float* XS = (float*)(ws + WS_XS); float* ZS = (float*)(ws + WS_ZS); float* YS = (float*)(ws + WS_YS); float* QS = (float*)(ws + WS_QS); float* OS = (float*)(ws + WS_OS); float* HS = (float*)(ws + WS_HS);
        if (ph == 0) {
            if (PMASK & 1) prologue(a, lds, wave, lane);
        } else if (ph == N_PHASES - 1) { if (PMASK & 2) {
            const int gw = bx * NWAVES + wave, NGW = G * NWAVES;
            const float* gf = a->in[I_NFIN];
            for (int m = gw; m < MP + NS; m += NGW) {
                if (m < MP) {
                    const float rs = row_rs(SS + (size_t)m * 16); f32x4* xr = (f32x4*)(XF + (size_t)m * DM) + lane;
#pragma unroll
                    for (int j = 0; j < 4; ++j) xr[64 * j] = xr[64 * j] * rs * ((const f32x4*)gf)[lane + 64 * j];
                } else {
                    const int s = m - MP; const f32x4* xr = (const f32x4*)(XS + (size_t)s * DM) + lane; f32x4 v[4]; float sq = 0.f;
#pragma unroll
                    for (int j = 0; j < 4; ++j) { v[j] = xr[64 * j]; sq += hsq4(v[j]); }
                    const float rs = rsqrtf(wave_sum(sq) * (1.0f / DM) + EPS);
                    f32x4* yo = (f32x4*)(a->out + O_YS + (size_t)s * DM) + lane;
#pragma unroll
                    for (int j = 0; j < 4; ++j) yo[64 * j] = v[j] * rs * ((const f32x4*)gf)[lane + 64 * j];
                }
            }
        } } else {
            const int l = (ph - 1) >> 3, sub = (ph - 1) & 7;
            unsigned char* wl = ws + WS_W + (size_t)l * W_LSTRIDE;
            pg8::StaticOrder S;
            if (sub == 0) { if (PMASK & 4) {
                { pg8::Gemm g{XB, (const bf16_t*)(wl + W_IN), MP, DIN, DM}; S.init(MP, DIN, G, bx);
                  EpiScale<0> E{(bf16_t*)(ws + WS_Z), DIN, SS};
                  pg8::gemm_phase<EpiScale<0>, pg8::StaticOrder, true, true>(lds, g, S, E); }
                if (l == 0) { pg8::Gemm g{(const bf16_t*)(ws + WS_MEMB), (const bf16_t*)(ws + WS_WKV), MM, 4096, DM}; S.init(MM, 4096, G, bx);
                  EpiKV E{(const float*)(ws + WS_MEMSS), a->out + O_MK, a->out + O_MV, (bf16_t*)(ws + WS_KP), (bf16_t*)(ws + WS_VT)};
                  pg8::gemm_phase<EpiKV, pg8::StaticOrder, true, true>(lds, g, S, E); }
                if (PMASK & 0x400) sgemm_phase<0>(XS, DM, (const bf16_t*)(wl + W_IN), DIN, ZS, DIN, wave, lane);
            } } else if (sub == 1) {
                if (PMASK & 8) for (int u = bx; u < 256; u += G) mixer_unit(a, l, u, lds, wave, lane);
                { const int gwr = (G - 1 - bx) * NWAVES + wave; if ((PMASK & 16) && gwr < NS) mixer_sample(a, l, gwr, lds, wave, lane); }
            } else if (sub == 2 || sub == 5 || sub == 7) { if (PMASK & 32) {
                const bf16_t* A = (const bf16_t*)(ws + (sub == 2 ? WS_Y : sub == 5 ? WS_O : WS_H));
                const bf16_t* Bt = (const bf16_t*)(wl + (sub == 2 ? W_OUT : sub == 5 ? W_O : W_F2));
                const int K = sub == 7 ? DFF : DM;
                pg8::Gemm g{A, Bt, MP, DM, K}; S.init(MP, DM, G, bx);
                EpiRes E{(l == 0 && sub == 2) ? a->in[I_XP] : XF, XF, XB, SS};
                pg8::gemm_phase<EpiRes, pg8::StaticOrder, true, true>(lds, g, S, E);
                if (PMASK & 0x400) sgemm_phase<3>(sub == 2 ? YS : sub == 5 ? OS : HS, K, Bt, DM, XS, DM, wave, lane);
            } } else if (sub == 3) { if (PMASK & 64) {
                pg8::Gemm g{XB, (const bf16_t*)(wl + W_Q), MP, DM, DM}; S.init(MP, DM, G, bx);
                EpiScale<1> E{(bf16_t*)(ws + WS_Q), DM, SS};
                pg8::gemm_phase<EpiScale<1>, pg8::StaticOrder, true, true>(lds, g, S, E);
                if (PMASK & 0x400) sgemm_phase<1>(XS, DM, (const bf16_t*)(wl + W_Q), DM, QS, DM, wave, lane);
            } } else if (sub == 4) {
                if (PMASK & 128) for (int u = bx; u < 256; u += G) attn_unit(a, l, u, wave, lane);
                if (PMASK & 256) for (int u = bx; u < 256; u += G) attn_sample_unit(a, l, u, lds, wave, lane);
            } else { if (PMASK & 512) {
                pg8::Gemm g{XB, (const bf16_t*)(wl + W_F1), MP, DFF, DM}; S.init(MP, DFF, G, bx);
                EpiScale<2> E{(bf16_t*)(ws + WS_H), DFF, SS};
                pg8::gemm_phase<EpiScale<2>, pg8::StaticOrder, true, true>(lds, g, S, E);
                if (PMASK & 0x400) sgemm_phase<2>(XS, DM, (const bf16_t*)(wl + W_F1), DFF, HS, DFF, wave, lane);
            } }
        }
        if (ph + 1 < ph_hi) grid.sync();
    }
}

#ifndef N_LAUNCH_MODE
#define N_LAUNCH_MODE 1
#endif
extern "C" void kernel_launch(void* const* d_in, const int* in_sizes, int n_in, void* d_out, int out_size, void* d_ws, size_t ws_size, hipStream_t stream) {
    static int grid = 0;
    if (grid == 0) {
        if (n_in != N_IN || (size_t)out_size != O_END || ws_size < WS_END) { fprintf(stderr, "kernel_launch: unexpected sizes n_in %d out %d ws %zu\n", n_in, out_size, ws_size); grid = -1; return; }
        int dev = 0, cus = 0, per_cu = 0;
        if (hipGetDevice(&dev) != hipSuccess || hipDeviceGetAttribute(&cus, hipDeviceAttributeMultiprocessorCount, dev) != hipSuccess) { grid = -1; return; }
        if (hipFuncSetAttribute((const void*)fwd_kernel, hipFuncAttributeMaxDynamicSharedMemorySize, LDS_BYTES) != hipSuccess) { fprintf(stderr, "kernel_launch: hipFuncSetAttribute failed\n"); grid = -1; return; }
        if (hipOccupancyMaxActiveBlocksPerMultiprocessor(&per_cu, (const void*)fwd_kernel, NTHR, LDS_BYTES) != hipSuccess || per_cu < 1) { fprintf(stderr, "kernel_launch: occupancy query says %d\n", per_cu); per_cu = 1; }
        (void)hipGetLastError();
        grid = cus;
    }
    if (grid < 0) return;
    Args a{};
    for (int i = 0; i < N_IN; ++i) a.in[i] = (const float*)d_in[i];
    a.out = (float*)d_out; a.ws = (unsigned char*)d_ws;
#if N_LAUNCH_MODE == 1
    a.ph_lo = 0; a.ph_hi = N_PHASES;
    void* args[] = {&a};
    hipError_t e = hipLaunchCooperativeKernel((const void*)fwd_kernel, dim3(grid), dim3(NTHR), args, LDS_BYTES, stream);
    if (e != hipSuccess) fprintf(stderr, "cooperative launch failed: %s (grid %d)\n", hipGetErrorString(e), grid);
#else
    for (int ph = 0; ph < N_PHASES; ++ph) {
        a.ph_lo = ph; a.ph_hi = ph + 1;
        hipLaunchKernelGGL(fwd_kernel, dim3(grid), dim3(NTHR), LDS_BYTES, stream, a);
    }
#endif
}
```

```cpp
#define DUPMASK 0
#include <hip/hip_runtime.h>
#include <hip/hip_cooperative_groups.h>
#include <cstdio>
#include <cstdint>
namespace cg = cooperative_groups;
namespace pg8 {
#define PG8_LAS __attribute__((address_space(3)))
typedef unsigned short bf16_t;
typedef short bf16x8 __attribute__((ext_vector_type(8)));
typedef float f32x4 __attribute__((ext_vector_type(4)));
typedef unsigned u32x4 __attribute__((ext_vector_type(4)));
constexpr int BM = 256, BK = 64, HALF = 128, HTB = HALF * BK * 2  , STAGE_BYTES = 8 * HTB, NXCD = 8, WGM = 8;

__host__ __device__ __forceinline__ int lds_byte(int r, int c) { const int st = (r >> 4) * 2 + (c >> 5), rr = r & 15, cc = c & 31, ob = rr * 64 + cc * 2; return st * 1024 + (ob ^ (((ob >> 9) & 1) << 5)); }
__host__ __device__ __forceinline__ void stage_rc(int b, int& R, int& C) { const int st = b / 1024, sb = b % 1024, swz = sb ^ (((sb >> 9) & 1) << 5); R = (st >> 1) * 16 + swz / 64; C = (st & 1) * 32 + (swz % 64) / 2; }
__host__ __device__ __forceinline__ int perm32(int rho) { const int n = rho >> 4, i = rho & 15; return 8 * (i >> 2) + 4 * n + (i & 3); }

struct Unit { int pm, pn; };
struct Gemm { const bf16_t* A; const bf16_t* Bt; int M, N, K; };

struct StaticOrder {
    int nM, nN, nwg, G, c;
    __host__ __device__ void init(int M, int N, int G_, int c_) { nM = M / BM; nN = N / BM; nwg = nM * nN; G = G_; c = c_; }
    __host__ __device__ bool next(int i, Unit& u) const {
        const long L = (long)i * G + c; if (L >= nwg) return false;
        int wgid = (int)L; { const int q = nwg / NXCD, r = nwg % NXCD, xcd = wgid % NXCD, off = wgid / NXCD; wgid = (xcd < r ? xcd * (q + 1) : r * (q + 1) + (xcd - r) * q) + off; }
        const int nig = WGM * nN, gid = wgid / nig, fm = gid * WGM, gsz = (nM - fm) < WGM ? (nM - fm) : WGM;
        u.pm = fm + ((wgid % nig) % gsz); u.pn = (wgid % nig) / gsz; return true;
    }
    __device__ __forceinline__ void a_ready(const Unit&) const {}
    __device__ __forceinline__ void done(const Unit&) const {}
};

__device__ __forceinline__ unsigned cvt_pk_bf16(float lo, float hi) { unsigned r; asm volatile("v_cvt_pk_bf16_f32 %0, %1, %2" : "=v"(r) : "v"(lo), "v"(hi)); return r; }
typedef float f32x2 __attribute__((ext_vector_type(2)));
template <class Epi, class Sched, bool ALIGN_EPI = false, bool SP2 = false>
__device__ __forceinline__ void gemm_phase(PG8_LAS unsigned char* lds, const Gemm g, const Sched& S, const Epi& E) {
    int tid = threadIdx.x; asm volatile("" : "+v"(tid)); const int wid = __builtin_amdgcn_readfirstlane(tid >> 6), lane = tid & 63, wr = wid >> 2, wc = wid & 3, fr = lane & 15, fq = lane >> 4;
    const int K = g.K, nt = K / BK;
    unsigned voffA[2], voffB[2];
#pragma unroll
    for (int i = 0; i < 2; ++i) { int R, C; stage_rc(tid * 16 + i * 8192, R, C); const int Rb = Epi::PERM ? ((R & ~31) + perm32(R & 31)) : R;
        voffA[i] = (unsigned)(R * K + C) * 2u; voffB[i] = (unsigned)(Rb * K + C) * 2u; }
    const size_t kstep = (size_t)(BK * 2);
    const size_t hstep = (size_t)HALF * K * 2;
    const size_t tstep = 2 * hstep;
    const unsigned ldsw = (unsigned)wid * 1024u;
    const int aoff = lds_byte(wr * 64 + fr, fq * 8), boff = lds_byte(wc * 32 + fr, fq * 8);
#define PG8_SA(b, h) (((b) * 2 + (h)) * HTB)
#define PG8_SB(b, h) ((4 + (b) * 2 + (h)) * HTB)
#define PG8_STAGE(bufoff, gbase, voff) do { _Pragma("unroll") for (int _i = 0; _i < 2; ++_i) \
        __builtin_amdgcn_global_load_lds((const unsigned*)((const char*)(gbase) + (voff)[_i]), (PG8_LAS unsigned*)(lds + (bufoff) + ldsw + _i * 8192), 16, 0, 0); } while (0)
#define PG8_LDA(dst, b, h) do { _Pragma("unroll") for (int m = 0; m < 4; ++m) _Pragma("unroll") for (int k = 0; k < 2; ++k) dst[m][k] = *(const PG8_LAS bf16x8*)(lds + PG8_SA(b, h) + aoff + m * 2048 + k * 1024); } while (0)
#define PG8_LDB(dst, b, h) do { _Pragma("unroll") for (int n = 0; n < 2; ++n) _Pragma("unroll") for (int k = 0; k < 2; ++k) dst[n][k] = *(const PG8_LAS bf16x8*)(lds + PG8_SB(b, h) + boff + n * 2048 + k * 1024); } while (0)
#define PG8_MMA(ai, bj, At, Bt) do { __builtin_amdgcn_s_setprio(1); _Pragma("unroll") for (int m = 0; m < 4; ++m) _Pragma("unroll") for (int n = 0; n < 2; ++n) _Pragma("unroll") for (int k = 0; k < 2; ++k) \
        acc[ai][bj][m][n] = __builtin_amdgcn_mfma_f32_16x16x32_bf16(Bt[n][k], At[m][k], acc[ai][bj][m][n], 0, 0, 0); __builtin_amdgcn_s_setprio(0); } while (0)
#define PG8_WAIT_V(n) asm volatile("s_waitcnt vmcnt(" #n ")" ::: "memory")
#define PG8_WAIT_L(n) asm volatile("s_waitcnt lgkmcnt(" #n ")" ::: "memory")
#define PG8_BAR __builtin_amdgcn_s_barrier()
#define PG8_SCHED __builtin_amdgcn_sched_barrier(0)
    Unit cur, nxt; int ui = 0;
    if (!S.next(0, cur)) return;
    f32x4 acc[2][2][4][2];
#pragma unroll
    for (int a = 0; a < 2; ++a)
#pragma unroll
        for (int b = 0; b < 2; ++b)
#pragma unroll
            for (int m = 0; m < 4; ++m)
#pragma unroll
                for (int n = 0; n < 2; ++n) acc[a][b][m][n] = (f32x4){0.f, 0.f, 0.f, 0.f};
    bf16x8 At[4][2], B0[2][2], B1[2][2];
    const char* cA = (const char*)g.A + (size_t)cur.pm * tstep; const char* cB = (const char*)g.Bt + (size_t)cur.pn * tstep;
    S.a_ready(cur);
    if constexpr (SP2) {
        PG8_STAGE(PG8_SB(0, 0), cB, voffB); PG8_STAGE(PG8_SB(0, 1), cB + hstep, voffB); PG8_STAGE(PG8_SA(0, 0), cA, voffA); PG8_STAGE(PG8_SA(0, 1), cA + hstep, voffA);
        if (wr == 1) PG8_BAR;
        PG8_WAIT_V(2); PG8_BAR;
        PG8_STAGE(PG8_SB(1, 0), cB + kstep, voffB); PG8_STAGE(PG8_SA(1, 0), cA + kstep, voffA); PG8_STAGE(PG8_SB(1, 1), cB + hstep + kstep, voffB);
        PG8_WAIT_V(6); PG8_BAR;
    } else {
        PG8_STAGE(PG8_SB(0, 0), cB, voffB); PG8_STAGE(PG8_SA(0, 0), cA, voffA); PG8_STAGE(PG8_SB(0, 1), cB + hstep, voffB); PG8_STAGE(PG8_SA(0, 1), cA + hstep, voffA);
        if (wr == 1) PG8_BAR;
        PG8_WAIT_V(4); PG8_BAR;
        PG8_STAGE(PG8_SB(1, 0), cB + kstep, voffB); PG8_STAGE(PG8_SA(1, 0), cA + kstep, voffA); PG8_STAGE(PG8_SB(1, 1), cB + hstep + kstep, voffB);
        PG8_WAIT_V(6); PG8_BAR;
    }
    for (;;) {
        const bool has_next = S.next(ui + 1, nxt);
        const char* nA = has_next ? (const char*)g.A + (size_t)nxt.pm * tstep : cA; const char* nB = has_next ? (const char*)g.Bt + (size_t)nxt.pn * tstep : cB;
        for (int t = 0; t < nt; t += 2) {
            const bool last = (t == nt - 2);
            const char* a1 = cA + (size_t)(t + 1) * kstep;
            const char* a2 = last ? nA : cA + (size_t)(t + 2) * kstep; const char* b2 = last ? nB : cB + (size_t)(t + 2) * kstep;
            const char* a3 = a2 + kstep; const char* b3 = b2 + kstep;
            if (last && has_next) S.a_ready(nxt);
            if constexpr (SP2) {
            PG8_LDB(B0, 0, 0); PG8_LDB(B1, 0, 1); PG8_SCHED; PG8_LDA(At, 0, 0); PG8_STAGE(PG8_SA(1, 1), a1 + hstep, voffA);
            PG8_WAIT_V(8); PG8_WAIT_L(0); PG8_BAR; PG8_MMA(0, 0, At, B0); PG8_MMA(0, 1, At, B1); PG8_BAR; PG8_SCHED;
            PG8_LDA(At, 0, 1); PG8_STAGE(PG8_SB(0, 0), b2, voffB); PG8_STAGE(PG8_SB(0, 1), b2 + hstep, voffB); PG8_STAGE(PG8_SA(0, 0), a2, voffA);
            PG8_WAIT_V(8); PG8_WAIT_L(0); PG8_BAR; PG8_MMA(1, 0, At, B0); PG8_MMA(1, 1, At, B1); PG8_BAR; PG8_SCHED;
            PG8_LDB(B0, 1, 0); PG8_LDB(B1, 1, 1); PG8_SCHED; PG8_LDA(At, 1, 0); PG8_STAGE(PG8_SA(0, 1), a2 + hstep, voffA);
            PG8_WAIT_V(8); PG8_WAIT_L(0); PG8_BAR; PG8_MMA(0, 0, At, B0); PG8_MMA(0, 1, At, B1); PG8_BAR; PG8_SCHED;
            PG8_LDA(At, 1, 1); PG8_STAGE(PG8_SB(1, 0), b3, voffB); PG8_STAGE(PG8_SB(1, 1), b3 + hstep, voffB); PG8_STAGE(PG8_SA(1, 0), a3, voffA);
            PG8_WAIT_V(8); PG8_WAIT_L(0); PG8_BAR; PG8_MMA(1, 0, At, B0); PG8_MMA(1, 1, At, B1); PG8_BAR; PG8_SCHED;
            } else {
            PG8_LDB(B0, 0, 0); PG8_SCHED; PG8_LDA(At, 0, 0); PG8_STAGE(PG8_SA(1, 1), a1 + hstep, voffA);
            PG8_WAIT_L(8); PG8_BAR; PG8_WAIT_L(0); PG8_MMA(0, 0, At, B0); PG8_BAR; PG8_SCHED;
            PG8_LDB(B1, 0, 1); PG8_STAGE(PG8_SB(0, 0), b2, voffB);
            PG8_BAR; PG8_WAIT_L(0); PG8_MMA(0, 1, At, B1); PG8_BAR;
            PG8_LDA(At, 0, 1); PG8_STAGE(PG8_SA(0, 0), a2, voffA);
            PG8_BAR; PG8_WAIT_L(0); PG8_MMA(1, 0, At, B0); PG8_BAR; PG8_SCHED;
            PG8_STAGE(PG8_SB(0, 1), b2 + hstep, voffB);
            PG8_WAIT_V(6); PG8_BAR; PG8_MMA(1, 1, At, B1); PG8_BAR;
            PG8_LDB(B0, 1, 0); PG8_SCHED; PG8_LDA(At, 1, 0); PG8_STAGE(PG8_SA(0, 1), a2 + hstep, voffA);
            PG8_WAIT_L(8); PG8_BAR; PG8_WAIT_L(0); PG8_MMA(0, 0, At, B0); PG8_BAR; PG8_SCHED;
            PG8_LDB(B1, 1, 1); PG8_STAGE(PG8_SB(1, 0), b3, voffB);
            PG8_BAR; PG8_WAIT_L(0); PG8_MMA(0, 1, At, B1); PG8_BAR;
            PG8_LDA(At, 1, 1); PG8_STAGE(PG8_SA(1, 0), a3, voffA);
            PG8_BAR; PG8_WAIT_L(0); PG8_MMA(1, 0, At, B0); PG8_BAR; PG8_SCHED;
            PG8_STAGE(PG8_SB(1, 1), b3 + hstep, voffB);
            PG8_WAIT_V(6); PG8_BAR; PG8_MMA(1, 1, At, B1); PG8_BAR;
            }
        }
        if constexpr (ALIGN_EPI) { if (wr == 0) PG8_BAR; }
        if constexpr (!Epi::AFTER_DRAIN) { E(acc, cur, wr, wc, fr, fq); S.done(cur); }
        if (!has_next) break;
#pragma unroll
        for (int a = 0; a < 2; ++a)
#pragma unroll
            for (int b = 0; b < 2; ++b)
#pragma unroll
                for (int m = 0; m < 4; ++m)
#pragma unroll
                    for (int n = 0; n < 2; ++n) acc[a][b][m][n] = (f32x4){0.f, 0.f, 0.f, 0.f};
        cur = nxt; cA = nA; cB = nB; ++ui;
        if constexpr (ALIGN_EPI) { if (wr == 1) PG8_BAR; }
    }
    PG8_WAIT_V(0);
    if constexpr (!ALIGN_EPI) { if (wr == 0) PG8_BAR; }
    PG8_BAR;
    if constexpr (Epi::AFTER_DRAIN) { E.fused(acc, cur, wr, wc, fr, fq, lds, wid, lane); S.done(cur); }
#undef PG8_SA
#undef PG8_SB
#undef PG8_STAGE
#undef PG8_LDA
#undef PG8_LDB
#undef PG8_MMA
#undef PG8_WAIT_V
#undef PG8_WAIT_L
#undef PG8_BAR
#undef PG8_SCHED
}
}

#define DI __device__ __forceinline__
#define LAS __attribute__((address_space(3)))
typedef unsigned short bf16_t;
typedef short bf16x8 __attribute__((ext_vector_type(8)));
typedef float f32x4 __attribute__((ext_vector_type(4)));
typedef float f32x16 __attribute__((ext_vector_type(16)));
typedef unsigned u32x4 __attribute__((ext_vector_type(4)));
typedef unsigned u32x2 __attribute__((ext_vector_type(2)));
typedef float f32x2_t __attribute__((ext_vector_type(2)));
typedef __bf16 bf16x2_t __attribute__((ext_vector_type(2)));

constexpr int DM = 1024, NB = 8, SEQ = 2048, MP = NB * SEQ, NL = 2, NS = 128, MEM = 256, MM = NB * MEM, DG = 256, DIN = 2048, DFF = 4096;
constexpr float EPS = 1e-6f;
constexpr int NWAVES = 8, NTHR = 512;
constexpr int LDS_BYTES = 147456;

constexpr size_t MiB = 1u << 20;
constexpr size_t WS_W = 2 * MiB, W_LSTRIDE = 28 * MiB;
constexpr size_t W_IN = 0, W_OUT = 4 * MiB, W_Q = 6 * MiB, W_O = 8 * MiB, W_F1 = 10 * MiB, W_F2 = 18 * MiB, W_GWS = 26 * MiB, W_PWT = 26 * MiB + 512 * 1024;
constexpr size_t WS_WKV = 58 * MiB;
constexpr size_t WS_MEMB = 66 * MiB;
constexpr size_t WS_MEMSS = 70 * MiB;
constexpr size_t WS_SS = 71 * MiB;
constexpr size_t WS_XB = 72 * MiB;
constexpr size_t WS_Z = 104 * MiB;
constexpr size_t WS_Y = 168 * MiB;
constexpr size_t WS_Q = 200 * MiB;
constexpr size_t WS_O = 232 * MiB;
constexpr size_t WS_H = 264 * MiB;
constexpr size_t WS_KP = 392 * MiB;
constexpr size_t WS_VT = 400 * MiB;
constexpr size_t WS_XS = 408 * MiB, WS_YS = 408 * MiB + 512 * 1024, WS_OS = 409 * MiB, WS_SSQ = 409 * MiB + 512 * 1024  , WS_ZS = 410 * MiB  , WS_QS = 412 * MiB  , WS_HS = 413 * MiB  , WS_END = 417 * MiB;
constexpr size_t WS_CTL = 0, CTL_ZERO_BYTES = 65536;

constexpr size_t O_YP = 0, O_YS = O_YP + (size_t)MP * DM, O_MK = O_YS + (size_t)NS * DM, O_MV = O_MK + (size_t)NL * MM * DM, O_GLUP = O_MV + (size_t)NL * MM * DM,
                 O_GLUS = O_GLUP + (size_t)NL * NB * 30 * DG, O_SHP = O_GLUS + (size_t)NL * NS * 30 * DG, O_SHS = O_SHP + (size_t)NL * NB * 2 * DG,
                 O_PLP = O_SHS + (size_t)NL * NS * 2 * DG, O_PLS = O_PLP + (size_t)NL * NB * 15 * DG, O_GV = O_PLS + (size_t)NL * NS * 15 * DG, O_END = O_GV + (size_t)NL * NS * DG;

enum { I_XP = 0, I_XS, I_MEM, I_CK, I_CV, I_SGLU, I_SSH, I_SPL, I_NMIX, I_WIN, I_LNG, I_LNB, I_GWS, I_GBS, I_CDW, I_CDWB, I_CLNG, I_CLNB, I_SCDW, I_PW, I_PSC, I_MOG, I_WOUT,
       I_NXA, I_NMEM, I_WQ, I_WK, I_WV, I_WO, I_NFF, I_WF1, I_WF2, I_NFIN, N_IN };

DI unsigned pk2(float lo, float hi) { f32x2_t v = {lo, hi}; bf16x2_t b = __builtin_convertvector(v, bf16x2_t); return __builtin_bit_cast(unsigned, b); }
DI float bf2f(unsigned short u) { return __uint_as_float((unsigned)u << 16); }
DI float bflo(unsigned u) { return __uint_as_float(u << 16); }
DI float bfhi(unsigned u) { return __uint_as_float(u & 0xffff0000u); }
DI f32x4 ld_bf4(const bf16_t* p) { const u32x2 w = *(const u32x2*)p; return (f32x4){bflo(w.x), bfhi(w.x), bflo(w.y), bfhi(w.y)}; }
DI void st_bf4(bf16_t* p, f32x4 v) { u32x2 w; w.x = pk2(v.x, v.y); w.y = pk2(v.z, v.w); *(u32x2*)p = w; }
DI float wave_sum(float v) {
#pragma unroll
    for (int o = 1; o < 64; o <<= 1) v += __shfl_xor(v, o);
    return v;
}
DI float hsum4(f32x4 v) { return (v.x + v.y) + (v.z + v.w); }
DI float hsq4(f32x4 v) { return (v.x * v.x + v.y * v.y) + (v.z * v.z + v.w * v.w); }
DI float sigmoidf_(float x) { return 1.0f / (1.0f + __expf(-x)); }
DI float row_rs(const float* ss16) {
    const f32x4* sp = (const f32x4*)ss16; const f32x4 a = sp[0], b = sp[1], c = sp[2], d = sp[3];
    const float s = (hsum4(a) + hsum4(b)) + (hsum4(c) + hsum4(d));
    return rsqrtf(s * (1.0f / DM) + EPS);
}

template <int MODE  > struct EpiScale {
    static constexpr bool PERM = true, AFTER_DRAIN = false;
    bf16_t* O; int ldc; const float* ss;
    DI void operator()(const f32x4 (&acc)[2][2][4][2], const pg8::Unit& u, int wr, int wc, int fr, int fq) const {
        const int row0 = u.pm * 256 + wr * 64 + fr, col0 = u.pn * 256 + wc * 32 + 8 * fq;
#pragma unroll
        for (int ai = 0; ai < 2; ++ai)
#pragma unroll
            for (int m = 0; m < 4; ++m) {
                const int row = row0 + ai * 128 + m * 16;
                float rs = row_rs(ss + (size_t)row * 16); if (MODE == 1) rs *= 0.0625f;
                bf16_t* rowp = O + (size_t)row * ldc + col0;
#pragma unroll
                for (int bj = 0; bj < 2; ++bj) {
                    f32x4 v0 = acc[ai][bj][m][0] * rs, v1 = acc[ai][bj][m][1] * rs;
                    if (MODE == 2) {
#pragma unroll
                        for (int j = 0; j < 4; ++j) { float a = fmaxf(v0[j], 0.f), b = fmaxf(v1[j], 0.f); v0[j] = a * a; v1[j] = b * b; }
                    }
                    u32x4 w; w.x = pk2(v0[0], v0[1]); w.y = pk2(v0[2], v0[3]); w.z = pk2(v1[0], v1[1]); w.w = pk2(v1[2], v1[3]);
                    *(u32x4*)(rowp + bj * 128) = w;
                }
            }
    }
};
struct EpiKV {
    static constexpr bool PERM = true, AFTER_DRAIN = false;
    const float* mss; float* outK; float* outV; bf16_t* KP; bf16_t* VT;
    DI void operator()(const f32x4 (&acc)[2][2][4][2], const pg8::Unit& u, int wr, int wc, int fr, int fq) const {
        const int l = u.pn >> 3, w8 = u.pn & 7, isV = w8 >> 2, h = w8 & 3, b = u.pm;
        const int row0 = u.pm * 256 + wr * 64 + fr, colh0 = h * 256 + wc * 32 + 8 * fq;
        float* outp = (isV ? outV : outK) + (size_t)l * MM * DM;
#pragma unroll
        for (int ai = 0; ai < 2; ++ai)
#pragma unroll
            for (int m = 0; m < 4; ++m) {
                const int row = row0 + ai * 128 + m * 16;
                const float rs = rsqrtf(mss[row] * (1.0f / DM) + EPS);
#pragma unroll
                for (int bj = 0; bj < 2; ++bj) {
                    const int colh = colh0 + bj * 128;
                    const f32x4 v0 = acc[ai][bj][m][0] * rs, v1 = acc[ai][bj][m][1] * rs;
                    *(f32x4*)(outp + (size_t)row * DM + colh) = v0; *(f32x4*)(outp + (size_t)row * DM + colh + 4) = v1;
                    if (!isV) {
                        u32x4 w; w.x = pk2(v0[0], v0[1]); w.y = pk2(v0[2], v0[3]); w.z = pk2(v1[0], v1[1]); w.w = pk2(v1[2], v1[3]);
                        *(u32x4*)(KP + ((size_t)l * MM + row) * DM + colh) = w;
                    } else {
                        bf16_t* vt = VT + ((size_t)((l * NB + b) * 4 + h) * 256 + (colh & 255)) * 256 + (row & 255);
#pragma unroll
                        for (int j = 0; j < 4; ++j) { vt[(size_t)j * 256] = (bf16_t)(pk2(v0[j], 0.f) & 0xffffu); vt[(size_t)(j + 4) * 256] = (bf16_t)(pk2(v1[j], 0.f) & 0xffffu); }
                    }
                }
            }
    }
};
struct EpiRes {
    static constexpr bool PERM = false, AFTER_DRAIN = false;
    const float* xold; float* xnew; bf16_t* xb; float* ss;
    DI void operator()(const f32x4 (&acc)[2][2][4][2], const pg8::Unit& u, int wr, int wc, int fr, int fq) const {
        const int row0 = u.pm * 256 + wr * 64 + fr, col0 = u.pn * 256 + wc * 32 + 4 * fq;
#pragma unroll
        for (int ai = 0; ai < 2; ++ai)
#pragma unroll
            for (int m = 0; m < 4; ++m) {
                const int row = row0 + ai * 128 + m * 16; const size_t off = (size_t)row * DM + col0;
                float sq = 0.f;
#pragma unroll
                for (int bj = 0; bj < 2; ++bj)
#pragma unroll
                    for (int n = 0; n < 2; ++n) {
                        const f32x4 o = *(const f32x4*)(xold + off + bj * 128 + n * 16) + acc[ai][bj][m][n];
                        *(f32x4*)(xnew + off + bj * 128 + n * 16) = o; st_bf4(xb + off + bj * 128 + n * 16, o); sq += hsq4(o);
                    }
                sq += __shfl_xor(sq, 16); sq += __shfl_xor(sq, 32);
                if (fq == 0) ss[(size_t)row * 16 + u.pn * 4 + wc] = sq;
                asm volatile("" ::: "memory");
            }
    }
};

template <int AMODE, bool SSQ> DI void sgemm_item(const float* A, int lda, const bf16_t* Bt, int ldb, int n0, int kbase, float* Out, int ldo, const float* ssq_in, float* ssq_out, int wave, int lane) {
    const int r = lane & 15, q = lane >> 4;
    const float* ap = A + (size_t)(16 * wave + r) * lda + kbase + 16 * q;
    const bf16_t* bp = Bt + (size_t)(n0 + r) * ldb + kbase + 16 * q;
    f32x4 av[4][4]; bf16x8 bv[4][2];
#pragma unroll
    for (int c = 0; c < 4; ++c) {
#pragma unroll
        for (int i = 0; i < 4; ++i) av[c][i] = *(const f32x4*)(ap + 64 * c + 4 * i);
        bv[c][0] = *(const bf16x8*)(bp + 64 * c); bv[c][1] = *(const bf16x8*)(bp + 64 * c + 8);
    }
    float rsA = 1.f; if (AMODE == 1) rsA = rsqrtf(ssq_in[16 * wave + r] * (1.0f / DM) + EPS);
    f32x4 acc = {0.f, 0.f, 0.f, 0.f}; float ssq = 0.f;
#pragma unroll
    for (int c = 0; c < 4; ++c) {
        if (AMODE == 1) {
#pragma unroll
            for (int i = 0; i < 4; ++i)
#pragma unroll
                for (int j = 0; j < 4; ++j) { const float t = fmaxf(av[c][i][j] * rsA, 0.f); av[c][i][j] = t * t; }
        }
        if (SSQ) ssq += (hsq4(av[c][0]) + hsq4(av[c][1])) + (hsq4(av[c][2]) + hsq4(av[c][3]));
        u32x4 p0, p1; p0.x = pk2(av[c][0].x, av[c][0].y); p0.y = pk2(av[c][0].z, av[c][0].w); p0.z = pk2(av[c][1].x, av[c][1].y); p0.w = pk2(av[c][1].z, av[c][1].w);
        p1.x = pk2(av[c][2].x, av[c][2].y); p1.y = pk2(av[c][2].z, av[c][2].w); p1.z = pk2(av[c][3].x, av[c][3].y); p1.w = pk2(av[c][3].z, av[c][3].w);
        acc = __builtin_amdgcn_mfma_f32_16x16x32_bf16(__builtin_bit_cast(bf16x8, p0), bv[c][0], acc, 0, 0, 0);
        acc = __builtin_amdgcn_mfma_f32_16x16x32_bf16(__builtin_bit_cast(bf16x8, p1), bv[c][1], acc, 0, 0, 0);
    }
    if (SSQ) { if (n0 == 0) { ssq += __shfl_xor(ssq, 16); ssq += __shfl_xor(ssq, 32); if (q == 0) unsafeAtomicAdd(ssq_out + 16 * wave + r, ssq); } }
#pragma unroll
    for (int j = 0; j < 4; ++j) unsafeAtomicAdd(Out + (size_t)(16 * wave + 4 * q + j) * ldo + n0 + r, acc[j]);
}
template <int AMODE, bool SSQ> DI void sgemm_phase(const float* A, int K, const bf16_t* Bt, int N, float* Out, const float* ssq_in, float* ssq_out, int bx, int G, int wave, int lane) {
    const int nsl = N / 16, nit = nsl * (K / 256);
    for (int it = bx; it < nit; it += G) { const int sl = it % nsl, kp = it / nsl; sgemm_item<AMODE, SSQ>(A, K, Bt, K, sl * 16, kp * 256, Out, N, ssq_in, ssq_out, wave, lane); }
}

DI void p0_transpose_item(const float* W, const float* g, int K, int N, bf16_t* WT, int row_off, LAS float* scr, int item, int lane) {
    const int nblk = N / 32, kb = item / nblk, nb = item % nblk, k0 = 64 * kb, n0 = 32 * nb;
#pragma unroll 8
    for (int i = 0; i < 32; ++i) { const int kk = 2 * i + (lane >> 5); const float gv = g ? g[k0 + kk] : 1.f; scr[kk * 33 + (lane & 31)] = W[(size_t)(k0 + kk) * N + n0 + (lane & 31)] * gv; }
    asm volatile("s_waitcnt lgkmcnt(0)" ::: "memory");
    const int c = lane & 7;
#pragma unroll
    for (int j = 0; j < 4; ++j) { const int n = (lane >> 3) + 8 * j; const LAS float* s = scr + (8 * c) * 33 + n;
        u32x4 o; o.x = pk2(s[0 * 33], s[1 * 33]); o.y = pk2(s[2 * 33], s[3 * 33]); o.z = pk2(s[4 * 33], s[5 * 33]); o.w = pk2(s[6 * 33], s[7 * 33]);
        *(u32x4*)(WT + (size_t)(row_off + n0 + n) * K + k0 + 8 * c) = o; }
    asm volatile("s_waitcnt lgkmcnt(0)" ::: "memory");
}
DI float row_to_bf16(const float* xrow, bf16_t* orow, int lane) {
    const f32x4* xr = (const f32x4*)xrow + lane; float s = 0.f;
#pragma unroll
    for (int j = 0; j < 4; ++j) { const f32x4 v = xr[64 * j]; s += hsq4(v); st_bf4(orow + 4 * lane + 256 * j, v); }
    return wave_sum(s);
}

struct Args { const float* in[N_IN]; float* out; unsigned char* ws; int ph_lo, ph_hi; };
typedef const __attribute__((address_space(4))) Args* AP;

DI void prologue(AP a, LAS unsigned char* lds, int wave, int lane) {
    unsigned char* ws = a->ws;
    LAS float* scr = (LAS float*)(lds + wave * 16384);
    const int gw = blockIdx.x * NWAVES + wave, NGW = gridDim.x * NWAVES;
    constexpr int IT_IN = 16 * 64, IT_SQ = 16 * 32, IT_F1 = 16 * 128, IT_F2 = 64 * 32, IT_L = IT_IN + 5 * IT_SQ + IT_F1 + IT_F2;
    for (int it = gw; it < NL * IT_L; it += NGW) {
        const int l = it / IT_L; int r = it % IT_L;
        unsigned char* wl = ws + WS_W + (size_t)l * W_LSTRIDE;
        if (r < IT_IN) { p0_transpose_item(a->in[I_WIN] + (size_t)l * DM * DIN, a->in[I_NMIX] + l * DM, DM, DIN, (bf16_t*)(wl + W_IN), 0, scr, r, lane); continue; } r -= IT_IN;
        if (r < IT_SQ) { p0_transpose_item(a->in[I_WOUT] + (size_t)l * DM * DM, nullptr, DM, DM, (bf16_t*)(wl + W_OUT), 0, scr, r, lane); continue; } r -= IT_SQ;
        if (r < IT_SQ) { p0_transpose_item(a->in[I_WQ] + (size_t)l * DM * DM, a->in[I_NXA] + l * DM, DM, DM, (bf16_t*)(wl + W_Q), 0, scr, r, lane); continue; } r -= IT_SQ;
        if (r < IT_SQ) { p0_transpose_item(a->in[I_WK] + (size_t)l * DM * DM, a->in[I_NMEM] + l * DM, DM, DM, (bf16_t*)(ws + WS_WKV), l * 2048, scr, r, lane); continue; } r -= IT_SQ;
        if (r < IT_SQ) { p0_transpose_item(a->in[I_WV] + (size_t)l * DM * DM, a->in[I_NMEM] + l * DM, DM, DM, (bf16_t*)(ws + WS_WKV), l * 2048 + 1024, scr, r, lane); continue; } r -= IT_SQ;
        if (r < IT_SQ) { p0_transpose_item(a->in[I_WO] + (size_t)l * DM * DM, nullptr, DM, DM, (bf16_t*)(wl + W_O), 0, scr, r, lane); continue; } r -= IT_SQ;
        if (r < IT_F1) { p0_transpose_item(a->in[I_WF1] + (size_t)l * DM * DFF, a->in[I_NFF] + l * DM, DM, DFF, (bf16_t*)(wl + W_F1), 0, scr, r, lane); continue; } r -= IT_F1;
        p0_transpose_item(a->in[I_WF2] + (size_t)l * DFF * DM, nullptr, DFF, DM, (bf16_t*)(wl + W_F2), 0, scr, r, lane);
    }
    {
        bf16_t* XB = (bf16_t*)(ws + WS_XB); float* SS = (float*)(ws + WS_SS);
        for (int m = gw; m < MP; m += NGW) { const float s = row_to_bf16(a->in[I_XP] + (size_t)m * DM, XB + (size_t)m * DM, lane); if (lane < 16) SS[(size_t)m * 16 + lane] = lane == 0 ? s : 0.f; }
        bf16_t* MB = (bf16_t*)(ws + WS_MEMB); float* MS = (float*)(ws + WS_MEMSS);
        for (int m = gw; m < MM; m += NGW) { const float s = row_to_bf16(a->in[I_MEM] + (size_t)m * DM, MB + (size_t)m * DM, lane); if (lane == 0) MS[m] = s; }
    }
    {
        const int gt = blockIdx.x * NTHR + wave * 64 + lane, NGT = gridDim.x * NTHR;
        for (int i = gt; i < NL * 4 * 128 * 128; i += NGT) { const int l = i >> 16, r = i & 65535, t = (r >> 7) & 127, s = r & 127;
            ((bf16_t*)(ws + WS_W + (size_t)l * W_LSTRIDE + W_GWS))[r] = (bf16_t)(pk2(s <= t ? a->in[I_GWS][i] : 0.f, 0.f) & 0xffffu); }
        for (int i = gt; i < NL * 4 * 64 * 64; i += NGT) { const int l = i >> 14, r = i & 16383, g = r >> 12, d = (r >> 6) & 63, c = r & 63;
            ((bf16_t*)(ws + WS_W + (size_t)l * W_LSTRIDE + W_PWT))[r] = (bf16_t)(pk2(a->in[I_PW][(size_t)l * 16384 + g * 4096 + c * 64 + d], 0.f) & 0xffffu); }
        for (int i = gt; i < NS * DM / 4; i += NGT) ((f32x4*)(ws + WS_XS))[i] = ((const f32x4*)a->in[I_XS])[i];
        for (int i = gt; i < (int)((WS_END - WS_ZS) / 16); i += NGT) ((f32x4*)(ws + WS_ZS))[i] = (f32x4){0.f, 0.f, 0.f, 0.f};
        for (int i = gt; i < NL * 3 * NS; i += NGT) ((float*)(ws + WS_SSQ))[i] = 0.f;
    }
}

#ifndef MIXP
#define MIXP 15
#endif
constexpr int VNT_P = 136;
constexpr int TT_OFF = 69632, TT_P = 260;
constexpr int CW_OFF = 96256;
constexpr int PL_P = 264;

DI void tt_rows_out(LAS unsigned char* lds, bf16_t* Yrow0, const float* mog, int wave, int lane) {
    const LAS float* TT = (const LAS float*)(lds + TT_OFF);
    const f32x4 g = *(const f32x4*)(mog + 4 * lane);
#pragma unroll
    for (int i = 0; i < 8; ++i) {
        const int tt = 8 * wave + i;
        const f32x4 v = *(const LAS f32x4*)(TT + tt * TT_P + 4 * lane);
        const float r = rsqrtf(wave_sum(hsq4(v)) * (1.0f / DG) + EPS);
        st_bf4(Yrow0 + (size_t)tt * DM + 4 * lane, v * r * g);
    }
}

DI void mixer_unit(AP a, int l, int uidx, LAS unsigned char* lds, int wave, int lane) {
    unsigned char* ws = a->ws;
    const int b = uidx >> 5, ju = uidx & 31, t0 = ju * 64, off = t0 & 127, tc = t0 - off;
    const size_t R0 = (size_t)b * SEQ + t0;
    const bf16_t* Z = (const bf16_t*)(ws + WS_Z);
    bf16_t* Y = (bf16_t*)(ws + WS_Y);
    const float* mog = a->in[I_MOG] + l * DM;
    if (MIXP & 1) {
        int lq_ = lane; asm volatile("" : "+v"(lq_)); const int lane = lq_; const int fr = lane & 15, fq = lane >> 4; (void)fr; (void)fq;
        LAS bf16_t* VNT = (LAS bf16_t*)lds;
        const f32x4 lg = *(const f32x4*)(a->in[I_LNG] + l * DG + 4 * lane), lb = *(const f32x4*)(a->in[I_LNB] + l * DG + 4 * lane);
        const int nrow = off + 64;
        for (int s = wave; s < nrow; s += NWAVES) {
            const f32x4 v = ld_bf4(Z + ((size_t)b * SEQ + tc + s) * DIN + 256 + 4 * lane);
            const float mean = wave_sum(hsum4(v)) * (1.0f / DG); const f32x4 d = v - mean;
            const float rstd = rsqrtf(wave_sum(hsq4(d)) * (1.0f / DG) + EPS);
            const f32x4 vn = d * rstd * lg + lb;
#pragma unroll
            for (int i = 0; i < 4; ++i) VNT[(4 * lane + i) * VNT_P + s] = (bf16_t)(pk2(vn[i], 0.f) & 0xffffu);
        }
        __syncthreads();
        const int mt = wave & 3, hp = wave >> 2, tl0 = off + 16 * mt, nks = (tl0 + 16 + 31) >> 5;
        const bf16_t* GW = (const bf16_t*)(ws + WS_W + (size_t)l * W_LSTRIDE + W_GWS);
        LAS float* TT = (LAS float*)(lds + TT_OFF);
#pragma unroll
        for (int hh = 0; hh < 2; ++hh) {
            const int h = 2 * hp + hh;
            f32x4 acc[4];
#pragma unroll
            for (int dt = 0; dt < 4; ++dt) acc[dt] = (f32x4){0.f, 0.f, 0.f, 0.f};
            for (int ks = 0; ks < nks; ++ks) {
                const bf16x8 af = *(const bf16x8*)(GW + ((size_t)h * 128 + tl0 + fr) * 128 + 32 * ks + 8 * fq);
#pragma unroll
                for (int dt = 0; dt < 4; ++dt) {
                    const bf16x8 bfr = *(const LAS bf16x8*)(VNT + (h * 64 + dt * 16 + fr) * VNT_P + 32 * ks + 8 * fq);
                    acc[dt] = __builtin_amdgcn_mfma_f32_16x16x32_bf16(af, bfr, acc[dt], 0, 0, 0);
                }
            }
#pragma unroll
            for (int dt = 0; dt < 4; ++dt)
#pragma unroll
                for (int j = 0; j < 4; ++j) {
                    const int tl = 16 * mt + 4 * fq + j, d = h * 64 + dt * 16 + fr;
                    const float bs = a->in[I_GBS][(l * 4 + h) * 128 + off + tl];
                    const float uu = bf2f(Z[(R0 + tl) * DIN + d]);
                    TT[tl * TT_P + d] = uu * (acc[dt][j] + bs);
                }
        }
        __syncthreads();
        tt_rows_out(lds, Y + R0 * DM + 0 * DG, mog + 0 * DG, wave, lane);
        __syncthreads();
    }
    if (MIXP & 2) {
        int lq_ = lane; asm volatile("" : "+v"(lq_)); const int lane = lq_; const int fr = lane & 15, fq = lane >> 4; (void)fr; (void)fq;
        LAS float* G = (LAS float*)lds; LAS float* CW = (LAS float*)(lds + CW_OFF);
        for (int rr = wave; rr < 94; rr += NWAVES) {
            const int t = t0 - 30 + rr; f32x4 gl = {0.f, 0.f, 0.f, 0.f};
            if (t >= 0) { const bf16_t* zr = Z + ((size_t)b * SEQ + t) * DIN; const f32x4 ga = ld_bf4(zr + 512 + 4 * lane), gg = ld_bf4(zr + 768 + 4 * lane);
#pragma unroll
                for (int i = 0; i < 4; ++i) gl[i] = ga[i] * sigmoidf_(gg[i]); }
            *(LAS f32x4*)(G + rr * 256 + 4 * lane) = gl;
            if (ju == 31 && rr >= 64) *(f32x4*)(a->out + O_GLUP + ((size_t)(l * NB + b) * 30 + (rr - 64)) * DG + 4 * lane) = gl;
        }
        for (int i = wave * 64 + lane; i < 31 * 64; i += NTHR) ((LAS f32x4*)CW)[i] = ((const f32x4*)(a->in[I_CDW] + (size_t)l * 31 * DG))[i];
        __syncthreads();
        f32x4 acc[8];
#pragma unroll
        for (int i = 0; i < 8; ++i) acc[i] = (f32x4){0.f, 0.f, 0.f, 0.f};
        f32x4 wj[8];
#pragma unroll
        for (int i = 0; i < 38; ++i) {
            const f32x4 g = *(const LAS f32x4*)(G + (8 * wave + i) * 256 + 4 * lane);
            if (i <= 30) wj[i & 7] = *(const LAS f32x4*)(CW + i * 256 + 4 * lane);
#pragma unroll
            for (int tt = 0; tt < 8; ++tt) { const int j = i - tt; if (j >= 0 && j <= 30) acc[tt] += wj[j & 7] * g; }
            if (i & 1) asm volatile("" ::: "memory");
        }
        const f32x4 cb = *(const f32x4*)(a->in[I_CDWB] + l * DG + 4 * lane), lg = *(const f32x4*)(a->in[I_CLNG] + l * DG + 4 * lane), lb = *(const f32x4*)(a->in[I_CLNB] + l * DG + 4 * lane);
        const f32x4 mg = *(const f32x4*)(mog + 1 * DG + 4 * lane);
#pragma unroll
        for (int tt = 0; tt < 8; ++tt) {
            const f32x4 x = acc[tt] + cb;
            const float mean = wave_sum(hsum4(x)) * (1.0f / DG); const f32x4 d = x - mean;
            const float rstd = rsqrtf(wave_sum(hsq4(d)) * (1.0f / DG) + EPS);
            f32x4 y = d * rstd * lg + lb;
#pragma unroll
            for (int i = 0; i < 4; ++i) y[i] = y[i] * sigmoidf_(y[i]);
            const float r = rsqrtf(wave_sum(hsq4(y)) * (1.0f / DG) + EPS);
            st_bf4(Y + (R0 + 8 * wave + tt) * DM + 1 * DG + 4 * lane, y * r * mg);
        }
        __syncthreads();
    }
    asm volatile("" ::: "memory");
    if (MIXP & 4) {
        int lq_ = lane; asm volatile("" : "+v"(lq_)); const int lane = lq_; const int fr = lane & 15, fq = lane >> 4; (void)fr; (void)fq;
        const float* sw = a->in[I_SCDW] + (size_t)l * 3 * DG;
        const f32x4 w0 = *(const f32x4*)(sw + 4 * lane), w1 = *(const f32x4*)(sw + DG + 4 * lane), w2 = *(const f32x4*)(sw + 2 * DG + 4 * lane);
        const f32x4 mg = *(const f32x4*)(mog + 2 * DG + 4 * lane);
        f32x4 s[10];
#pragma unroll
        for (int i = 0; i < 10; ++i) {
            const int t = t0 + 8 * wave - 2 + i; s[i] = (f32x4){0.f, 0.f, 0.f, 0.f};
            if (t >= 0) { const bf16_t* zr = Z + ((size_t)b * SEQ + t) * DIN; s[i] = ld_bf4(zr + 1280 + 4 * lane) * ld_bf4(zr + 1536 + 4 * lane); }
        }
#pragma unroll
        for (int tt = 0; tt < 8; ++tt) {
            const int tl = 8 * wave + tt;
            const f32x4 sb = ld_bf4(Z + (R0 + tl) * DIN + 1024 + 4 * lane);
            const f32x4 y = sb * (w0 * s[tt] + w1 * s[tt + 1] + w2 * s[tt + 2]);
            const float r = rsqrtf(wave_sum(hsq4(y)) * (1.0f / DG) + EPS);
            st_bf4(Y + (R0 + tl) * DM + 2 * DG + 4 * lane, y * r * mg);
            if (ju == 31 && tl >= 62) *(f32x4*)(a->out + O_SHP + ((size_t)(l * NB + b) * 2 + (tl - 62)) * DG + 4 * lane) = s[tt + 2];
        }
    }
    asm volatile("s_waitcnt vmcnt(0)" ::: "memory");
    if (MIXP & 8) {
        int lq_ = lane; asm volatile("" : "+v"(lq_)); const int lane = lq_; const int fr = lane & 15, fq = lane >> 4; (void)fr; (void)fq;
        LAS bf16_t* PL = (LAS bf16_t*)lds; LAS float* TT = (LAS float*)(lds + TT_OFF);
        const int g = lane >> 4, w = 2 << g;
        f32x4 px[23];
#pragma unroll
        for (int i = 0; i < 23; ++i) {
            const int t = t0 + 8 * wave - 15 + i; px[i] = (f32x4){0.f, 0.f, 0.f, 0.f};
            if (t >= 0) px[i] = ld_bf4(Z + ((size_t)b * SEQ + t) * DIN + 1792 + 4 * lane);
        }
#pragma unroll
        for (int tt = 0; tt < 8; ++tt) {
            const int tl = 8 * wave + tt, t = t0 + tl;
            f32x4 sum = {0.f, 0.f, 0.f, 0.f};
#pragma unroll
            for (int i = 0; i < 16; ++i) if (i < w) sum += px[15 + tt - i];
            const float cnt = (float)min(w, t + 1);
            const f32x4 pooled = sum / cnt - px[15 + tt];
            u32x2 pw; pw.x = pk2(pooled.x, pooled.y); pw.y = pk2(pooled.z, pooled.w);
            *(LAS u32x2*)(PL + tl * PL_P + 4 * lane) = pw;
            if (ju == 31 && tl >= 49) *(f32x4*)(a->out + O_PLP + ((size_t)(l * NB + b) * 15 + (tl - 49)) * DG + 4 * lane) = px[15 + tt];
        }
        __syncthreads();
        const int mt = wave & 3, gp = wave >> 2;
        const bf16_t* PWT = (const bf16_t*)(ws + WS_W + (size_t)l * W_LSTRIDE + W_PWT);
#pragma unroll
        for (int gg = 0; gg < 2; ++gg) {
            const int gi = 2 * gp + gg;
#pragma unroll
            for (int nt = 0; nt < 4; ++nt) {
                f32x4 acc = {0.f, 0.f, 0.f, 0.f};
#pragma unroll
                for (int ks = 0; ks < 2; ++ks) {
                    const bf16x8 af = *(const LAS bf16x8*)(PL + (16 * mt + fr) * PL_P + gi * 64 + 32 * ks + 8 * fq);
                    const bf16x8 bfr = *(const bf16x8*)(PWT + ((size_t)gi * 64 + 16 * nt + fr) * 64 + 32 * ks + 8 * fq);
                    acc = __builtin_amdgcn_mfma_f32_16x16x32_bf16(af, bfr, acc, 0, 0, 0);
                }
                const int d = gi * 64 + 16 * nt + fr; const float sc = a->in[I_PSC][l * DG + d];
#pragma unroll
                for (int j = 0; j < 4; ++j) TT[(16 * mt + 4 * fq + j) * TT_P + d] = acc[j] * sc;
            }
        }
        __syncthreads();
        tt_rows_out(lds, Y + R0 * DM + 3 * DG, mog + 3 * DG, wave, lane);
        __syncthreads();
    }
}

DI void mixer_sample(AP a, int l, int bs, LAS unsigned char* lds, int wave, int lane) {
    unsigned char* ws = a->ws;
    const float* z = (const float*)(ws + WS_ZS) + ((size_t)l * NS + bs) * DIN;
    const float zrs = rsqrtf(((const float*)(ws + WS_SSQ))[(l * 3 + 0) * NS + bs] * (1.0f / DM) + EPS);
    float* ys = (float*)(ws + WS_YS) + (size_t)bs * DM;
    const float* mog = a->in[I_MOG] + l * DM;
    const int c4 = 4 * lane;
    {
        const f32x4 u = *(const f32x4*)(z + c4) * zrs, v = *(const f32x4*)(z + 256 + c4) * zrs;
        const f32x4 lg = *(const f32x4*)(a->in[I_LNG] + l * DG + c4), lb = *(const f32x4*)(a->in[I_LNB] + l * DG + c4);
        const float mean = wave_sum(hsum4(v)) * (1.0f / DG); const f32x4 d = v - mean;
        const float rstd = rsqrtf(wave_sum(hsq4(d)) * (1.0f / DG) + EPS);
        const f32x4 vn = d * rstd * lg + lb;
        *(f32x4*)(a->out + O_GV + ((size_t)l * NS + bs) * DG + c4) = vn;
        const int h = lane >> 4;
        const float w00 = a->in[I_GWS][((size_t)(l * 4 + h) * 128) * 128], b0 = a->in[I_GBS][(l * 4 + h) * 128];
        const f32x4 y = u * (vn * w00 + b0);
        const float r = rsqrtf(wave_sum(hsq4(y)) * (1.0f / DG) + EPS);
        *(f32x4*)(ys + c4) = y * r * *(const f32x4*)(mog + c4);
    }
    {
        const f32x4 ga = *(const f32x4*)(z + 512 + c4) * zrs, gg = *(const f32x4*)(z + 768 + c4) * zrs;
        f32x4 glu;
#pragma unroll
        for (int i = 0; i < 4; ++i) glu[i] = ga[i] * sigmoidf_(gg[i]);
        const float* st = a->in[I_SGLU] + ((size_t)(l * NS + bs) * 30) * DG + c4;
        float* so = a->out + O_GLUS + ((size_t)(l * NS + bs) * 30) * DG + c4;
        const float* cw = a->in[I_CDW] + (size_t)l * 31 * DG + c4;
        f32x4 acc = *(const f32x4*)(cw + 30 * DG) * glu;
#pragma unroll 6
        for (int j = 0; j < 30; ++j) { const f32x4 sv = *(const f32x4*)(st + j * DG); acc += *(const f32x4*)(cw + j * DG) * sv; if (j >= 1) *(f32x4*)(so + (j - 1) * DG) = sv; }
        *(f32x4*)(so + 29 * DG) = glu;
        const f32x4 x = acc + *(const f32x4*)(a->in[I_CDWB] + l * DG + c4);
        const float mean = wave_sum(hsum4(x)) * (1.0f / DG); const f32x4 d = x - mean;
        const float rstd = rsqrtf(wave_sum(hsq4(d)) * (1.0f / DG) + EPS);
        f32x4 y = d * rstd * *(const f32x4*)(a->in[I_CLNG] + l * DG + c4) + *(const f32x4*)(a->in[I_CLNB] + l * DG + c4);
#pragma unroll
        for (int i = 0; i < 4; ++i) y[i] = y[i] * sigmoidf_(y[i]);
        const float r = rsqrtf(wave_sum(hsq4(y)) * (1.0f / DG) + EPS);
        *(f32x4*)(ys + DG + c4) = y * r * *(const f32x4*)(mog + DG + c4);
    }
    {
        const f32x4 sb = *(const f32x4*)(z + 1024 + c4) * zrs, s = (*(const f32x4*)(z + 1280 + c4) * zrs) * (*(const f32x4*)(z + 1536 + c4) * zrs);
        const float* st = a->in[I_SSH] + ((size_t)(l * NS + bs) * 2) * DG + c4;
        float* so = a->out + O_SHS + ((size_t)(l * NS + bs) * 2) * DG + c4;
        const float* sw = a->in[I_SCDW] + (size_t)l * 3 * DG + c4;
        const f32x4 s0 = *(const f32x4*)st, s1 = *(const f32x4*)(st + DG);
        const f32x4 y = sb * (*(const f32x4*)sw * s0 + *(const f32x4*)(sw + DG) * s1 + *(const f32x4*)(sw + 2 * DG) * s);
        *(f32x4*)so = s1; *(f32x4*)(so + DG) = s;
        const float r = rsqrtf(wave_sum(hsq4(y)) * (1.0f / DG) + EPS);
        *(f32x4*)(ys + 2 * DG + c4) = y * r * *(const f32x4*)(mog + 2 * DG + c4);
    }
    {
        const f32x4 px = *(const f32x4*)(z + 1792 + c4) * zrs;
        const float* st = a->in[I_SPL] + ((size_t)(l * NS + bs) * 15) * DG + c4;
        float* so = a->out + O_PLS + ((size_t)(l * NS + bs) * 15) * DG + c4;
        const int g = lane >> 4, w = 2 << g;
        f32x4 sum = px;
#pragma unroll
        for (int j = 0; j < 15; ++j) { const f32x4 sv = *(const f32x4*)(st + j * DG); if (15 - j < w) sum += sv; if (j >= 1) *(f32x4*)(so + (j - 1) * DG) = sv; }
        *(f32x4*)(so + 14 * DG) = px;
        const f32x4 pooled = sum / (float)w - px;
        LAS float* PLs = (LAS float*)(lds + wave * 1024);
        *(LAS f32x4*)(PLs + c4) = pooled;
        asm volatile("s_waitcnt lgkmcnt(0)" ::: "memory");
        const float* pw = a->in[I_PW] + (size_t)l * 16384 + (size_t)g * 4096 + 4 * (lane & 15);
        f32x4 acc = {0.f, 0.f, 0.f, 0.f};
#pragma unroll 8
        for (int c = 0; c < 64; ++c) acc += *(const f32x4*)(pw + c * 64) * PLs[g * 64 + c];
        const f32x4 y = acc * *(const f32x4*)(a->in[I_PSC] + l * DG + c4);
        const float r = rsqrtf(wave_sum(hsq4(y)) * (1.0f / DG) + EPS);
        *(f32x4*)(ys + 3 * DG + c4) = y * r * *(const f32x4*)(mog + 3 * DG + c4);
        asm volatile("s_waitcnt lgkmcnt(0)" ::: "memory");
    }
}

DI void attn_unit(AP a, int l, int uidx, int wave, int lane) {
    unsigned char* ws = a->ws;
    const int b = uidx >> 5, h = (uidx >> 3) & 3, qt = uidx & 7;
    const int r32 = lane & 31, hi = lane >> 5;
    const size_t q0 = (size_t)b * SEQ + qt * 256 + 32 * wave;
    const bf16_t* Qp = (const bf16_t*)(ws + WS_Q) + (q0 + r32) * DM + h * 256 + 8 * hi;
    const bf16_t* Kp = (const bf16_t*)(ws + WS_KP) + ((size_t)l * MM + b * 256 + r32) * DM + h * 256 + 8 * hi;
    const bf16_t* Vp = (const bf16_t*)(ws + WS_VT) + ((size_t)((l * NB + b) * 4 + h) * 256 + r32) * 256 + 4 * hi;
    bf16x8 qf[16];
#pragma unroll
    for (int ks = 0; ks < 16; ++ks) qf[ks] = *(const bf16x8*)(Qp + 16 * ks);
    f32x16 S[8];
#pragma unroll
    for (int kt = 0; kt < 8; ++kt) {
#pragma unroll
        for (int i = 0; i < 16; ++i) S[kt][i] = 0.f;
#pragma unroll
        for (int ks = 0; ks < 16; ++ks) {
            const bf16x8 kf = *(const bf16x8*)(Kp + (size_t)kt * 32 * DM + 16 * ks);
            S[kt] = __builtin_amdgcn_mfma_f32_32x32x16_bf16(kf, qf[ks], S[kt], 0, 0, 0);
        }
    }
    float mx = -3.0e38f;
#pragma unroll
    for (int kt = 0; kt < 8; ++kt)
#pragma unroll
        for (int i = 0; i < 16; ++i) mx = fmaxf(mx, S[kt][i]);
    mx = fmaxf(mx, __shfl_xor(mx, 32));
    float sum = 0.f; const float mxl = mx * 1.4426950408889634f;
#pragma unroll
    for (int kt = 0; kt < 8; ++kt)
#pragma unroll
        for (int i = 0; i < 16; ++i) { const float p = exp2f(S[kt][i] * 1.4426950408889634f - mxl); S[kt][i] = p; sum += p; }
    sum += __shfl_xor(sum, 32);
    const float inv = 1.0f / sum;
    bf16x8 pf[16];
#pragma unroll
    for (int kt = 0; kt < 8; ++kt)
#pragma unroll
        for (int c = 0; c < 2; ++c) {
            u32x4 p; p.x = pk2(S[kt][8 * c + 0], S[kt][8 * c + 1]); p.y = pk2(S[kt][8 * c + 2], S[kt][8 * c + 3]); p.z = pk2(S[kt][8 * c + 4], S[kt][8 * c + 5]); p.w = pk2(S[kt][8 * c + 6], S[kt][8 * c + 7]);
            pf[2 * kt + c] = __builtin_bit_cast(bf16x8, p);
        }
    bf16_t* Op = (bf16_t*)(ws + WS_O) + (q0 + r32) * DM + h * 256 + 4 * hi;
#pragma unroll
    for (int dt = 0; dt < 8; ++dt) {
        f32x16 o;
#pragma unroll
        for (int i = 0; i < 16; ++i) o[i] = 0.f;
#pragma unroll
        for (int kc = 0; kc < 16; ++kc) {
            const bf16_t* vp = Vp + (size_t)dt * 32 * 256 + 16 * kc;
            const u32x2 v0 = *(const u32x2*)vp, v1 = *(const u32x2*)(vp + 8);
            u32x4 vv; vv.x = v0.x; vv.y = v0.y; vv.z = v1.x; vv.w = v1.y;
            o = __builtin_amdgcn_mfma_f32_32x32x16_bf16(__builtin_bit_cast(bf16x8, vv), pf[kc], o, 0, 0, 0);
        }
#pragma unroll
        for (int rg = 0; rg < 4; ++rg) {
            u32x2 w; w.x = pk2(o[4 * rg] * inv, o[4 * rg + 1] * inv); w.y = pk2(o[4 * rg + 2] * inv, o[4 * rg + 3] * inv);
            *(u32x2*)(Op + 32 * dt + 8 * rg) = w;
        }
    }
}

DI void attn_sample_unit(AP a, int l, int uidx, LAS unsigned char* lds, int wave, int lane) {
    unsigned char* ws = a->ws;
    const int bs = uidx >> 1, hp = uidx & 1;
    LAS float* SC = (LAS float*)lds;
    LAS float* RED = (LAS float*)(lds + 4096);
    const float* qp = (const float*)(ws + WS_QS) + ((size_t)l * NS + bs) * DM + hp * 512 + 8 * lane;
    const float qrs = 0.0625f * rsqrtf(((const float*)(ws + WS_SSQ))[(l * 3 + 1) * NS + bs] * (1.0f / DM) + EPS);
    const f32x4 q0 = *(const f32x4*)qp * qrs, q1 = *(const f32x4*)(qp + 4) * qrs;
    const float* Kb = a->in[I_CK] + ((size_t)(l * NS + bs) * MEM) * DM + hp * 512 + 8 * lane;
    const float* Vb = a->in[I_CV] + ((size_t)(l * NS + bs) * MEM) * DM + hp * 512 + 8 * lane;
#pragma unroll 8
    for (int mi = 0; mi < 32; ++mi) {
        const int m = wave + 8 * mi;
        const f32x4 k0 = *(const f32x4*)(Kb + (size_t)m * DM), k1 = *(const f32x4*)(Kb + (size_t)m * DM + 4);
        float d = hsum4(k0 * q0) + hsum4(k1 * q1);
        d += __shfl_xor(d, 1); d += __shfl_xor(d, 2); d += __shfl_xor(d, 4); d += __shfl_xor(d, 8); d += __shfl_xor(d, 16);
        if ((lane & 31) == 0) SC[(lane >> 5) * 256 + m] = d;
    }
    __syncthreads();
    if (wave < 2) {
        const f32x4 v = *(const LAS f32x4*)(SC + wave * 256 + 4 * lane);
        float mx = fmaxf(fmaxf(v.x, v.y), fmaxf(v.z, v.w));
#pragma unroll
        for (int o = 1; o < 64; o <<= 1) mx = fmaxf(mx, __shfl_xor(mx, o));
        f32x4 e; e.x = __expf(v.x - mx); e.y = __expf(v.y - mx); e.z = __expf(v.z - mx); e.w = __expf(v.w - mx);
        const float inv = 1.0f / wave_sum(hsum4(e));
        *(LAS f32x4*)(SC + wave * 256 + 4 * lane) = e * inv;
    }
    __syncthreads();
    f32x4 o0 = {0.f, 0.f, 0.f, 0.f}, o1 = {0.f, 0.f, 0.f, 0.f};
#pragma unroll 8
    for (int mi = 0; mi < 32; ++mi) {
        const int m = wave + 8 * mi;
        const f32x4 v0 = *(const f32x4*)(Vb + (size_t)m * DM), v1 = *(const f32x4*)(Vb + (size_t)m * DM + 4);
        const float p = SC[(lane >> 5) * 256 + m];
        o0 += v0 * p; o1 += v1 * p;
    }
    *(LAS f32x4*)(RED + wave * 512 + 8 * lane) = o0; *(LAS f32x4*)(RED + wave * 512 + 8 * lane + 4) = o1;
    __syncthreads();
    {
        const int t = wave * 64 + lane; float s = 0.f;
#pragma unroll
        for (int w = 0; w < 8; ++w) s += RED[w * 512 + t];
        ((float*)(ws + WS_OS))[(size_t)bs * DM + hp * 512 + t] = s;
    }
    __syncthreads();
}


#define XB_TMO      128
#define XB_XCNT(j)  (256  + 64 * (j))
#define XB_XSUB(j)  (1280 + 64 * (j))
#define XB_XGEN(j)  (2304 + 64 * (j))
#define XB_TOP      3328
#define XB_TOPGEN   3392
#define XCD_BAR_WORDS 3456
#define XB_SPIN_CAP (1u << 18)
DI unsigned xb_ld(unsigned* p)              { return __hip_atomic_load(p, __ATOMIC_RELAXED, __HIP_MEMORY_SCOPE_AGENT); }
DI unsigned xb_add(unsigned* p, unsigned v) { return __hip_atomic_fetch_add(p, v, __ATOMIC_RELAXED, __HIP_MEMORY_SCOPE_AGENT); }
DI unsigned xb_xcc_id() { return (unsigned)__builtin_amdgcn_s_getreg((3 << 11) | 20) & 0xFu; }
#define XB_SPIN(cond, bar) do { unsigned _sp = 0; while (cond) { __builtin_amdgcn_s_sleep(1); \
    if ((++_sp & 255u) == 0u) { if (xb_ld(&(bar)[XB_TMO])) break; if (_sp > XB_SPIN_CAP) { atomicAdd(&(bar)[XB_TMO], 1u); break; } } } } while (0)
struct XcdBarrier { unsigned* bar; unsigned x; volatile LAS unsigned* st; };
DI XcdBarrier xcd_barrier_post(unsigned* bar, volatile LAS unsigned* st) {
    XcdBarrier b; b.bar = bar; b.x = xb_xcc_id(); b.st = st;
    if (threadIdx.x == 0) (void)xb_add(&bar[XB_XCNT(b.x)], 1u);
    return b;
}
DI void xcd_barrier_complete(unsigned* bar, unsigned x, unsigned& nloc, unsigned& nx) {
    const unsigned G = gridDim.x * gridDim.y * gridDim.z;
    unsigned sum, cnt, mine, sp = 0u;
    for (;;) {
        sum = 0u; cnt = 0u; mine = 0u;
#pragma unroll
        for (unsigned j = 0; j < 16; ++j) { const unsigned c = xb_ld(&bar[XB_XCNT(j)]); sum += c; cnt += (c > 0u) ? 1u : 0u; mine = (j == x) ? c : mine; }
        if (sum == G) break;
        __builtin_amdgcn_s_sleep(1);
        if ((++sp & 255u) == 0u) { if (xb_ld(&bar[XB_TMO])) break; if (sp > XB_SPIN_CAP) { atomicAdd(&bar[XB_TMO], 1u); break; } }
    }
    nloc = mine > 0u ? mine : 1u; nx = cnt > 0u ? cnt : 1u;
}
DI void xcd_barrier(const XcdBarrier& b) {
    asm volatile("s_waitcnt vmcnt(0)" ::: "memory");
    __syncthreads();
    if (threadIdx.x == 0) {
        unsigned* bar = b.bar;
        __builtin_amdgcn_s_waitcnt(0);
        unsigned nloc = b.st[0], nx = b.st[1];
        if (nloc == 0u) { xcd_barrier_complete(bar, b.x, nloc, nx); b.st[0] = nloc; b.st[1] = nx; }
        const unsigned old = xb_add(&bar[XB_XSUB(b.x)], 1u);
        const unsigned gen = old / nloc;
        if (old + 1u == (gen + 1u) * nloc) {
            __builtin_amdgcn_fence(__ATOMIC_RELEASE, "agent");
            asm volatile("s_waitcnt vmcnt(0)" ::: "memory");
            const unsigned og = xb_add(&bar[XB_TOP], 1u);
            const unsigned tg = og / nx;
            if (og + 1u == (tg + 1u) * nx) xb_add(&bar[XB_TOPGEN], 1u);
            else XB_SPIN(xb_ld(&bar[XB_TOPGEN]) == tg, bar);
            __builtin_amdgcn_fence(__ATOMIC_ACQUIRE, "agent");
            xb_add(&bar[XB_XGEN(b.x)], 1u);
            asm volatile("s_waitcnt vmcnt(0)" ::: "memory");
        } else {
            XB_SPIN(xb_ld(&bar[XB_XGEN(b.x)]) == gen, bar);
            __builtin_amdgcn_fence(__ATOMIC_ACQUIRE, "agent");
            asm volatile("s_waitcnt vmcnt(0)" ::: "memory");
        }
    }
    __syncthreads();
}

#ifndef PMASK
#define PMASK 0xffff
#endif
#ifndef DUPMASK
#define DUPMASK 0
#endif
constexpr int N_PHASES = 18;
__global__ void __launch_bounds__(NTHR, 2) fwd_kernel(Args a_) {
    extern __shared__ __attribute__((aligned(16))) unsigned char lds_raw[];
    LAS unsigned char* lds = (LAS unsigned char*)lds_raw;
    cg::grid_group grid = cg::this_grid();
    volatile LAS unsigned* MISC = (volatile LAS unsigned*)(lds + LDS_BYTES - 256);
    if (threadIdx.x < 32) MISC[threadIdx.x] = 0u;
    __syncthreads();
    const XcdBarrier xbar = xcd_barrier_post((unsigned*)(a_.ws + WS_CTL), MISC + 8);
    const int ph_lo = a_.ph_lo, ph_hi = a_.ph_hi;
    for (int ph = ph_lo; ph < ph_hi; ++ph) {
        AP a = (AP)__builtin_amdgcn_kernarg_segment_ptr();
        asm volatile("" : "+s"(a));
        int tid = threadIdx.x; asm volatile("" : "+v"(tid));
        const int lane = tid & 63, wave = __builtin_amdgcn_readfirstlane(tid >> 6);
        int bx = blockIdx.x; asm volatile("" : "+s"(bx));
        const int G = gridDim.x;
        unsigned char* ws = a->ws;
        bf16_t* XB = (bf16_t*)(ws + WS_XB); float* SS = (float*)(ws + WS_SS); float* XF = a->out + O_YP;
        float* XS = (float*)(ws + WS_XS); float* YS = (float*)(ws + WS_YS); float* OS = (float*)(ws + WS_OS);
        if (ph == 0) {
            if (PMASK & 1) prologue(a, lds, wave, lane);
        } else if (ph == N_PHASES - 1) { if (PMASK & 2) {
            const int gw = bx * NWAVES + wave, NGW = G * NWAVES;
            const float* gf = a->in[I_NFIN];
            for (int m = gw; m < MP + NS; m += NGW) {
                if (m < MP) {
                    const float rs = row_rs(SS + (size_t)m * 16); f32x4* xr = (f32x4*)(XF + (size_t)m * DM) + lane;
#pragma unroll
                    for (int j = 0; j < 4; ++j) xr[64 * j] = xr[64 * j] * rs * ((const f32x4*)gf)[lane + 64 * j];
                } else {
                    const int s = m - MP; const f32x4* xr = (const f32x4*)(XS + (size_t)s * DM) + lane; f32x4 v[4]; float sq = 0.f;
#pragma unroll
                    for (int j = 0; j < 4; ++j) { v[j] = xr[64 * j]; sq += hsq4(v[j]); }
                    const float rs = rsqrtf(wave_sum(sq) * (1.0f / DM) + EPS);
                    f32x4* yo = (f32x4*)(a->out + O_YS + (size_t)s * DM) + lane;
#pragma unroll
                    for (int j = 0; j < 4; ++j) yo[64 * j] = v[j] * rs * ((const f32x4*)gf)[lane + 64 * j];
                }
            }
        } } else {
            const int l = (ph - 1) >> 3, sub = (ph - 1) & 7;
            unsigned char* wl = ws + WS_W + (size_t)l * W_LSTRIDE;
            pg8::StaticOrder S;
            if (sub == 0) { if (PMASK & 4) {
                { pg8::Gemm g{XB, (const bf16_t*)(wl + W_IN), MP, DIN, DM}; S.init(MP, DIN, G, bx);
                  EpiScale<0> E{(bf16_t*)(ws + WS_Z), DIN, SS};
                  pg8::gemm_phase<EpiScale<0>, pg8::StaticOrder, true, true>(lds, g, S, E); }
                if (l == 0) { pg8::Gemm g{(const bf16_t*)(ws + WS_MEMB), (const bf16_t*)(ws + WS_WKV), MM, 4096, DM}; S.init(MM, 4096, G, bx);
                  EpiKV E{(const float*)(ws + WS_MEMSS), a->out + O_MK, a->out + O_MV, (bf16_t*)(ws + WS_KP), (bf16_t*)(ws + WS_VT)};
                  pg8::gemm_phase<EpiKV, pg8::StaticOrder, true, true>(lds, g, S, E); }
                sgemm_phase<0, true>(XS, DM, (const bf16_t*)(wl + W_IN), DIN, (float*)(ws + WS_ZS) + (size_t)l * NS * DIN, nullptr, (float*)(ws + WS_SSQ) + (l * 3 + 0) * NS, bx, G, wave, lane);
            } } else if (sub == 1) {
                for (int rep = 0; rep < ((DUPMASK & 4) ? 2 : 1); ++rep) for (int u = bx; u < 256; u += G) mixer_unit(a, l, u, lds, wave, lane);
                { const int gwr = (G - 1 - bx) * NWAVES + wave; if ((PMASK & 16) && gwr < NS) mixer_sample(a, l, gwr, lds, wave, lane); }
            } else if (sub == 2 || sub == 5 || sub == 7) { if (PMASK & 32) {
                const bf16_t* A = (const bf16_t*)(ws + (sub == 2 ? WS_Y : sub == 5 ? WS_O : WS_H));
                const bf16_t* Bt = (const bf16_t*)(wl + (sub == 2 ? W_OUT : sub == 5 ? W_O : W_F2));
                const int K = sub == 7 ? DFF : DM;
                pg8::Gemm g{A, Bt, MP, DM, K}; S.init(MP, DM, G, bx);
                EpiRes E{(l == 0 && sub == 2) ? a->in[I_XP] : XF, XF, XB, SS};
                pg8::gemm_phase<EpiRes, pg8::StaticOrder, true, true>(lds, g, S, E);
                if (sub == 7) sgemm_phase<1, false>((const float*)(ws + WS_HS) + (size_t)l * NS * DFF, DFF, Bt, DM, XS, (const float*)(ws + WS_SSQ) + (l * 3 + 2) * NS, nullptr, bx, G, wave, lane);
                else sgemm_phase<0, false>(sub == 2 ? YS : OS, DM, Bt, DM, XS, nullptr, nullptr, bx, G, wave, lane);
            } } else if (sub == 3) { if (PMASK & 64) {
                pg8::Gemm g{XB, (const bf16_t*)(wl + W_Q), MP, DM, DM}; S.init(MP, DM, G, bx);
                EpiScale<1> E{(bf16_t*)(ws + WS_Q), DM, SS};
                pg8::gemm_phase<EpiScale<1>, pg8::StaticOrder, true, true>(lds, g, S, E);
                sgemm_phase<0, true>(XS, DM, (const bf16_t*)(wl + W_Q), DM, (float*)(ws + WS_QS) + (size_t)l * NS * DM, nullptr, (float*)(ws + WS_SSQ) + (l * 3 + 1) * NS, bx, G, wave, lane);
            } } else if (sub == 4) {
                for (int rep = 0; rep < ((DUPMASK & 1) ? 2 : 1); ++rep) for (int u = bx; u < 256; u += G) attn_unit(a, l, u, wave, lane);
                for (int rep = 0; rep < ((DUPMASK & 2) ? 2 : 1); ++rep) for (int u = bx; u < 256; u += G) attn_sample_unit(a, l, u, lds, wave, lane);
            } else { if (PMASK & 512) {
                pg8::Gemm g{XB, (const bf16_t*)(wl + W_F1), MP, DFF, DM}; S.init(MP, DFF, G, bx);
                EpiScale<2> E{(bf16_t*)(ws + WS_H), DFF, SS};
                for (int rep = 0; rep < ((DUPMASK & 32) ? 2 : 1); ++rep) pg8::gemm_phase<EpiScale<2>, pg8::StaticOrder, true, true>(lds, g, S, E);
                sgemm_phase<0, true>(XS, DM, (const bf16_t*)(wl + W_F1), DFF, (float*)(ws + WS_HS) + (size_t)l * NS * DFF, nullptr, (float*)(ws + WS_SSQ) + (l * 3 + 2) * NS, bx, G, wave, lane);
            } }
        }
        if (ph + 1 < ph_hi) { if (ph >= N_PHASES) grid.sync();   else xcd_barrier(xbar); }
    }
}

#ifndef N_LAUNCH_MODE
#define N_LAUNCH_MODE 1
#endif
extern "C" void kernel_launch(void* const* d_in, const int* in_sizes, int n_in, void* d_out, int out_size, void* d_ws, size_t ws_size, hipStream_t stream) {
    static int grid = 0;
    if (grid == 0) {
        if (n_in != N_IN || (size_t)out_size != O_END || ws_size < WS_END + 2 * MiB) { fprintf(stderr, "kernel_launch: unexpected sizes n_in %d out %d ws %zu\n", n_in, out_size, ws_size); grid = -1; return; }
        int dev = 0, cus = 0, per_cu = 0;
        if (hipGetDevice(&dev) != hipSuccess || hipDeviceGetAttribute(&cus, hipDeviceAttributeMultiprocessorCount, dev) != hipSuccess) { grid = -1; return; }
        if (hipFuncSetAttribute((const void*)fwd_kernel, hipFuncAttributeMaxDynamicSharedMemorySize, LDS_BYTES) != hipSuccess) { fprintf(stderr, "kernel_launch: hipFuncSetAttribute failed\n"); grid = -1; return; }
        if (hipOccupancyMaxActiveBlocksPerMultiprocessor(&per_cu, (const void*)fwd_kernel, NTHR, LDS_BYTES) != hipSuccess || per_cu < 1) { fprintf(stderr, "kernel_launch: occupancy query says %d\n", per_cu); per_cu = 1; }
        (void)hipGetLastError();
        grid = cus;
    }
    if (grid < 0) return;
    if (hipMemsetAsync((char*)d_ws + WS_CTL, 0, CTL_ZERO_BYTES, stream) != hipSuccess) { fprintf(stderr, "kernel_launch: memset failed\n"); return; }
    Args a{};
    for (int i = 0; i < N_IN; ++i) a.in[i] = (const float*)d_in[i];
    a.out = (float*)d_out; a.ws = (unsigned char*)d_ws;
#if N_LAUNCH_MODE == 1
    a.ph_lo = 0; a.ph_hi = N_PHASES;
    void* args[] = {&a};
    hipError_t e = hipLaunchCooperativeKernel((const void*)fwd_kernel, dim3(grid), dim3(NTHR), args, LDS_BYTES, stream);
    if (e != hipSuccess) fprintf(stderr, "cooperative launch failed: %s (grid %d)\n", hipGetErrorString(e), grid);
#else
    for (int ph = 0; ph < N_PHASES; ++ph) {
        a.ph_lo = ph; a.ph_hi = ph + 1;
        hipLaunchKernelGGL(fwd_kernel, dim3(grid), dim3(NTHR), LDS_BYTES, stream, a);
    }
#endif
}
```

```cpp
#define DUPMASK 0
#include <hip/hip_runtime.h>
#include <hip/hip_cooperative_groups.h>
#include <cstdio>
#include <cstdint>
namespace cg = cooperative_groups;
namespace pg8 {
#define PG8_LAS __attribute__((address_space(3)))
typedef unsigned short bf16_t;
typedef short bf16x8 __attribute__((ext_vector_type(8)));
typedef float f32x4 __attribute__((ext_vector_type(4)));
typedef unsigned u32x4 __attribute__((ext_vector_type(4)));
constexpr int BM = 256, BK = 64, HALF = 128, HTB = HALF * BK * 2  , STAGE_BYTES = 8 * HTB, NXCD = 8, WGM = 8;

__host__ __device__ __forceinline__ int lds_byte(int r, int c) { const int st = (r >> 4) * 2 + (c >> 5), rr = r & 15, cc = c & 31, ob = rr * 64 + cc * 2; return st * 1024 + (ob ^ (((ob >> 9) & 1) << 5)); }
__host__ __device__ __forceinline__ void stage_rc(int b, int& R, int& C) { const int st = b / 1024, sb = b % 1024, swz = sb ^ (((sb >> 9) & 1) << 5); R = (st >> 1) * 16 + swz / 64; C = (st & 1) * 32 + (swz % 64) / 2; }
__host__ __device__ __forceinline__ int perm32(int rho) { const int n = rho >> 4, i = rho & 15; return 8 * (i >> 2) + 4 * n + (i & 3); }

struct Unit { int pm, pn; };
struct Gemm { const bf16_t* A; const bf16_t* Bt; int M, N, K; };

struct StaticOrder {
    int nM, nN, nwg, G, c;
    __host__ __device__ void init(int M, int N, int G_, int c_) { nM = M / BM; nN = N / BM; nwg = nM * nN; G = G_; c = c_; }
    __host__ __device__ bool next(int i, Unit& u) const {
        const long L = (long)i * G + c; if (L >= nwg) return false;
        int wgid = (int)L; { const int q = nwg / NXCD, r = nwg % NXCD, xcd = wgid % NXCD, off = wgid / NXCD; wgid = (xcd < r ? xcd * (q + 1) : r * (q + 1) + (xcd - r) * q) + off; }
        const int nig = WGM * nN, gid = wgid / nig, fm = gid * WGM, gsz = (nM - fm) < WGM ? (nM - fm) : WGM;
        u.pm = fm + ((wgid % nig) % gsz); u.pn = (wgid % nig) / gsz; return true;
    }
    __device__ __forceinline__ void a_ready(const Unit&) const {}
    __device__ __forceinline__ void done(const Unit&) const {}
};

__device__ __forceinline__ unsigned cvt_pk_bf16(float lo, float hi) { unsigned r; asm volatile("v_cvt_pk_bf16_f32 %0, %1, %2" : "=v"(r) : "v"(lo), "v"(hi)); return r; }
typedef float f32x2 __attribute__((ext_vector_type(2)));
template <class Epi, class Sched, bool ALIGN_EPI = false, bool SP2 = false>
__device__ __forceinline__ void gemm_phase(PG8_LAS unsigned char* lds, const Gemm g, const Sched& S, const Epi& E) {
    int tid = threadIdx.x; asm volatile("" : "+v"(tid)); const int wid = __builtin_amdgcn_readfirstlane(tid >> 6), lane = tid & 63, wr = wid >> 2, wc = wid & 3, fr = lane & 15, fq = lane >> 4;
    const int K = g.K, nt = K / BK;
    unsigned voffA[2], voffB[2];
#pragma unroll
    for (int i = 0; i < 2; ++i) { int R, C; stage_rc(tid * 16 + i * 8192, R, C); const int Rb = Epi::PERM ? ((R & ~31) + perm32(R & 31)) : R;
        voffA[i] = (unsigned)(R * K + C) * 2u; voffB[i] = (unsigned)(Rb * K + C) * 2u; }
    const size_t kstep = (size_t)(BK * 2);
    const size_t hstep = (size_t)HALF * K * 2;
    const size_t tstep = 2 * hstep;
    const unsigned ldsw = (unsigned)wid * 1024u;
    const int aoff = lds_byte(wr * 64 + fr, fq * 8), boff = lds_byte(wc * 32 + fr, fq * 8);
#define PG8_SA(b, h) (((b) * 2 + (h)) * HTB)
#define PG8_SB(b, h) ((4 + (b) * 2 + (h)) * HTB)
#define PG8_STAGE(bufoff, gbase, voff) do { _Pragma("unroll") for (int _i = 0; _i < 2; ++_i) \
        __builtin_amdgcn_global_load_lds((const unsigned*)((const char*)(gbase) + (voff)[_i]), (PG8_LAS unsigned*)(lds + (bufoff) + ldsw + _i * 8192), 16, 0, 0); } while (0)
#define PG8_LDA(dst, b, h) do { _Pragma("unroll") for (int m = 0; m < 4; ++m) _Pragma("unroll") for (int k = 0; k < 2; ++k) dst[m][k] = *(const PG8_LAS bf16x8*)(lds + PG8_SA(b, h) + aoff + m * 2048 + k * 1024); } while (0)
#define PG8_LDB(dst, b, h) do { _Pragma("unroll") for (int n = 0; n < 2; ++n) _Pragma("unroll") for (int k = 0; k < 2; ++k) dst[n][k] = *(const PG8_LAS bf16x8*)(lds + PG8_SB(b, h) + boff + n * 2048 + k * 1024); } while (0)
#define PG8_MMA(ai, bj, At, Bt) do { __builtin_amdgcn_s_setprio(1); _Pragma("unroll") for (int m = 0; m < 4; ++m) _Pragma("unroll") for (int n = 0; n < 2; ++n) _Pragma("unroll") for (int k = 0; k < 2; ++k) \
        acc[ai][bj][m][n] = __builtin_amdgcn_mfma_f32_16x16x32_bf16(Bt[n][k], At[m][k], acc[ai][bj][m][n], 0, 0, 0); __builtin_amdgcn_s_setprio(0); } while (0)
#define PG8_WAIT_V(n) asm volatile("s_waitcnt vmcnt(" #n ")" ::: "memory")
#define PG8_WAIT_L(n) asm volatile("s_waitcnt lgkmcnt(" #n ")" ::: "memory")
#define PG8_BAR __builtin_amdgcn_s_barrier()
#define PG8_SCHED __builtin_amdgcn_sched_barrier(0)
    Unit cur, nxt; int ui = 0;
    if (!S.next(0, cur)) return;
    f32x4 acc[2][2][4][2];
#pragma unroll
    for (int a = 0; a < 2; ++a)
#pragma unroll
        for (int b = 0; b < 2; ++b)
#pragma unroll
            for (int m = 0; m < 4; ++m)
#pragma unroll
                for (int n = 0; n < 2; ++n) acc[a][b][m][n] = (f32x4){0.f, 0.f, 0.f, 0.f};
    bf16x8 At[4][2], B0[2][2], B1[2][2];
    const char* cA = (const char*)g.A + (size_t)cur.pm * tstep; const char* cB = (const char*)g.Bt + (size_t)cur.pn * tstep;
    S.a_ready(cur);
    if constexpr (SP2) {
        PG8_STAGE(PG8_SB(0, 0), cB, voffB); PG8_STAGE(PG8_SB(0, 1), cB + hstep, voffB); PG8_STAGE(PG8_SA(0, 0), cA, voffA); PG8_STAGE(PG8_SA(0, 1), cA + hstep, voffA);
        if (wr == 1) PG8_BAR;
        PG8_WAIT_V(2); PG8_BAR;
        PG8_STAGE(PG8_SB(1, 0), cB + kstep, voffB); PG8_STAGE(PG8_SA(1, 0), cA + kstep, voffA); PG8_STAGE(PG8_SB(1, 1), cB + hstep + kstep, voffB);
        PG8_WAIT_V(6); PG8_BAR;
    } else {
        PG8_STAGE(PG8_SB(0, 0), cB, voffB); PG8_STAGE(PG8_SA(0, 0), cA, voffA); PG8_STAGE(PG8_SB(0, 1), cB + hstep, voffB); PG8_STAGE(PG8_SA(0, 1), cA + hstep, voffA);
        if (wr == 1) PG8_BAR;
        PG8_WAIT_V(4); PG8_BAR;
        PG8_STAGE(PG8_SB(1, 0), cB + kstep, voffB); PG8_STAGE(PG8_SA(1, 0), cA + kstep, voffA); PG8_STAGE(PG8_SB(1, 1), cB + hstep + kstep, voffB);
        PG8_WAIT_V(6); PG8_BAR;
    }
    for (;;) {
        const bool has_next = S.next(ui + 1, nxt);
        const char* nA = has_next ? (const char*)g.A + (size_t)nxt.pm * tstep : cA; const char* nB = has_next ? (const char*)g.Bt + (size_t)nxt.pn * tstep : cB;
        for (int t = 0; t < nt; t += 2) {
            const bool last = (t == nt - 2);
            const char* a1 = cA + (size_t)(t + 1) * kstep;
            const char* a2 = last ? nA : cA + (size_t)(t + 2) * kstep; const char* b2 = last ? nB : cB + (size_t)(t + 2) * kstep;
            const char* a3 = a2 + kstep; const char* b3 = b2 + kstep;
            if (last && has_next) S.a_ready(nxt);
            if constexpr (SP2) {
            PG8_LDB(B0, 0, 0); PG8_LDB(B1, 0, 1); PG8_SCHED; PG8_LDA(At, 0, 0); PG8_STAGE(PG8_SA(1, 1), a1 + hstep, voffA);
            PG8_WAIT_V(8); PG8_WAIT_L(0); PG8_BAR; PG8_MMA(0, 0, At, B0); PG8_MMA(0, 1, At, B1); PG8_BAR; PG8_SCHED;
            PG8_LDA(At, 0, 1); PG8_STAGE(PG8_SB(0, 0), b2, voffB); PG8_STAGE(PG8_SB(0, 1), b2 + hstep, voffB); PG8_STAGE(PG8_SA(0, 0), a2, voffA);
            PG8_WAIT_V(8); PG8_WAIT_L(0); PG8_BAR; PG8_MMA(1, 0, At, B0); PG8_MMA(1, 1, At, B1); PG8_BAR; PG8_SCHED;
            PG8_LDB(B0, 1, 0); PG8_LDB(B1, 1, 1); PG8_SCHED; PG8_LDA(At, 1, 0); PG8_STAGE(PG8_SA(0, 1), a2 + hstep, voffA);
            PG8_WAIT_V(8); PG8_WAIT_L(0); PG8_BAR; PG8_MMA(0, 0, At, B0); PG8_MMA(0, 1, At, B1); PG8_BAR; PG8_SCHED;
            PG8_LDA(At, 1, 1); PG8_STAGE(PG8_SB(1, 0), b3, voffB); PG8_STAGE(PG8_SB(1, 1), b3 + hstep, voffB); PG8_STAGE(PG8_SA(1, 0), a3, voffA);
            PG8_WAIT_V(8); PG8_WAIT_L(0); PG8_BAR; PG8_MMA(1, 0, At, B0); PG8_MMA(1, 1, At, B1); PG8_BAR; PG8_SCHED;
            } else {
            PG8_LDB(B0, 0, 0); PG8_SCHED; PG8_LDA(At, 0, 0); PG8_STAGE(PG8_SA(1, 1), a1 + hstep, voffA);
            PG8_WAIT_L(8); PG8_BAR; PG8_WAIT_L(0); PG8_MMA(0, 0, At, B0); PG8_BAR; PG8_SCHED;
            PG8_LDB(B1, 0, 1); PG8_STAGE(PG8_SB(0, 0), b2, voffB);
            PG8_BAR; PG8_WAIT_L(0); PG8_MMA(0, 1, At, B1); PG8_BAR;
            PG8_LDA(At, 0, 1); PG8_STAGE(PG8_SA(0, 0), a2, voffA);
            PG8_BAR; PG8_WAIT_L(0); PG8_MMA(1, 0, At, B0); PG8_BAR; PG8_SCHED;
            PG8_STAGE(PG8_SB(0, 1), b2 + hstep, voffB);
            PG8_WAIT_V(6); PG8_BAR; PG8_MMA(1, 1, At, B1); PG8_BAR;
            PG8_LDB(B0, 1, 0); PG8_SCHED; PG8_LDA(At, 1, 0); PG8_STAGE(PG8_SA(0, 1), a2 + hstep, voffA);
            PG8_WAIT_L(8); PG8_BAR; PG8_WAIT_L(0); PG8_MMA(0, 0, At, B0); PG8_BAR; PG8_SCHED;
            PG8_LDB(B1, 1, 1); PG8_STAGE(PG8_SB(1, 0), b3, voffB);
            PG8_BAR; PG8_WAIT_L(0); PG8_MMA(0, 1, At, B1); PG8_BAR;
            PG8_LDA(At, 1, 1); PG8_STAGE(PG8_SA(1, 0), a3, voffA);
            PG8_BAR; PG8_WAIT_L(0); PG8_MMA(1, 0, At, B0); PG8_BAR; PG8_SCHED;
            PG8_STAGE(PG8_SB(1, 1), b3 + hstep, voffB);
            PG8_WAIT_V(6); PG8_BAR; PG8_MMA(1, 1, At, B1); PG8_BAR;
            }
        }
        if constexpr (ALIGN_EPI) { if (wr == 0) PG8_BAR; }
        if constexpr (!Epi::AFTER_DRAIN) { E(acc, cur, wr, wc, fr, fq); S.done(cur); }
        if (!has_next) break;
#pragma unroll
        for (int a = 0; a < 2; ++a)
#pragma unroll
            for (int b = 0; b < 2; ++b)
#pragma unroll
                for (int m = 0; m < 4; ++m)
#pragma unroll
                    for (int n = 0; n < 2; ++n) acc[a][b][m][n] = (f32x4){0.f, 0.f, 0.f, 0.f};
        cur = nxt; cA = nA; cB = nB; ++ui;
        if constexpr (ALIGN_EPI) { if (wr == 1) PG8_BAR; }
    }
    PG8_WAIT_V(0);
    if constexpr (!ALIGN_EPI) { if (wr == 0) PG8_BAR; }
    PG8_BAR;
    if constexpr (Epi::AFTER_DRAIN) { E.fused(acc, cur, wr, wc, fr, fq, lds, wid, lane); S.done(cur); }
#undef PG8_SA
#undef PG8_SB
#undef PG8_STAGE
#undef PG8_LDA
#undef PG8_LDB
#undef PG8_MMA
#undef PG8_WAIT_V
#undef PG8_WAIT_L
#undef PG8_BAR
#undef PG8_SCHED
}
}

#define DI __device__ __forceinline__
#define LAS __attribute__((address_space(3)))
typedef unsigned short bf16_t;
typedef short bf16x8 __attribute__((ext_vector_type(8)));
typedef float f32x4 __attribute__((ext_vector_type(4)));
typedef float f32x16 __attribute__((ext_vector_type(16)));
typedef unsigned u32x4 __attribute__((ext_vector_type(4)));
typedef unsigned u32x2 __attribute__((ext_vector_type(2)));
typedef float f32x2_t __attribute__((ext_vector_type(2)));
typedef __bf16 bf16x2_t __attribute__((ext_vector_type(2)));

constexpr int DM = 1024, NB = 8, SEQ = 2048, MP = NB * SEQ, NL = 2, NS = 128, MEM = 256, MM = NB * MEM, DG = 256, DIN = 2048, DFF = 4096;
constexpr float EPS = 1e-6f;
constexpr int NWAVES = 8, NTHR = 512;
constexpr int LDS_BYTES = 147456;

constexpr size_t MiB = 1u << 20;
constexpr size_t WS_W = 2 * MiB, W_LSTRIDE = 28 * MiB;
constexpr size_t W_IN = 0, W_OUT = 4 * MiB, W_Q = 6 * MiB, W_O = 8 * MiB, W_F1 = 10 * MiB, W_F2 = 18 * MiB, W_GWS = 26 * MiB, W_PWT = 26 * MiB + 512 * 1024;
constexpr size_t WS_WKV = 58 * MiB;
constexpr size_t WS_MEMB = 66 * MiB;
constexpr size_t WS_MEMSS = 70 * MiB;
constexpr size_t WS_SS = 71 * MiB;
constexpr size_t WS_XB = 72 * MiB;
constexpr size_t WS_Z = 104 * MiB;
constexpr size_t WS_Y = 168 * MiB;
constexpr size_t WS_Q = 200 * MiB;
constexpr size_t WS_O = 232 * MiB;
constexpr size_t WS_H = 264 * MiB;
constexpr size_t WS_KP = 392 * MiB;
constexpr size_t WS_VT = 400 * MiB;
constexpr size_t WS_XS = 408 * MiB, WS_YS = 408 * MiB + 512 * 1024, WS_OS = 409 * MiB, WS_SSQ = 409 * MiB + 512 * 1024  , WS_ZS = 410 * MiB  , WS_QS = 412 * MiB  , WS_HS = 413 * MiB  , WS_END = 417 * MiB;
constexpr size_t WS_CTL = 0, CTL_ZERO_BYTES = 65536;

constexpr size_t O_YP = 0, O_YS = O_YP + (size_t)MP * DM, O_MK = O_YS + (size_t)NS * DM, O_MV = O_MK + (size_t)NL * MM * DM, O_GLUP = O_MV + (size_t)NL * MM * DM,
                 O_GLUS = O_GLUP + (size_t)NL * NB * 30 * DG, O_SHP = O_GLUS + (size_t)NL * NS * 30 * DG, O_SHS = O_SHP + (size_t)NL * NB * 2 * DG,
                 O_PLP = O_SHS + (size_t)NL * NS * 2 * DG, O_PLS = O_PLP + (size_t)NL * NB * 15 * DG, O_GV = O_PLS + (size_t)NL * NS * 15 * DG, O_END = O_GV + (size_t)NL * NS * DG;

enum { I_XP = 0, I_XS, I_MEM, I_CK, I_CV, I_SGLU, I_SSH, I_SPL, I_NMIX, I_WIN, I_LNG, I_LNB, I_GWS, I_GBS, I_CDW, I_CDWB, I_CLNG, I_CLNB, I_SCDW, I_PW, I_PSC, I_MOG, I_WOUT,
       I_NXA, I_NMEM, I_WQ, I_WK, I_WV, I_WO, I_NFF, I_WF1, I_WF2, I_NFIN, N_IN };

DI unsigned pk2(float lo, float hi) { f32x2_t v = {lo, hi}; bf16x2_t b = __builtin_convertvector(v, bf16x2_t); return __builtin_bit_cast(unsigned, b); }
DI float bf2f(unsigned short u) { return __uint_as_float((unsigned)u << 16); }
DI float bflo(unsigned u) { return __uint_as_float(u << 16); }
DI float bfhi(unsigned u) { return __uint_as_float(u & 0xffff0000u); }
DI f32x4 ld_bf4(const bf16_t* p) { const u32x2 w = *(const u32x2*)p; return (f32x4){bflo(w.x), bfhi(w.x), bflo(w.y), bfhi(w.y)}; }
DI void st_bf4(bf16_t* p, f32x4 v) { u32x2 w; w.x = pk2(v.x, v.y); w.y = pk2(v.z, v.w); *(u32x2*)p = w; }
DI float wave_sum(float v) {
#pragma unroll
    for (int o = 1; o < 64; o <<= 1) v += __shfl_xor(v, o);
    return v;
}
DI float hsum4(f32x4 v) { return (v.x + v.y) + (v.z + v.w); }
DI float hsq4(f32x4 v) { return (v.x * v.x + v.y * v.y) + (v.z * v.z + v.w * v.w); }
DI float sigmoidf_(float x) { return 1.0f / (1.0f + __expf(-x)); }
DI float row_rs(const float* ss16) {
    const f32x4* sp = (const f32x4*)ss16; const f32x4 a = sp[0], b = sp[1], c = sp[2], d = sp[3];
    const float s = (hsum4(a) + hsum4(b)) + (hsum4(c) + hsum4(d));
    return rsqrtf(s * (1.0f / DM) + EPS);
}

template <int MODE  > struct EpiScale {
    static constexpr bool PERM = true, AFTER_DRAIN = false;
    bf16_t* O; int ldc; const float* ss;
    DI void operator()(const f32x4 (&acc)[2][2][4][2], const pg8::Unit& u, int wr, int wc, int fr, int fq) const {
        const int row0 = u.pm * 256 + wr * 64 + fr, col0 = u.pn * 256 + wc * 32 + 8 * fq;
#pragma unroll
        for (int ai = 0; ai < 2; ++ai)
#pragma unroll
            for (int m = 0; m < 4; ++m) {
                const int row = row0 + ai * 128 + m * 16;
                float rs = row_rs(ss + (size_t)row * 16); if (MODE == 1) rs *= 0.0625f;
                bf16_t* rowp = O + (size_t)row * ldc + col0;
#pragma unroll
                for (int bj = 0; bj < 2; ++bj) {
                    f32x4 v0 = acc[ai][bj][m][0] * rs, v1 = acc[ai][bj][m][1] * rs;
                    if (MODE == 2) {
#pragma unroll
                        for (int j = 0; j < 4; ++j) { float a = fmaxf(v0[j], 0.f), b = fmaxf(v1[j], 0.f); v0[j] = a * a; v1[j] = b * b; }
                    }
                    u32x4 w; w.x = pk2(v0[0], v0[1]); w.y = pk2(v0[2], v0[3]); w.z = pk2(v1[0], v1[1]); w.w = pk2(v1[2], v1[3]);
                    *(u32x4*)(rowp + bj * 128) = w;
                }
            }
    }
};
struct EpiKV {
    static constexpr bool PERM = true, AFTER_DRAIN = false;
    const float* mss; float* outK; float* outV; bf16_t* KP; bf16_t* VT;
    DI void operator()(const f32x4 (&acc)[2][2][4][2], const pg8::Unit& u, int wr, int wc, int fr, int fq) const {
        const int l = u.pn >> 3, w8 = u.pn & 7, isV = w8 >> 2, h = w8 & 3, b = u.pm;
        const int row0 = u.pm * 256 + wr * 64 + fr, colh0 = h * 256 + wc * 32 + 8 * fq;
        float* outp = (isV ? outV : outK) + (size_t)l * MM * DM;
#pragma unroll
        for (int ai = 0; ai < 2; ++ai)
#pragma unroll
            for (int m = 0; m < 4; ++m) {
                const int row = row0 + ai * 128 + m * 16;
                const float rs = rsqrtf(mss[row] * (1.0f / DM) + EPS);
#pragma unroll
                for (int bj = 0; bj < 2; ++bj) {
                    const int colh = colh0 + bj * 128;
                    const f32x4 v0 = acc[ai][bj][m][0] * rs, v1 = acc[ai][bj][m][1] * rs;
                    *(f32x4*)(outp + (size_t)row * DM + colh) = v0; *(f32x4*)(outp + (size_t)row * DM + colh + 4) = v1;
                    if (!isV) {
                        u32x4 w; w.x = pk2(v0[0], v0[1]); w.y = pk2(v0[2], v0[3]); w.z = pk2(v1[0], v1[1]); w.w = pk2(v1[2], v1[3]);
                        *(u32x4*)(KP + ((size_t)l * MM + row) * DM + colh) = w;
                    } else {
                        bf16_t* vt = VT + ((size_t)((l * NB + b) * 4 + h) * 256 + (colh & 255)) * 256 + (row & 255);
#pragma unroll
                        for (int j = 0; j < 4; ++j) { vt[(size_t)j * 256] = (bf16_t)(pk2(v0[j], 0.f) & 0xffffu); vt[(size_t)(j + 4) * 256] = (bf16_t)(pk2(v1[j], 0.f) & 0xffffu); }
                    }
                }
            }
    }
};
struct EpiRes {
    static constexpr bool PERM = true, AFTER_DRAIN = false;
    bf16_t* xb; float* ss;
    DI void operator()(const f32x4 (&acc)[2][2][4][2], const pg8::Unit& u, int wr, int wc, int fr, int fq) const {
        const int row0 = u.pm * 256 + wr * 64 + fr, col0 = u.pn * 256 + wc * 32 + 8 * fq;
#pragma unroll
        for (int ai = 0; ai < 2; ++ai)
#pragma unroll
            for (int m = 0; m < 4; ++m) {
                const int row = row0 + ai * 128 + m * 16; bf16_t* rowp = xb + (size_t)row * DM + col0;
                const u32x4 o0 = *(const u32x4*)rowp, o1 = *(const u32x4*)(rowp + 128);
                float sq = 0.f;
#pragma unroll
                for (int bj = 0; bj < 2; ++bj) {
                    const u32x4 ov = bj ? o1 : o0;
                    f32x4 v0 = acc[ai][bj][m][0], v1 = acc[ai][bj][m][1];
                    v0.x += bflo(ov.x); v0.y += bfhi(ov.x); v0.z += bflo(ov.y); v0.w += bfhi(ov.y);
                    v1.x += bflo(ov.z); v1.y += bfhi(ov.z); v1.z += bflo(ov.w); v1.w += bfhi(ov.w);
                    sq += hsq4(v0) + hsq4(v1);
                    u32x4 w; w.x = pk2(v0[0], v0[1]); w.y = pk2(v0[2], v0[3]); w.z = pk2(v1[0], v1[1]); w.w = pk2(v1[2], v1[3]);
                    *(u32x4*)(rowp + bj * 128) = w;
                }
                sq += __shfl_xor(sq, 16); sq += __shfl_xor(sq, 32);
                if (fq == 0) ss[(size_t)row * 16 + u.pn * 4 + wc] = sq;
                asm volatile("" ::: "memory");
            }
    }
};

template <int AMODE, bool SSQ, int NSL> DI void sgemm_item(const float* A, int lda, const bf16_t* Bt, int ldb, int n0, int kbase, float* Out, int ldo, const float* ssq_in, float* ssq_out, int wave, int lane) {
    const int r = lane & 15, q = lane >> 4;
    const float* ap = A + (size_t)(16 * wave + r) * lda + kbase + 16 * q;
    const bf16_t* bp = Bt + (size_t)(n0 + r) * ldb + kbase + 16 * q;
    f32x4 av[4][4]; bf16x8 bv[NSL][4][2];
#pragma unroll
    for (int c = 0; c < 4; ++c)
#pragma unroll
        for (int i = 0; i < 4; ++i) av[c][i] = *(const f32x4*)(ap + 64 * c + 4 * i);
#pragma unroll
    for (int sl = 0; sl < NSL; ++sl)
#pragma unroll
        for (int c = 0; c < 4; ++c) { bv[sl][c][0] = *(const bf16x8*)(bp + (size_t)sl * 16 * ldb + 64 * c); bv[sl][c][1] = *(const bf16x8*)(bp + (size_t)sl * 16 * ldb + 64 * c + 8); }
    float rsA = 1.f; if (AMODE == 1) rsA = rsqrtf(ssq_in[16 * wave + r] * (1.0f / DM) + EPS);
    f32x4 acc[NSL]; float ssq = 0.f;
#pragma unroll
    for (int sl = 0; sl < NSL; ++sl) acc[sl] = (f32x4){0.f, 0.f, 0.f, 0.f};
#pragma unroll
    for (int c = 0; c < 4; ++c) {
        if (AMODE == 1) {
#pragma unroll
            for (int i = 0; i < 4; ++i)
#pragma unroll
                for (int j = 0; j < 4; ++j) { const float t = fmaxf(av[c][i][j] * rsA, 0.f); av[c][i][j] = t * t; }
        }
        if (SSQ) ssq += (hsq4(av[c][0]) + hsq4(av[c][1])) + (hsq4(av[c][2]) + hsq4(av[c][3]));
        u32x4 p0, p1; p0.x = pk2(av[c][0].x, av[c][0].y); p0.y = pk2(av[c][0].z, av[c][0].w); p0.z = pk2(av[c][1].x, av[c][1].y); p0.w = pk2(av[c][1].z, av[c][1].w);
        p1.x = pk2(av[c][2].x, av[c][2].y); p1.y = pk2(av[c][2].z, av[c][2].w); p1.z = pk2(av[c][3].x, av[c][3].y); p1.w = pk2(av[c][3].z, av[c][3].w);
#pragma unroll
        for (int sl = 0; sl < NSL; ++sl) {
            acc[sl] = __builtin_amdgcn_mfma_f32_16x16x32_bf16(__builtin_bit_cast(bf16x8, p0), bv[sl][c][0], acc[sl], 0, 0, 0);
            acc[sl] = __builtin_amdgcn_mfma_f32_16x16x32_bf16(__builtin_bit_cast(bf16x8, p1), bv[sl][c][1], acc[sl], 0, 0, 0);
        }
    }
    if (SSQ) { if (n0 == 0) { ssq += __shfl_xor(ssq, 16); ssq += __shfl_xor(ssq, 32); if (q == 0) unsafeAtomicAdd(ssq_out + 16 * wave + r, ssq); } }
#pragma unroll
    for (int sl = 0; sl < NSL; ++sl)
#pragma unroll
        for (int j = 0; j < 4; ++j) unsafeAtomicAdd(Out + (size_t)(16 * wave + 4 * q + j) * ldo + n0 + 16 * sl + r, acc[sl][j]);
}
template <int AMODE, bool SSQ, int NSL> DI void sgemm_phase(const float* A, int K, const bf16_t* Bt, int N, float* Out, const float* ssq_in, float* ssq_out, int bx, int G, int wave, int lane) {
    const int ng = N / (16 * NSL), nit = ng * (K / 256);
    for (int it = bx; it < nit; it += G) { const int sg = it % ng, kp = it / ng; sgemm_item<AMODE, SSQ, NSL>(A, K, Bt, K, sg * 16 * NSL, kp * 256, Out, N, ssq_in, ssq_out, wave, lane); }
}
template <int AMODE, bool SSQ, int NSL> DI void sgemm_phase_p(const float* A, int K, const bf16_t* Bt, int N, float* Out, const float* ssq_in, float* ssq_out, unsigned char* ws, int bx, int G, int wave, int lane) {
    sgemm_phase<AMODE, SSQ, NSL>(A, K, Bt, N, Out, ssq_in, ssq_out, bx, G, wave, lane);
    if (DUPMASK & 8) sgemm_phase<AMODE, SSQ, NSL>(A, K, Bt, N, (float*)(ws + WS_END), ssq_in, (float*)(ws + WS_END) + 1024 * 1024, bx, G, wave, lane);
}

DI void p0_transpose_item(const float* W, const float* g, int K, int N, bf16_t* WT, int row_off, LAS float* scr, int item, int lane) {
    const int nblk = N / 32, kb = item / nblk, nb = item % nblk, k0 = 64 * kb, n0 = 32 * nb;
#pragma unroll 8
    for (int i = 0; i < 32; ++i) { const int kk = 2 * i + (lane >> 5); const float gv = g ? g[k0 + kk] : 1.f; scr[kk * 33 + (lane & 31)] = W[(size_t)(k0 + kk) * N + n0 + (lane & 31)] * gv; }
    asm volatile("s_waitcnt lgkmcnt(0)" ::: "memory");
    const int c = lane & 7;
#pragma unroll
    for (int j = 0; j < 4; ++j) { const int n = (lane >> 3) + 8 * j; const LAS float* s = scr + (8 * c) * 33 + n;
        u32x4 o; o.x = pk2(s[0 * 33], s[1 * 33]); o.y = pk2(s[2 * 33], s[3 * 33]); o.z = pk2(s[4 * 33], s[5 * 33]); o.w = pk2(s[6 * 33], s[7 * 33]);
        *(u32x4*)(WT + (size_t)(row_off + n0 + n) * K + k0 + 8 * c) = o; }
    asm volatile("s_waitcnt lgkmcnt(0)" ::: "memory");
}
DI float row_to_bf16(const float* xrow, bf16_t* orow, int lane) {
    const f32x4* xr = (const f32x4*)xrow + lane; float s = 0.f;
#pragma unroll
    for (int j = 0; j < 4; ++j) { const f32x4 v = xr[64 * j]; s += hsq4(v); st_bf4(orow + 4 * lane + 256 * j, v); }
    return wave_sum(s);
}

struct Args { const float* in[N_IN]; float* out; unsigned char* ws; int ph_lo, ph_hi; };
typedef const __attribute__((address_space(4))) Args* AP;

DI void prologue(AP a, LAS unsigned char* lds, int wave, int lane) {
    unsigned char* ws = a->ws;
    LAS float* scr = (LAS float*)(lds + wave * 16384);
    const int gw = blockIdx.x * NWAVES + wave, NGW = gridDim.x * NWAVES;
    constexpr int IT_IN = 16 * 64, IT_SQ = 16 * 32, IT_F1 = 16 * 128, IT_F2 = 64 * 32, IT_L = IT_IN + 5 * IT_SQ + IT_F1 + IT_F2;
    for (int it = gw; it < NL * IT_L; it += NGW) {
        const int l = it / IT_L; int r = it % IT_L;
        unsigned char* wl = ws + WS_W + (size_t)l * W_LSTRIDE;
        if (r < IT_IN) { p0_transpose_item(a->in[I_WIN] + (size_t)l * DM * DIN, a->in[I_NMIX] + l * DM, DM, DIN, (bf16_t*)(wl + W_IN), 0, scr, r, lane); continue; } r -= IT_IN;
        if (r < IT_SQ) { p0_transpose_item(a->in[I_WOUT] + (size_t)l * DM * DM, nullptr, DM, DM, (bf16_t*)(wl + W_OUT), 0, scr, r, lane); continue; } r -= IT_SQ;
        if (r < IT_SQ) { p0_transpose_item(a->in[I_WQ] + (size_t)l * DM * DM, a->in[I_NXA] + l * DM, DM, DM, (bf16_t*)(wl + W_Q), 0, scr, r, lane); continue; } r -= IT_SQ;
        if (r < IT_SQ) { p0_transpose_item(a->in[I_WK] + (size_t)l * DM * DM, a->in[I_NMEM] + l * DM, DM, DM, (bf16_t*)(ws + WS_WKV), l * 2048, scr, r, lane); continue; } r -= IT_SQ;
        if (r < IT_SQ) { p0_transpose_item(a->in[I_WV] + (size_t)l * DM * DM, a->in[I_NMEM] + l * DM, DM, DM, (bf16_t*)(ws + WS_WKV), l * 2048 + 1024, scr, r, lane); continue; } r -= IT_SQ;
        if (r < IT_SQ) { p0_transpose_item(a->in[I_WO] + (size_t)l * DM * DM, nullptr, DM, DM, (bf16_t*)(wl + W_O), 0, scr, r, lane); continue; } r -= IT_SQ;
        if (r < IT_F1) { p0_transpose_item(a->in[I_WF1] + (size_t)l * DM * DFF, a->in[I_NFF] + l * DM, DM, DFF, (bf16_t*)(wl + W_F1), 0, scr, r, lane); continue; } r -= IT_F1;
        p0_transpose_item(a->in[I_WF2] + (size_t)l * DFF * DM, nullptr, DFF, DM, (bf16_t*)(wl + W_F2), 0, scr, r, lane);
    }
    {
        bf16_t* XB = (bf16_t*)(ws + WS_XB); float* SS = (float*)(ws + WS_SS);
        for (int m = gw; m < MP; m += NGW) { const float s = row_to_bf16(a->in[I_XP] + (size_t)m * DM, XB + (size_t)m * DM, lane); if (lane < 16) SS[(size_t)m * 16 + lane] = lane == 0 ? s : 0.f; }
        bf16_t* MB = (bf16_t*)(ws + WS_MEMB); float* MS = (float*)(ws + WS_MEMSS);
        for (int m = gw; m < MM; m += NGW) { const float s = row_to_bf16(a->in[I_MEM] + (size_t)m * DM, MB + (size_t)m * DM, lane); if (lane == 0) MS[m] = s; }
    }
    {
        const int gt = blockIdx.x * NTHR + wave * 64 + lane, NGT = gridDim.x * NTHR;
        for (int i = gt; i < NL * 4 * 128 * 128; i += NGT) { const int l = i >> 16, r = i & 65535, t = (r >> 7) & 127, s = r & 127;
            ((bf16_t*)(ws + WS_W + (size_t)l * W_LSTRIDE + W_GWS))[r] = (bf16_t)(pk2(s <= t ? a->in[I_GWS][i] : 0.f, 0.f) & 0xffffu); }
        for (int i = gt; i < NL * 4 * 64 * 64; i += NGT) { const int l = i >> 14, r = i & 16383, g = r >> 12, d = (r >> 6) & 63, c = r & 63;
            ((bf16_t*)(ws + WS_W + (size_t)l * W_LSTRIDE + W_PWT))[r] = (bf16_t)(pk2(a->in[I_PW][(size_t)l * 16384 + g * 4096 + c * 64 + d], 0.f) & 0xffffu); }
        for (int i = gt; i < NS * DM / 4; i += NGT) ((f32x4*)(ws + WS_XS))[i] = ((const f32x4*)a->in[I_XS])[i];
        for (int i = gt; i < (int)((WS_END - WS_ZS) / 16); i += NGT) ((f32x4*)(ws + WS_ZS))[i] = (f32x4){0.f, 0.f, 0.f, 0.f};
        for (int i = gt; i < NL * 3 * NS; i += NGT) ((float*)(ws + WS_SSQ))[i] = 0.f;
    }
}

#ifndef MIXP
#define MIXP 15
#endif
constexpr int VNT_P = 136;
constexpr int TT_OFF = 69632, TT_P = 260;
constexpr int CW_OFF = 96256;
constexpr int PL_P = 264;

DI void tt_rows_out(LAS unsigned char* lds, bf16_t* Yrow0, const float* mog, int wave, int lane) {
    const LAS float* TT = (const LAS float*)(lds + TT_OFF);
    const f32x4 g = *(const f32x4*)(mog + 4 * lane);
#pragma unroll
    for (int i = 0; i < 8; ++i) {
        const int tt = 8 * wave + i;
        const f32x4 v = *(const LAS f32x4*)(TT + tt * TT_P + 4 * lane);
        const float r = rsqrtf(wave_sum(hsq4(v)) * (1.0f / DG) + EPS);
        st_bf4(Yrow0 + (size_t)tt * DM + 4 * lane, v * r * g);
    }
}

DI void mixer_unit(AP a, int l, int uidx, LAS unsigned char* lds, int wave, int lane) {
    unsigned char* ws = a->ws;
    const int b = uidx >> 5, ju = uidx & 31, t0 = ju * 64, off = t0 & 127, tc = t0 - off;
    const size_t R0 = (size_t)b * SEQ + t0;
    const bf16_t* Z = (const bf16_t*)(ws + WS_Z);
    bf16_t* Y = (bf16_t*)(ws + WS_Y);
    const float* mog = a->in[I_MOG] + l * DM;
    if (MIXP & 1) {
        int lq_ = lane; asm volatile("" : "+v"(lq_)); const int lane = lq_; const int fr = lane & 15, fq = lane >> 4; (void)fr; (void)fq;
        LAS bf16_t* VNT = (LAS bf16_t*)lds;
        const f32x4 lg = *(const f32x4*)(a->in[I_LNG] + l * DG + 4 * lane), lb = *(const f32x4*)(a->in[I_LNB] + l * DG + 4 * lane);
        const int nrow = off + 64;
        for (int s = wave; s < nrow; s += NWAVES) {
            const f32x4 v = ld_bf4(Z + ((size_t)b * SEQ + tc + s) * DIN + 256 + 4 * lane);
            const float mean = wave_sum(hsum4(v)) * (1.0f / DG); const f32x4 d = v - mean;
            const float rstd = rsqrtf(wave_sum(hsq4(d)) * (1.0f / DG) + EPS);
            const f32x4 vn = d * rstd * lg + lb;
#pragma unroll
            for (int i = 0; i < 4; ++i) VNT[(4 * lane + i) * VNT_P + s] = (bf16_t)(pk2(vn[i], 0.f) & 0xffffu);
        }
        __syncthreads();
        const int mt = wave & 3, hp = wave >> 2, tl0 = off + 16 * mt, nks = (tl0 + 16 + 31) >> 5;
        const bf16_t* GW = (const bf16_t*)(ws + WS_W + (size_t)l * W_LSTRIDE + W_GWS);
        LAS float* TT = (LAS float*)(lds + TT_OFF);
#pragma unroll
        for (int hh = 0; hh < 2; ++hh) {
            const int h = 2 * hp + hh;
            f32x4 acc[4];
#pragma unroll
            for (int dt = 0; dt < 4; ++dt) acc[dt] = (f32x4){0.f, 0.f, 0.f, 0.f};
            for (int ks = 0; ks < nks; ++ks) {
                const bf16x8 af = *(const bf16x8*)(GW + ((size_t)h * 128 + tl0 + fr) * 128 + 32 * ks + 8 * fq);
#pragma unroll
                for (int dt = 0; dt < 4; ++dt) {
                    const bf16x8 bfr = *(const LAS bf16x8*)(VNT + (h * 64 + dt * 16 + fr) * VNT_P + 32 * ks + 8 * fq);
                    acc[dt] = __builtin_amdgcn_mfma_f32_16x16x32_bf16(af, bfr, acc[dt], 0, 0, 0);
                }
            }
#pragma unroll
            for (int dt = 0; dt < 4; ++dt)
#pragma unroll
                for (int j = 0; j < 4; ++j) {
                    const int tl = 16 * mt + 4 * fq + j, d = h * 64 + dt * 16 + fr;
                    const float bs = a->in[I_GBS][(l * 4 + h) * 128 + off + tl];
                    const float uu = bf2f(Z[(R0 + tl) * DIN + d]);
                    TT[tl * TT_P + d] = uu * (acc[dt][j] + bs);
                }
        }
        __syncthreads();
        tt_rows_out(lds, Y + R0 * DM + 0 * DG, mog + 0 * DG, wave, lane);
        __syncthreads();
    }
    if (MIXP & 2) {
        int lq_ = lane; asm volatile("" : "+v"(lq_)); const int lane = lq_; const int fr = lane & 15, fq = lane >> 4; (void)fr; (void)fq;
        LAS float* G = (LAS float*)lds; LAS float* CW = (LAS float*)(lds + CW_OFF);
        for (int rr = wave; rr < 94; rr += NWAVES) {
            const int t = t0 - 30 + rr; f32x4 gl = {0.f, 0.f, 0.f, 0.f};
            if (t >= 0) { const bf16_t* zr = Z + ((size_t)b * SEQ + t) * DIN; const f32x4 ga = ld_bf4(zr + 512 + 4 * lane), gg = ld_bf4(zr + 768 + 4 * lane);
#pragma unroll
                for (int i = 0; i < 4; ++i) gl[i] = ga[i] * sigmoidf_(gg[i]); }
            *(LAS f32x4*)(G + rr * 256 + 4 * lane) = gl;
            if (ju == 31 && rr >= 64) *(f32x4*)(a->out + O_GLUP + ((size_t)(l * NB + b) * 30 + (rr - 64)) * DG + 4 * lane) = gl;
        }
        for (int i = wave * 64 + lane; i < 31 * 64; i += NTHR) ((LAS f32x4*)CW)[i] = ((const f32x4*)(a->in[I_CDW] + (size_t)l * 31 * DG))[i];
        __syncthreads();
        f32x4 acc[8];
#pragma unroll
        for (int i = 0; i < 8; ++i) acc[i] = (f32x4){0.f, 0.f, 0.f, 0.f};
        f32x4 wj[8];
#pragma unroll
        for (int i = 0; i < 38; ++i) {
            const f32x4 g = *(const LAS f32x4*)(G + (8 * wave + i) * 256 + 4 * lane);
            if (i <= 30) wj[i & 7] = *(const LAS f32x4*)(CW + i * 256 + 4 * lane);
#pragma unroll
            for (int tt = 0; tt < 8; ++tt) { const int j = i - tt; if (j >= 0 && j <= 30) acc[tt] += wj[j & 7] * g; }
            if (i & 1) asm volatile("" ::: "memory");
        }
        const f32x4 cb = *(const f32x4*)(a->in[I_CDWB] + l * DG + 4 * lane), lg = *(const f32x4*)(a->in[I_CLNG] + l * DG + 4 * lane), lb = *(const f32x4*)(a->in[I_CLNB] + l * DG + 4 * lane);
        const f32x4 mg = *(const f32x4*)(mog + 1 * DG + 4 * lane);
#pragma unroll
        for (int tt = 0; tt < 8; ++tt) {
            const f32x4 x = acc[tt] + cb;
            const float mean = wave_sum(hsum4(x)) * (1.0f / DG); const f32x4 d = x - mean;
            const float rstd = rsqrtf(wave_sum(hsq4(d)) * (1.0f / DG) + EPS);
            f32x4 y = d * rstd * lg + lb;
#pragma unroll
            for (int i = 0; i < 4; ++i) y[i] = y[i] * sigmoidf_(y[i]);
            const float r = rsqrtf(wave_sum(hsq4(y)) * (1.0f / DG) + EPS);
            st_bf4(Y + (R0 + 8 * wave + tt) * DM + 1 * DG + 4 * lane, y * r * mg);
        }
        __syncthreads();
    }
    asm volatile("" ::: "memory");
    if (MIXP & 4) {
        int lq_ = lane; asm volatile("" : "+v"(lq_)); const int lane = lq_; const int fr = lane & 15, fq = lane >> 4; (void)fr; (void)fq;
        const float* sw = a->in[I_SCDW] + (size_t)l * 3 * DG;
        const f32x4 w0 = *(const f32x4*)(sw + 4 * lane), w1 = *(const f32x4*)(sw + DG + 4 * lane), w2 = *(const f32x4*)(sw + 2 * DG + 4 * lane);
        const f32x4 mg = *(const f32x4*)(mog + 2 * DG + 4 * lane);
        f32x4 s[10];
#pragma unroll
        for (int i = 0; i < 10; ++i) {
            const int t = t0 + 8 * wave - 2 + i; s[i] = (f32x4){0.f, 0.f, 0.f, 0.f};
            if (t >= 0) { const bf16_t* zr = Z + ((size_t)b * SEQ + t) * DIN; s[i] = ld_bf4(zr + 1280 + 4 * lane) * ld_bf4(zr + 1536 + 4 * lane); }
        }
#pragma unroll
        for (int tt = 0; tt < 8; ++tt) {
            const int tl = 8 * wave + tt;
            const f32x4 sb = ld_bf4(Z + (R0 + tl) * DIN + 1024 + 4 * lane);
            const f32x4 y = sb * (w0 * s[tt] + w1 * s[tt + 1] + w2 * s[tt + 2]);
            const float r = rsqrtf(wave_sum(hsq4(y)) * (1.0f / DG) + EPS);
            st_bf4(Y + (R0 + tl) * DM + 2 * DG + 4 * lane, y * r * mg);
            if (ju == 31 && tl >= 62) *(f32x4*)(a->out + O_SHP + ((size_t)(l * NB + b) * 2 + (tl - 62)) * DG + 4 * lane) = s[tt + 2];
        }
    }
    asm volatile("s_waitcnt vmcnt(0)" ::: "memory");
    if (MIXP & 8) {
        int lq_ = lane; asm volatile("" : "+v"(lq_)); const int lane = lq_; const int fr = lane & 15, fq = lane >> 4; (void)fr; (void)fq;
        LAS bf16_t* PL = (LAS bf16_t*)lds; LAS float* TT = (LAS float*)(lds + TT_OFF);
        const int g = lane >> 4, w = 2 << g;
        f32x4 px[23];
#pragma unroll
        for (int i = 0; i < 23; ++i) {
            const int t = t0 + 8 * wave - 15 + i; px[i] = (f32x4){0.f, 0.f, 0.f, 0.f};
            if (t >= 0) px[i] = ld_bf4(Z + ((size_t)b * SEQ + t) * DIN + 1792 + 4 * lane);
        }
#pragma unroll
        for (int tt = 0; tt < 8; ++tt) {
            const int tl = 8 * wave + tt, t = t0 + tl;
            f32x4 sum = {0.f, 0.f, 0.f, 0.f};
#pragma unroll
            for (int i = 0; i < 16; ++i) if (i < w) sum += px[15 + tt - i];
            const float cnt = (float)min(w, t + 1);
            const f32x4 pooled = sum / cnt - px[15 + tt];
            u32x2 pw; pw.x = pk2(pooled.x, pooled.y); pw.y = pk2(pooled.z, pooled.w);
            *(LAS u32x2*)(PL + tl * PL_P + 4 * lane) = pw;
            if (ju == 31 && tl >= 49) *(f32x4*)(a->out + O_PLP + ((size_t)(l * NB + b) * 15 + (tl - 49)) * DG + 4 * lane) = px[15 + tt];
        }
        __syncthreads();
        const int mt = wave & 3, gp = wave >> 2;
        const bf16_t* PWT = (const bf16_t*)(ws + WS_W + (size_t)l * W_LSTRIDE + W_PWT);
#pragma unroll
        for (int gg = 0; gg < 2; ++gg) {
            const int gi = 2 * gp + gg;
#pragma unroll
            for (int nt = 0; nt < 4; ++nt) {
                f32x4 acc = {0.f, 0.f, 0.f, 0.f};
#pragma unroll
                for (int ks = 0; ks < 2; ++ks) {
                    const bf16x8 af = *(const LAS bf16x8*)(PL + (16 * mt + fr) * PL_P + gi * 64 + 32 * ks + 8 * fq);
                    const bf16x8 bfr = *(const bf16x8*)(PWT + ((size_t)gi * 64 + 16 * nt + fr) * 64 + 32 * ks + 8 * fq);
                    acc = __builtin_amdgcn_mfma_f32_16x16x32_bf16(af, bfr, acc, 0, 0, 0);
                }
                const int d = gi * 64 + 16 * nt + fr; const float sc = a->in[I_PSC][l * DG + d];
#pragma unroll
                for (int j = 0; j < 4; ++j) TT[(16 * mt + 4 * fq + j) * TT_P + d] = acc[j] * sc;
            }
        }
        __syncthreads();
        tt_rows_out(lds, Y + R0 * DM + 3 * DG, mog + 3 * DG, wave, lane);
        __syncthreads();
    }
}

DI void mixer_sample(AP a, int l, int bs, LAS unsigned char* lds, int wave, int lane) {
    unsigned char* ws = a->ws;
    const float* z = (const float*)(ws + WS_ZS) + ((size_t)l * NS + bs) * DIN;
    const float zrs = rsqrtf(((const float*)(ws + WS_SSQ))[(l * 3 + 0) * NS + bs] * (1.0f / DM) + EPS);
    float* ys = (float*)(ws + WS_YS) + (size_t)bs * DM;
    const float* mog = a->in[I_MOG] + l * DM;
    const int c4 = 4 * lane;
    {
        const f32x4 u = *(const f32x4*)(z + c4) * zrs, v = *(const f32x4*)(z + 256 + c4) * zrs;
        const f32x4 lg = *(const f32x4*)(a->in[I_LNG] + l * DG + c4), lb = *(const f32x4*)(a->in[I_LNB] + l * DG + c4);
        const float mean = wave_sum(hsum4(v)) * (1.0f / DG); const f32x4 d = v - mean;
        const float rstd = rsqrtf(wave_sum(hsq4(d)) * (1.0f / DG) + EPS);
        const f32x4 vn = d * rstd * lg + lb;
        *(f32x4*)(a->out + O_GV + ((size_t)l * NS + bs) * DG + c4) = vn;
        const int h = lane >> 4;
        const float w00 = a->in[I_GWS][((size_t)(l * 4 + h) * 128) * 128], b0 = a->in[I_GBS][(l * 4 + h) * 128];
        const f32x4 y = u * (vn * w00 + b0);
        const float r = rsqrtf(wave_sum(hsq4(y)) * (1.0f / DG) + EPS);
        *(f32x4*)(ys + c4) = y * r * *(const f32x4*)(mog + c4);
    }
    {
        const f32x4 ga = *(const f32x4*)(z + 512 + c4) * zrs, gg = *(const f32x4*)(z + 768 + c4) * zrs;
        f32x4 glu;
#pragma unroll
        for (int i = 0; i < 4; ++i) glu[i] = ga[i] * sigmoidf_(gg[i]);
        const float* st = a->in[I_SGLU] + ((size_t)(l * NS + bs) * 30) * DG + c4;
        float* so = a->out + O_GLUS + ((size_t)(l * NS + bs) * 30) * DG + c4;
        const float* cw = a->in[I_CDW] + (size_t)l * 31 * DG + c4;
        f32x4 acc = *(const f32x4*)(cw + 30 * DG) * glu;
#pragma unroll 6
        for (int j = 0; j < 30; ++j) { const f32x4 sv = *(const f32x4*)(st + j * DG); acc += *(const f32x4*)(cw + j * DG) * sv; if (j >= 1) *(f32x4*)(so + (j - 1) * DG) = sv; }
        *(f32x4*)(so + 29 * DG) = glu;
        const f32x4 x = acc + *(const f32x4*)(a->in[I_CDWB] + l * DG + c4);
        const float mean = wave_sum(hsum4(x)) * (1.0f / DG); const f32x4 d = x - mean;
        const float rstd = rsqrtf(wave_sum(hsq4(d)) * (1.0f / DG) + EPS);
        f32x4 y = d * rstd * *(const f32x4*)(a->in[I_CLNG] + l * DG + c4) + *(const f32x4*)(a->in[I_CLNB] + l * DG + c4);
#pragma unroll
        for (int i = 0; i < 4; ++i) y[i] = y[i] * sigmoidf_(y[i]);
        const float r = rsqrtf(wave_sum(hsq4(y)) * (1.0f / DG) + EPS);
        *(f32x4*)(ys + DG + c4) = y * r * *(const f32x4*)(mog + DG + c4);
    }
    {
        const f32x4 sb = *(const f32x4*)(z + 1024 + c4) * zrs, s = (*(const f32x4*)(z + 1280 + c4) * zrs) * (*(const f32x4*)(z + 1536 + c4) * zrs);
        const float* st = a->in[I_SSH] + ((size_t)(l * NS + bs) * 2) * DG + c4;
        float* so = a->out + O_SHS + ((size_t)(l * NS + bs) * 2) * DG + c4;
        const float* sw = a->in[I_SCDW] + (size_t)l * 3 * DG + c4;
        const f32x4 s0 = *(const f32x4*)st, s1 = *(const f32x4*)(st + DG);
        const f32x4 y = sb * (*(const f32x4*)sw * s0 + *(const f32x4*)(sw + DG) * s1 + *(const f32x4*)(sw + 2 * DG) * s);
        *(f32x4*)so = s1; *(f32x4*)(so + DG) = s;
        const float r = rsqrtf(wave_sum(hsq4(y)) * (1.0f / DG) + EPS);
        *(f32x4*)(ys + 2 * DG + c4) = y * r * *(const f32x4*)(mog + 2 * DG + c4);
    }
    {
        const f32x4 px = *(const f32x4*)(z + 1792 + c4) * zrs;
        const float* st = a->in[I_SPL] + ((size_t)(l * NS + bs) * 15) * DG + c4;
        float* so = a->out + O_PLS + ((size_t)(l * NS + bs) * 15) * DG + c4;
        const int g = lane >> 4, w = 2 << g;
        f32x4 sum = px;
#pragma unroll
        for (int j = 0; j < 15; ++j) { const f32x4 sv = *(const f32x4*)(st + j * DG); if (15 - j < w) sum += sv; if (j >= 1) *(f32x4*)(so + (j - 1) * DG) = sv; }
        *(f32x4*)(so + 14 * DG) = px;
        const f32x4 pooled = sum / (float)w - px;
        LAS float* PLs = (LAS float*)(lds + wave * 1024);
        *(LAS f32x4*)(PLs + c4) = pooled;
        asm volatile("s_waitcnt lgkmcnt(0)" ::: "memory");
        const float* pw = a->in[I_PW] + (size_t)l * 16384 + (size_t)g * 4096 + 4 * (lane & 15);
        f32x4 acc = {0.f, 0.f, 0.f, 0.f};
#pragma unroll 8
        for (int c = 0; c < 64; ++c) acc += *(const f32x4*)(pw + c * 64) * PLs[g * 64 + c];
        const f32x4 y = acc * *(const f32x4*)(a->in[I_PSC] + l * DG + c4);
        const float r = rsqrtf(wave_sum(hsq4(y)) * (1.0f / DG) + EPS);
        *(f32x4*)(ys + 3 * DG + c4) = y * r * *(const f32x4*)(mog + 3 * DG + c4);
        asm volatile("s_waitcnt lgkmcnt(0)" ::: "memory");
    }
}

DI void attn_unit(AP a, int l, int uidx, int wave, int lane) {
    unsigned char* ws = a->ws;
    const int b = uidx >> 5, h = (uidx >> 3) & 3, qt = uidx & 7;
    const int r32 = lane & 31, hi = lane >> 5;
    const size_t q0 = (size_t)b * SEQ + qt * 256 + 32 * wave;
    const bf16_t* Qp = (const bf16_t*)(ws + WS_Q) + (q0 + r32) * DM + h * 256 + 8 * hi;
    const bf16_t* Kp = (const bf16_t*)(ws + WS_KP) + ((size_t)l * MM + b * 256 + r32) * DM + h * 256 + 8 * hi;
    const bf16_t* Vp = (const bf16_t*)(ws + WS_VT) + ((size_t)((l * NB + b) * 4 + h) * 256 + r32) * 256 + 4 * hi;
    bf16x8 qf[16];
#pragma unroll
    for (int ks = 0; ks < 16; ++ks) qf[ks] = *(const bf16x8*)(Qp + 16 * ks);
    f32x16 S[8];
#pragma unroll
    for (int kt = 0; kt < 8; ++kt) {
#pragma unroll
        for (int i = 0; i < 16; ++i) S[kt][i] = 0.f;
#pragma unroll
        for (int ks = 0; ks < 16; ++ks) {
            const bf16x8 kf = *(const bf16x8*)(Kp + (size_t)kt * 32 * DM + 16 * ks);
            S[kt] = __builtin_amdgcn_mfma_f32_32x32x16_bf16(kf, qf[ks], S[kt], 0, 0, 0);
        }
    }
    float mx = -3.0e38f;
#pragma unroll
    for (int kt = 0; kt < 8; ++kt)
#pragma unroll
        for (int i = 0; i < 16; ++i) mx = fmaxf(mx, S[kt][i]);
    mx = fmaxf(mx, __shfl_xor(mx, 32));
    float sum = 0.f; const float mxl = mx * 1.4426950408889634f;
#pragma unroll
    for (int kt = 0; kt < 8; ++kt)
#pragma unroll
        for (int i = 0; i < 16; ++i) { const float p = exp2f(S[kt][i] * 1.4426950408889634f - mxl); S[kt][i] = p; sum += p; }
    sum += __shfl_xor(sum, 32);
    const float inv = 1.0f / sum;
    bf16x8 pf[16];
#pragma unroll
    for (int kt = 0; kt < 8; ++kt)
#pragma unroll
        for (int c = 0; c < 2; ++c) {
            u32x4 p; p.x = pk2(S[kt][8 * c + 0], S[kt][8 * c + 1]); p.y = pk2(S[kt][8 * c + 2], S[kt][8 * c + 3]); p.z = pk2(S[kt][8 * c + 4], S[kt][8 * c + 5]); p.w = pk2(S[kt][8 * c + 6], S[kt][8 * c + 7]);
            pf[2 * kt + c] = __builtin_bit_cast(bf16x8, p);
        }
    bf16_t* Op = (bf16_t*)(ws + WS_O) + (q0 + r32) * DM + h * 256 + 4 * hi;
#pragma unroll
    for (int dt = 0; dt < 8; ++dt) {
        f32x16 o;
#pragma unroll
        for (int i = 0; i < 16; ++i) o[i] = 0.f;
#pragma unroll
        for (int kc = 0; kc < 16; ++kc) {
            const bf16_t* vp = Vp + (size_t)dt * 32 * 256 + 16 * kc;
            const u32x2 v0 = *(const u32x2*)vp, v1 = *(const u32x2*)(vp + 8);
            u32x4 vv; vv.x = v0.x; vv.y = v0.y; vv.z = v1.x; vv.w = v1.y;
            o = __builtin_amdgcn_mfma_f32_32x32x16_bf16(__builtin_bit_cast(bf16x8, vv), pf[kc], o, 0, 0, 0);
        }
#pragma unroll
        for (int rg = 0; rg < 4; ++rg) {
            u32x2 w; w.x = pk2(o[4 * rg] * inv, o[4 * rg + 1] * inv); w.y = pk2(o[4 * rg + 2] * inv, o[4 * rg + 3] * inv);
            *(u32x2*)(Op + 32 * dt + 8 * rg) = w;
        }
    }
}

DI void attn_sample_unit(AP a, int l, int uidx, LAS unsigned char* lds, int wave, int lane) {
    unsigned char* ws = a->ws;
    const int bs = uidx >> 1, hp = uidx & 1;
    LAS float* SC = (LAS float*)lds;
    LAS float* RED = (LAS float*)(lds + 4096);
    const float* qp = (const float*)(ws + WS_QS) + ((size_t)l * NS + bs) * DM + hp * 512 + 8 * lane;
    const float qrs = 0.0625f * rsqrtf(((const float*)(ws + WS_SSQ))[(l * 3 + 1) * NS + bs] * (1.0f / DM) + EPS);
    const f32x4 q0 = *(const f32x4*)qp * qrs, q1 = *(const f32x4*)(qp + 4) * qrs;
    const float* Kb = a->in[I_CK] + ((size_t)(l * NS + bs) * MEM) * DM + hp * 512 + 8 * lane;
    const float* Vb = a->in[I_CV] + ((size_t)(l * NS + bs) * MEM) * DM + hp * 512 + 8 * lane;
#pragma unroll 8
    for (int mi = 0; mi < 32; ++mi) {
        const int m = wave + 8 * mi;
        const f32x4 k0 = *(const f32x4*)(Kb + (size_t)m * DM), k1 = *(const f32x4*)(Kb + (size_t)m * DM + 4);
        float d = hsum4(k0 * q0) + hsum4(k1 * q1);
        d += __shfl_xor(d, 1); d += __shfl_xor(d, 2); d += __shfl_xor(d, 4); d += __shfl_xor(d, 8); d += __shfl_xor(d, 16);
        if ((lane & 31) == 0) SC[(lane >> 5) * 256 + m] = d;
    }
    __syncthreads();
    if (wave < 2) {
        const f32x4 v = *(const LAS f32x4*)(SC + wave * 256 + 4 * lane);
        float mx = fmaxf(fmaxf(v.x, v.y), fmaxf(v.z, v.w));
#pragma unroll
        for (int o = 1; o < 64; o <<= 1) mx = fmaxf(mx, __shfl_xor(mx, o));
        f32x4 e; e.x = __expf(v.x - mx); e.y = __expf(v.y - mx); e.z = __expf(v.z - mx); e.w = __expf(v.w - mx);
        const float inv = 1.0f / wave_sum(hsum4(e));
        *(LAS f32x4*)(SC + wave * 256 + 4 * lane) = e * inv;
    }
    __syncthreads();
    f32x4 o0 = {0.f, 0.f, 0.f, 0.f}, o1 = {0.f, 0.f, 0.f, 0.f};
#pragma unroll 8
    for (int mi = 0; mi < 32; ++mi) {
        const int m = wave + 8 * mi;
        const f32x4 v0 = *(const f32x4*)(Vb + (size_t)m * DM), v1 = *(const f32x4*)(Vb + (size_t)m * DM + 4);
        const float p = SC[(lane >> 5) * 256 + m];
        o0 += v0 * p; o1 += v1 * p;
    }
    *(LAS f32x4*)(RED + wave * 512 + 8 * lane) = o0; *(LAS f32x4*)(RED + wave * 512 + 8 * lane + 4) = o1;
    __syncthreads();
    {
        const int t = wave * 64 + lane; float s = 0.f;
#pragma unroll
        for (int w = 0; w < 8; ++w) s += RED[w * 512 + t];
        ((float*)(ws + WS_OS))[(size_t)bs * DM + hp * 512 + t] = s;
    }
    __syncthreads();
}


#define XB_TMO      128
#define XB_XCNT(j)  (256  + 64 * (j))
#define XB_XSUB(j)  (1280 + 64 * (j))
#define XB_XGEN(j)  (2304 + 64 * (j))
#define XB_TOP      3328
#define XB_TOPGEN   3392
#define XCD_BAR_WORDS 3456
#define XB_SPIN_CAP (1u << 18)
DI unsigned xb_ld(unsigned* p)              { return __hip_atomic_load(p, __ATOMIC_RELAXED, __HIP_MEMORY_SCOPE_AGENT); }
DI unsigned xb_add(unsigned* p, unsigned v) { return __hip_atomic_fetch_add(p, v, __ATOMIC_RELAXED, __HIP_MEMORY_SCOPE_AGENT); }
DI unsigned xb_xcc_id() { return (unsigned)__builtin_amdgcn_s_getreg((3 << 11) | 20) & 0xFu; }
#define XB_SPIN(cond, bar) do { unsigned _sp = 0; while (cond) { __builtin_amdgcn_s_sleep(1); \
    if ((++_sp & 255u) == 0u) { if (xb_ld(&(bar)[XB_TMO])) break; if (_sp > XB_SPIN_CAP) { atomicAdd(&(bar)[XB_TMO], 1u); break; } } } } while (0)
struct XcdBarrier { unsigned* bar; unsigned x; volatile LAS unsigned* st; };
DI XcdBarrier xcd_barrier_post(unsigned* bar, volatile LAS unsigned* st) {
    XcdBarrier b; b.bar = bar; b.x = xb_xcc_id(); b.st = st;
    if (threadIdx.x == 0) (void)xb_add(&bar[XB_XCNT(b.x)], 1u);
    return b;
}
DI void xcd_barrier_complete(unsigned* bar, unsigned x, unsigned& nloc, unsigned& nx) {
    const unsigned G = gridDim.x * gridDim.y * gridDim.z;
    unsigned sum, cnt, mine, sp = 0u;
    for (;;) {
        sum = 0u; cnt = 0u; mine = 0u;
#pragma unroll
        for (unsigned j = 0; j < 16; ++j) { const unsigned c = xb_ld(&bar[XB_XCNT(j)]); sum += c; cnt += (c > 0u) ? 1u : 0u; mine = (j == x) ? c : mine; }
        if (sum == G) break;
        __builtin_amdgcn_s_sleep(1);
        if ((++sp & 255u) == 0u) { if (xb_ld(&bar[XB_TMO])) break; if (sp > XB_SPIN_CAP) { atomicAdd(&bar[XB_TMO], 1u); break; } }
    }
    nloc = mine > 0u ? mine : 1u; nx = cnt > 0u ? cnt : 1u;
}
DI void xcd_barrier(const XcdBarrier& b) {
    asm volatile("s_waitcnt vmcnt(0)" ::: "memory");
    __syncthreads();
    if (threadIdx.x == 0) {
        unsigned* bar = b.bar;
        __builtin_amdgcn_s_waitcnt(0);
        unsigned nloc = b.st[0], nx = b.st[1];
        if (nloc == 0u) { xcd_barrier_complete(bar, b.x, nloc, nx); b.st[0] = nloc; b.st[1] = nx; }
        const unsigned old = xb_add(&bar[XB_XSUB(b.x)], 1u);
        const unsigned gen = old / nloc;
        if (old + 1u == (gen + 1u) * nloc) {
            __builtin_amdgcn_fence(__ATOMIC_RELEASE, "agent");
            asm volatile("s_waitcnt vmcnt(0)" ::: "memory");
            const unsigned og = xb_add(&bar[XB_TOP], 1u);
            const unsigned tg = og / nx;
            if (og + 1u == (tg + 1u) * nx) xb_add(&bar[XB_TOPGEN], 1u);
            else XB_SPIN(xb_ld(&bar[XB_TOPGEN]) == tg, bar);
            __builtin_amdgcn_fence(__ATOMIC_ACQUIRE, "agent");
            xb_add(&bar[XB_XGEN(b.x)], 1u);
            asm volatile("s_waitcnt vmcnt(0)" ::: "memory");
        } else {
            XB_SPIN(xb_ld(&bar[XB_XGEN(b.x)]) == gen, bar);
            __builtin_amdgcn_fence(__ATOMIC_ACQUIRE, "agent");
            asm volatile("s_waitcnt vmcnt(0)" ::: "memory");
        }
    }
    __syncthreads();
}

#ifndef PMASK
#define PMASK 0xffff
#endif
#ifndef DUPMASK
#define DUPMASK 0
#endif
constexpr int N_PHASES = 18;
__global__ void __launch_bounds__(NTHR, 2) fwd_kernel(Args a_) {
    extern __shared__ __attribute__((aligned(16))) unsigned char lds_raw[];
    LAS unsigned char* lds = (LAS unsigned char*)lds_raw;
    cg::grid_group grid = cg::this_grid();
    volatile LAS unsigned* MISC = (volatile LAS unsigned*)(lds + LDS_BYTES - 256);
    if (threadIdx.x < 32) MISC[threadIdx.x] = 0u;
    __syncthreads();
    const XcdBarrier xbar = xcd_barrier_post((unsigned*)(a_.ws + WS_CTL), MISC + 8);
    const int ph_lo = a_.ph_lo, ph_hi = a_.ph_hi;
    for (int ph = ph_lo; ph < ph_hi; ++ph) {
        AP a = (AP)__builtin_amdgcn_kernarg_segment_ptr();
        asm volatile("" : "+s"(a));
        int tid = threadIdx.x; asm volatile("" : "+v"(tid));
        const int lane = tid & 63, wave = __builtin_amdgcn_readfirstlane(tid >> 6);
        int bx = blockIdx.x; asm volatile("" : "+s"(bx));
        const int G = gridDim.x;
        unsigned char* ws = a->ws;
        bf16_t* XB = (bf16_t*)(ws + WS_XB); float* SS = (float*)(ws + WS_SS); float* XF = a->out + O_YP;
        float* XS = (float*)(ws + WS_XS); float* YS = (float*)(ws + WS_YS); float* OS = (float*)(ws + WS_OS);
        if (ph == 0) {
            for (int rep = 0; rep < ((DUPMASK & 64) ? 2 : 1); ++rep) prologue(a, lds, wave, lane);
        } else if (ph == N_PHASES - 1) { if (PMASK & 2) {
            const int gw = bx * NWAVES + wave, NGW = G * NWAVES;
            const float* gf = a->in[I_NFIN];
            for (int m = gw; m < MP + NS; m += NGW) {
                if (m < MP) {
                    const float rs = row_rs(SS + (size_t)m * 16); f32x4* yr = (f32x4*)(XF + (size_t)m * DM) + lane; const bf16_t* xr = XB + (size_t)m * DM + 4 * lane;
#pragma unroll
                    for (int j = 0; j < 4; ++j) yr[64 * j] = ld_bf4(xr + 256 * j) * rs * ((const f32x4*)gf)[lane + 64 * j];
                } else {
                    const int s = m - MP; const f32x4* xr = (const f32x4*)(XS + (size_t)s * DM) + lane; f32x4 v[4]; float sq = 0.f;
#pragma unroll
                    for (int j = 0; j < 4; ++j) { v[j] = xr[64 * j]; sq += hsq4(v[j]); }
                    const float rs = rsqrtf(wave_sum(sq) * (1.0f / DM) + EPS);
                    f32x4* yo = (f32x4*)(a->out + O_YS + (size_t)s * DM) + lane;
#pragma unroll
                    for (int j = 0; j < 4; ++j) yo[64 * j] = v[j] * rs * ((const f32x4*)gf)[lane + 64 * j];
                }
            }
        } } else {
            const int l = (ph - 1) >> 3, sub = (ph - 1) & 7;
            unsigned char* wl = ws + WS_W + (size_t)l * W_LSTRIDE;
            pg8::StaticOrder S;
            if (sub == 0) { if (PMASK & 4) {
                { pg8::Gemm g{XB, (const bf16_t*)(wl + W_IN), MP, DIN, DM}; S.init(MP, DIN, G, bx);
                  EpiScale<0> E{(bf16_t*)(ws + WS_Z), DIN, SS};
                  for (int rep = 0; rep < ((DUPMASK & 256) ? 2 : 1); ++rep) pg8::gemm_phase<EpiScale<0>, pg8::StaticOrder, true, true>(lds, g, S, E); }
                if (l == 0) { pg8::Gemm g{(const bf16_t*)(ws + WS_MEMB), (const bf16_t*)(ws + WS_WKV), MM, 4096, DM}; S.init(MM, 4096, G, bx);
                  EpiKV E{(const float*)(ws + WS_MEMSS), a->out + O_MK, a->out + O_MV, (bf16_t*)(ws + WS_KP), (bf16_t*)(ws + WS_VT)};
                  pg8::gemm_phase<EpiKV, pg8::StaticOrder, true, true>(lds, g, S, E); }
                sgemm_phase_p<0, true, 2>(XS, DM, (const bf16_t*)(wl + W_IN), DIN, (float*)(ws + WS_ZS) + (size_t)l * NS * DIN, nullptr, (float*)(ws + WS_SSQ) + (l * 3 + 0) * NS, ws, bx, G, wave, lane);
            } } else if (sub == 1) {
                for (int rep = 0; rep < ((DUPMASK & 4) ? 2 : 1); ++rep) for (int u = bx; u < 256; u += G) mixer_unit(a, l, u, lds, wave, lane);
                { const int gwr = (G - 1 - bx) * NWAVES + wave; if ((PMASK & 16) && gwr < NS) mixer_sample(a, l, gwr, lds, wave, lane); }
            } else if (sub == 2 || sub == 5 || sub == 7) { if (PMASK & 32) {
                const bf16_t* A = (const bf16_t*)(ws + (sub == 2 ? WS_Y : sub == 5 ? WS_O : WS_H));
                const bf16_t* Bt = (const bf16_t*)(wl + (sub == 2 ? W_OUT : sub == 5 ? W_O : W_F2));
                const int K = sub == 7 ? DFF : DM;
                pg8::Gemm g{A, Bt, MP, DM, K}; S.init(MP, DM, G, bx);
                EpiRes E{XB, SS};
                pg8::gemm_phase<EpiRes, pg8::StaticOrder, true, true>(lds, g, S, E);

                if (sub == 7) sgemm_phase_p<1, false, 2>((const float*)(ws + WS_HS) + (size_t)l * NS * DFF, DFF, Bt, DM, XS, (const float*)(ws + WS_SSQ) + (l * 3 + 2) * NS, nullptr, ws, bx, G, wave, lane);
                else sgemm_phase_p<0, false, 1>(sub == 2 ? YS : OS, DM, Bt, DM, XS, nullptr, nullptr, ws, bx, G, wave, lane);
            } } else if (sub == 3) { if (PMASK & 64) {
                pg8::Gemm g{XB, (const bf16_t*)(wl + W_Q), MP, DM, DM}; S.init(MP, DM, G, bx);
                EpiScale<1> E{(bf16_t*)(ws + WS_Q), DM, SS};
                for (int rep = 0; rep < ((DUPMASK & 512) ? 2 : 1); ++rep) pg8::gemm_phase<EpiScale<1>, pg8::StaticOrder, true, true>(lds, g, S, E);
                sgemm_phase_p<0, true, 1>(XS, DM, (const bf16_t*)(wl + W_Q), DM, (float*)(ws + WS_QS) + (size_t)l * NS * DM, nullptr, (float*)(ws + WS_SSQ) + (l * 3 + 1) * NS, ws, bx, G, wave, lane);
            } } else if (sub == 4) {
                for (int rep = 0; rep < ((DUPMASK & 1) ? 2 : 1); ++rep) for (int u = bx; u < 256; u += G) attn_unit(a, l, u, wave, lane);
                for (int rep = 0; rep < ((DUPMASK & 2) ? 2 : 1); ++rep) for (int u = bx; u < 256; u += G) attn_sample_unit(a, l, u, lds, wave, lane);
            } else { if (PMASK & 512) {
                pg8::Gemm g{XB, (const bf16_t*)(wl + W_F1), MP, DFF, DM}; S.init(MP, DFF, G, bx);
                EpiScale<2> E{(bf16_t*)(ws + WS_H), DFF, SS};
                for (int rep = 0; rep < ((DUPMASK & 32) ? 2 : 1); ++rep) pg8::gemm_phase<EpiScale<2>, pg8::StaticOrder, true, true>(lds, g, S, E);
                sgemm_phase_p<0, true, 4>(XS, DM, (const bf16_t*)(wl + W_F1), DFF, (float*)(ws + WS_HS) + (size_t)l * NS * DFF, nullptr, (float*)(ws + WS_SSQ) + (l * 3 + 2) * NS, ws, bx, G, wave, lane);
            } }
        }
        if (ph + 1 < ph_hi) { if (ph >= N_PHASES) grid.sync();   else { xcd_barrier(xbar); if (DUPMASK & 16) xcd_barrier(xbar); } }
    }
}

#ifndef N_LAUNCH_MODE
#define N_LAUNCH_MODE 1
#endif
extern "C" void kernel_launch(void* const* d_in, const int* in_sizes, int n_in, void* d_out, int out_size, void* d_ws, size_t ws_size, hipStream_t stream) {
    static int grid = 0;
    if (grid == 0) {
        if (n_in != N_IN || (size_t)out_size != O_END || ws_size < WS_END + 106 * MiB) { fprintf(stderr, "kernel_launch: unexpected sizes n_in %d out %d ws %zu\n", n_in, out_size, ws_size); grid = -1; return; }
        int dev = 0, cus = 0, per_cu = 0;
        if (hipGetDevice(&dev) != hipSuccess || hipDeviceGetAttribute(&cus, hipDeviceAttributeMultiprocessorCount, dev) != hipSuccess) { grid = -1; return; }
        if (hipFuncSetAttribute((const void*)fwd_kernel, hipFuncAttributeMaxDynamicSharedMemorySize, LDS_BYTES) != hipSuccess) { fprintf(stderr, "kernel_launch: hipFuncSetAttribute failed\n"); grid = -1; return; }
        if (hipOccupancyMaxActiveBlocksPerMultiprocessor(&per_cu, (const void*)fwd_kernel, NTHR, LDS_BYTES) != hipSuccess || per_cu < 1) { fprintf(stderr, "kernel_launch: occupancy query says %d\n", per_cu); per_cu = 1; }
        (void)hipGetLastError();
        grid = cus;
    }
    if (grid < 0) return;
    if (hipMemsetAsync((char*)d_ws + WS_CTL, 0, CTL_ZERO_BYTES, stream) != hipSuccess) { fprintf(stderr, "kernel_launch: memset failed\n"); return; }
    Args a{};
    for (int i = 0; i < N_IN; ++i) a.in[i] = (const float*)d_in[i];
    a.out = (float*)d_out; a.ws = (unsigned char*)d_ws;
#if N_LAUNCH_MODE == 1
    a.ph_lo = 0; a.ph_hi = N_PHASES;
    void* args[] = {&a};
    hipError_t e = hipLaunchCooperativeKernel((const void*)fwd_kernel, dim3(grid), dim3(NTHR), args, LDS_BYTES, stream);
    if (e != hipSuccess) fprintf(stderr, "cooperative launch failed: %s (grid %d)\n", hipGetErrorString(e), grid);
#else
    for (int ph = 0; ph < N_PHASES; ++ph) {
        a.ph_lo = ph; a.ph_hi = ph + 1;
        hipLaunchKernelGGL(fwd_kernel, dim3(grid), dim3(NTHR), LDS_BYTES, stream, a);
    }
#endif
}
```

```cpp
#define DUPMASK 0
#include <hip/hip_runtime.h>
#include <hip/hip_cooperative_groups.h>
#include <cstdio>
#include <cstdint>
namespace cg = cooperative_groups;
namespace pg8 {
#define PG8_LAS __attribute__((address_space(3)))
typedef unsigned short bf16_t;
typedef short bf16x8 __attribute__((ext_vector_type(8)));
typedef float f32x4 __attribute__((ext_vector_type(4)));
typedef unsigned u32x4 __attribute__((ext_vector_type(4)));
constexpr int BM = 256, BK = 64, HALF = 128, HTB = HALF * BK * 2  , STAGE_BYTES = 8 * HTB, NXCD = 8, WGM = 8;

__host__ __device__ __forceinline__ int lds_byte(int r, int c) { const int st = (r >> 4) * 2 + (c >> 5), rr = r & 15, cc = c & 31, ob = rr * 64 + cc * 2; return st * 1024 + (ob ^ (((ob >> 9) & 1) << 5)); }
__host__ __device__ __forceinline__ void stage_rc(int b, int& R, int& C) { const int st = b / 1024, sb = b % 1024, swz = sb ^ (((sb >> 9) & 1) << 5); R = (st >> 1) * 16 + swz / 64; C = (st & 1) * 32 + (swz % 64) / 2; }
__host__ __device__ __forceinline__ int perm32(int rho) { const int n = rho >> 4, i = rho & 15; return 8 * (i >> 2) + 4 * n + (i & 3); }

struct Unit { int pm, pn; };
struct Gemm { const bf16_t* A; const bf16_t* Bt; int M, N, K; };

struct StaticOrder {
    int nM, nN, nwg, G, c;
    __host__ __device__ void init(int M, int N, int G_, int c_) { nM = M / BM; nN = N / BM; nwg = nM * nN; G = G_; c = c_; }
    __host__ __device__ bool next(int i, Unit& u) const {
        const long L = (long)i * G + c; if (L >= nwg) return false;
        int wgid = (int)L; { const int q = nwg / NXCD, r = nwg % NXCD, xcd = wgid % NXCD, off = wgid / NXCD; wgid = (xcd < r ? xcd * (q + 1) : r * (q + 1) + (xcd - r) * q) + off; }
        const int nig = WGM * nN, gid = wgid / nig, fm = gid * WGM, gsz = (nM - fm) < WGM ? (nM - fm) : WGM;
        u.pm = fm + ((wgid % nig) % gsz); u.pn = (wgid % nig) / gsz; return true;
    }
    __device__ __forceinline__ void a_ready(const Unit&) const {}
    __device__ __forceinline__ void done(const Unit&) const {}
};

__device__ __forceinline__ unsigned cvt_pk_bf16(float lo, float hi) { unsigned r; asm volatile("v_cvt_pk_bf16_f32 %0, %1, %2" : "=v"(r) : "v"(lo), "v"(hi)); return r; }
typedef float f32x2 __attribute__((ext_vector_type(2)));
template <class Epi, class Sched, bool ALIGN_EPI = false, bool SP2 = false>
__device__ __forceinline__ void gemm_phase(PG8_LAS unsigned char* lds, const Gemm g, const Sched& S, const Epi& E) {
    int tid = threadIdx.x; asm volatile("" : "+v"(tid)); const int wid = __builtin_amdgcn_readfirstlane(tid >> 6), lane = tid & 63, wr = wid >> 2, wc = wid & 3, fr = lane & 15, fq = lane >> 4;
    const int K = g.K, nt = K / BK;
    unsigned voffA[2], voffB[2];
#pragma unroll
    for (int i = 0; i < 2; ++i) { int R, C; stage_rc(tid * 16 + i * 8192, R, C); const int Rb = Epi::PERM ? ((R & ~31) + perm32(R & 31)) : R;
        voffA[i] = (unsigned)(R * K + C) * 2u; voffB[i] = (unsigned)(Rb * K + C) * 2u; }
    const size_t kstep = (size_t)(BK * 2);
    const size_t hstep = (size_t)HALF * K * 2;
    const size_t tstep = 2 * hstep;
    const unsigned ldsw = (unsigned)wid * 1024u;
    const int aoff = lds_byte(wr * 64 + fr, fq * 8), boff = lds_byte(wc * 32 + fr, fq * 8);
#define PG8_SA(b, h) (((b) * 2 + (h)) * HTB)
#define PG8_SB(b, h) ((4 + (b) * 2 + (h)) * HTB)
#define PG8_STAGE(bufoff, gbase, voff) do { _Pragma("unroll") for (int _i = 0; _i < 2; ++_i) \
        __builtin_amdgcn_global_load_lds((const unsigned*)((const char*)(gbase) + (voff)[_i]), (PG8_LAS unsigned*)(lds + (bufoff) + ldsw + _i * 8192), 16, 0, 0); } while (0)
#define PG8_LDA(dst, b, h) do { _Pragma("unroll") for (int m = 0; m < 4; ++m) _Pragma("unroll") for (int k = 0; k < 2; ++k) dst[m][k] = *(const PG8_LAS bf16x8*)(lds + PG8_SA(b, h) + aoff + m * 2048 + k * 1024); } while (0)
#define PG8_LDB(dst, b, h) do { _Pragma("unroll") for (int n = 0; n < 2; ++n) _Pragma("unroll") for (int k = 0; k < 2; ++k) dst[n][k] = *(const PG8_LAS bf16x8*)(lds + PG8_SB(b, h) + boff + n * 2048 + k * 1024); } while (0)
#define PG8_MMA(ai, bj, At, Bt) do { __builtin_amdgcn_s_setprio(1); _Pragma("unroll") for (int m = 0; m < 4; ++m) _Pragma("unroll") for (int n = 0; n < 2; ++n) _Pragma("unroll") for (int k = 0; k < 2; ++k) \
        acc[ai][bj][m][n] = __builtin_amdgcn_mfma_f32_16x16x32_bf16(Bt[n][k], At[m][k], acc[ai][bj][m][n], 0, 0, 0); __builtin_amdgcn_s_setprio(0); } while (0)
#define PG8_WAIT_V(n) asm volatile("s_waitcnt vmcnt(" #n ")" ::: "memory")
#define PG8_WAIT_L(n) asm volatile("s_waitcnt lgkmcnt(" #n ")" ::: "memory")
#define PG8_BAR __builtin_amdgcn_s_barrier()
#define PG8_SCHED __builtin_amdgcn_sched_barrier(0)
    Unit cur, nxt; int ui = 0;
    if (!S.next(0, cur)) return;
    f32x4 acc[2][2][4][2];
#pragma unroll
    for (int a = 0; a < 2; ++a)
#pragma unroll
        for (int b = 0; b < 2; ++b)
#pragma unroll
            for (int m = 0; m < 4; ++m)
#pragma unroll
                for (int n = 0; n < 2; ++n) acc[a][b][m][n] = (f32x4){0.f, 0.f, 0.f, 0.f};
    bf16x8 At[4][2], B0[2][2], B1[2][2];
    const char* cA = (const char*)g.A + (size_t)cur.pm * tstep; const char* cB = (const char*)g.Bt + (size_t)cur.pn * tstep;
    S.a_ready(cur);
    if constexpr (SP2) {
        PG8_STAGE(PG8_SB(0, 0), cB, voffB); PG8_STAGE(PG8_SB(0, 1), cB + hstep, voffB); PG8_STAGE(PG8_SA(0, 0), cA, voffA); PG8_STAGE(PG8_SA(0, 1), cA + hstep, voffA);
        if (wr == 1) PG8_BAR;
        PG8_WAIT_V(2); PG8_BAR;
        PG8_STAGE(PG8_SB(1, 0), cB + kstep, voffB); PG8_STAGE(PG8_SA(1, 0), cA + kstep, voffA); PG8_STAGE(PG8_SB(1, 1), cB + hstep + kstep, voffB);
        PG8_WAIT_V(6); PG8_BAR;
    } else {
        PG8_STAGE(PG8_SB(0, 0), cB, voffB); PG8_STAGE(PG8_SA(0, 0), cA, voffA); PG8_STAGE(PG8_SB(0, 1), cB + hstep, voffB); PG8_STAGE(PG8_SA(0, 1), cA + hstep, voffA);
        if (wr == 1) PG8_BAR;
        PG8_WAIT_V(4); PG8_BAR;
        PG8_STAGE(PG8_SB(1, 0), cB + kstep, voffB); PG8_STAGE(PG8_SA(1, 0), cA + kstep, voffA); PG8_STAGE(PG8_SB(1, 1), cB + hstep + kstep, voffB);
        PG8_WAIT_V(6); PG8_BAR;
    }
    for (;;) {
        const bool has_next = S.next(ui + 1, nxt);
        const char* nA = has_next ? (const char*)g.A + (size_t)nxt.pm * tstep : cA; const char* nB = has_next ? (const char*)g.Bt + (size_t)nxt.pn * tstep : cB;
        for (int t = 0; t < nt; t += 2) {
            const bool last = (t == nt - 2);
            const char* a1 = cA + (size_t)(t + 1) * kstep;
            const char* a2 = last ? nA : cA + (size_t)(t + 2) * kstep; const char* b2 = last ? nB : cB + (size_t)(t + 2) * kstep;
            const char* a3 = a2 + kstep; const char* b3 = b2 + kstep;
            if (last && has_next) S.a_ready(nxt);
            if constexpr (SP2) {
            PG8_LDB(B0, 0, 0); PG8_LDB(B1, 0, 1); PG8_SCHED; PG8_LDA(At, 0, 0); PG8_STAGE(PG8_SA(1, 1), a1 + hstep, voffA);
            PG8_WAIT_V(8); PG8_WAIT_L(0); PG8_BAR; PG8_MMA(0, 0, At, B0); PG8_MMA(0, 1, At, B1); PG8_BAR; PG8_SCHED;
            PG8_LDA(At, 0, 1); PG8_STAGE(PG8_SB(0, 0), b2, voffB); PG8_STAGE(PG8_SB(0, 1), b2 + hstep, voffB); PG8_STAGE(PG8_SA(0, 0), a2, voffA);
            PG8_WAIT_V(8); PG8_WAIT_L(0); PG8_BAR; PG8_MMA(1, 0, At, B0); PG8_MMA(1, 1, At, B1); PG8_BAR; PG8_SCHED;
            PG8_LDB(B0, 1, 0); PG8_LDB(B1, 1, 1); PG8_SCHED; PG8_LDA(At, 1, 0); PG8_STAGE(PG8_SA(0, 1), a2 + hstep, voffA);
            PG8_WAIT_V(8); PG8_WAIT_L(0); PG8_BAR; PG8_MMA(0, 0, At, B0); PG8_MMA(0, 1, At, B1); PG8_BAR; PG8_SCHED;
            PG8_LDA(At, 1, 1); PG8_STAGE(PG8_SB(1, 0), b3, voffB); PG8_STAGE(PG8_SB(1, 1), b3 + hstep, voffB); PG8_STAGE(PG8_SA(1, 0), a3, voffA);
            PG8_WAIT_V(8); PG8_WAIT_L(0); PG8_BAR; PG8_MMA(1, 0, At, B0); PG8_MMA(1, 1, At, B1); PG8_BAR; PG8_SCHED;
            } else {
            PG8_LDB(B0, 0, 0); PG8_SCHED; PG8_LDA(At, 0, 0); PG8_STAGE(PG8_SA(1, 1), a1 + hstep, voffA);
            PG8_WAIT_L(8); PG8_BAR; PG8_WAIT_L(0); PG8_MMA(0, 0, At, B0); PG8_BAR; PG8_SCHED;
            PG8_LDB(B1, 0, 1); PG8_STAGE(PG8_SB(0, 0), b2, voffB);
            PG8_BAR; PG8_WAIT_L(0); PG8_MMA(0, 1, At, B1); PG8_BAR;
            PG8_LDA(At, 0, 1); PG8_STAGE(PG8_SA(0, 0), a2, voffA);
            PG8_BAR; PG8_WAIT_L(0); PG8_MMA(1, 0, At, B0); PG8_BAR; PG8_SCHED;
            PG8_STAGE(PG8_SB(0, 1), b2 + hstep, voffB);
            PG8_WAIT_V(6); PG8_BAR; PG8_MMA(1, 1, At, B1); PG8_BAR;
            PG8_LDB(B0, 1, 0); PG8_SCHED; PG8_LDA(At, 1, 0); PG8_STAGE(PG8_SA(0, 1), a2 + hstep, voffA);
            PG8_WAIT_L(8); PG8_BAR; PG8_WAIT_L(0); PG8_MMA(0, 0, At, B0); PG8_BAR; PG8_SCHED;
            PG8_LDB(B1, 1, 1); PG8_STAGE(PG8_SB(1, 0), b3, voffB);
            PG8_BAR; PG8_WAIT_L(0); PG8_MMA(0, 1, At, B1); PG8_BAR;
            PG8_LDA(At, 1, 1); PG8_STAGE(PG8_SA(1, 0), a3, voffA);
            PG8_BAR; PG8_WAIT_L(0); PG8_MMA(1, 0, At, B0); PG8_BAR; PG8_SCHED;
            PG8_STAGE(PG8_SB(1, 1), b3 + hstep, voffB);
            PG8_WAIT_V(6); PG8_BAR; PG8_MMA(1, 1, At, B1); PG8_BAR;
            }
        }
        if constexpr (ALIGN_EPI) { if (wr == 0) PG8_BAR; }
        if constexpr (!Epi::AFTER_DRAIN) { E(acc, cur, wr, wc, fr, fq); S.done(cur); }
        if (!has_next) break;
#pragma unroll
        for (int a = 0; a < 2; ++a)
#pragma unroll
            for (int b = 0; b < 2; ++b)
#pragma unroll
                for (int m = 0; m < 4; ++m)
#pragma unroll
                    for (int n = 0; n < 2; ++n) acc[a][b][m][n] = (f32x4){0.f, 0.f, 0.f, 0.f};
        cur = nxt; cA = nA; cB = nB; ++ui;
        if constexpr (ALIGN_EPI) { if (wr == 1) PG8_BAR; }
    }
    PG8_WAIT_V(0);
    if constexpr (!ALIGN_EPI) { if (wr == 0) PG8_BAR; }
    PG8_BAR;
    if constexpr (Epi::AFTER_DRAIN) { E.fused(acc, cur, wr, wc, fr, fq, lds, wid, lane); S.done(cur); }
#undef PG8_SA
#undef PG8_SB
#undef PG8_STAGE
#undef PG8_LDA
#undef PG8_LDB
#undef PG8_MMA
#undef PG8_WAIT_V
#undef PG8_WAIT_L
#undef PG8_BAR
#undef PG8_SCHED
}
}

#define DI __device__ __forceinline__
#define LAS __attribute__((address_space(3)))
typedef unsigned short bf16_t;
typedef short bf16x8 __attribute__((ext_vector_type(8)));
typedef float f32x4 __attribute__((ext_vector_type(4)));
typedef float f32x16 __attribute__((ext_vector_type(16)));
typedef unsigned u32x4 __attribute__((ext_vector_type(4)));
typedef unsigned u32x2 __attribute__((ext_vector_type(2)));
typedef float f32x2_t __attribute__((ext_vector_type(2)));
typedef __bf16 bf16x2_t __attribute__((ext_vector_type(2)));

constexpr int DM = 1024, NB = 8, SEQ = 2048, MP = NB * SEQ, NL = 2, NS = 128, MEM = 256, MM = NB * MEM, DG = 256, DIN = 2048, DFF = 4096;
constexpr float EPS = 1e-6f;
constexpr int NWAVES = 8, NTHR = 512;
constexpr int LDS_BYTES = 147456;

constexpr size_t MiB = 1u << 20;
constexpr size_t WS_W = 2 * MiB, W_LSTRIDE = 28 * MiB;
constexpr size_t W_IN = 0, W_OUT = 4 * MiB, W_Q = 6 * MiB, W_O = 8 * MiB, W_F1 = 10 * MiB, W_F2 = 18 * MiB, W_GWS = 26 * MiB, W_PWT = 26 * MiB + 512 * 1024;
constexpr size_t WS_WKV = 58 * MiB;
constexpr size_t WS_MEMB = 66 * MiB;
constexpr size_t WS_MEMSS = 70 * MiB;
constexpr size_t WS_SS = 71 * MiB;
constexpr size_t WS_XB = 72 * MiB;
constexpr size_t WS_Z = 104 * MiB;
constexpr size_t WS_Y = 168 * MiB;
constexpr size_t WS_Q = 200 * MiB;
constexpr size_t WS_O = 232 * MiB;
constexpr size_t WS_H = 264 * MiB;
constexpr size_t WS_KP = 392 * MiB;
constexpr size_t WS_VT = 400 * MiB;
constexpr size_t WS_XS = 408 * MiB, WS_YS = 408 * MiB + 512 * 1024, WS_OS = 409 * MiB, WS_SSQ = 409 * MiB + 512 * 1024  , WS_ZS = 410 * MiB  , WS_QS = 412 * MiB  , WS_HS = 413 * MiB  , WS_END = 417 * MiB;
constexpr size_t WS_CTL = 0, CTL_ZERO_BYTES = 65536;

constexpr size_t O_YP = 0, O_YS = O_YP + (size_t)MP * DM, O_MK = O_YS + (size_t)NS * DM, O_MV = O_MK + (size_t)NL * MM * DM, O_GLUP = O_MV + (size_t)NL * MM * DM,
                 O_GLUS = O_GLUP + (size_t)NL * NB * 30 * DG, O_SHP = O_GLUS + (size_t)NL * NS * 30 * DG, O_SHS = O_SHP + (size_t)NL * NB * 2 * DG,
                 O_PLP = O_SHS + (size_t)NL * NS * 2 * DG, O_PLS = O_PLP + (size_t)NL * NB * 15 * DG, O_GV = O_PLS + (size_t)NL * NS * 15 * DG, O_END = O_GV + (size_t)NL * NS * DG;

enum { I_XP = 0, I_XS, I_MEM, I_CK, I_CV, I_SGLU, I_SSH, I_SPL, I_NMIX, I_WIN, I_LNG, I_LNB, I_GWS, I_GBS, I_CDW, I_CDWB, I_CLNG, I_CLNB, I_SCDW, I_PW, I_PSC, I_MOG, I_WOUT,
       I_NXA, I_NMEM, I_WQ, I_WK, I_WV, I_WO, I_NFF, I_WF1, I_WF2, I_NFIN, N_IN };

DI unsigned pk2(float lo, float hi) { f32x2_t v = {lo, hi}; bf16x2_t b = __builtin_convertvector(v, bf16x2_t); return __builtin_bit_cast(unsigned, b); }
DI float bf2f(unsigned short u) { return __uint_as_float((unsigned)u << 16); }
DI float bflo(unsigned u) { return __uint_as_float(u << 16); }
DI float bfhi(unsigned u) { return __uint_as_float(u & 0xffff0000u); }
DI f32x4 ld_bf4(const bf16_t* p) { const u32x2 w = *(const u32x2*)p; return (f32x4){bflo(w.x), bfhi(w.x), bflo(w.y), bfhi(w.y)}; }
DI void st_bf4(bf16_t* p, f32x4 v) { u32x2 w; w.x = pk2(v.x, v.y); w.y = pk2(v.z, v.w); *(u32x2*)p = w; }
DI float wave_sum(float v) {
#pragma unroll
    for (int o = 1; o < 64; o <<= 1) v += __shfl_xor(v, o);
    return v;
}
DI float hsum4(f32x4 v) { return (v.x + v.y) + (v.z + v.w); }
DI float hsq4(f32x4 v) { return (v.x * v.x + v.y * v.y) + (v.z * v.z + v.w * v.w); }
DI float sigmoidf_(float x) { return 1.0f / (1.0f + __expf(-x)); }
DI float row_rs(const float* ss16) {
    const f32x4* sp = (const f32x4*)ss16; const f32x4 a = sp[0], b = sp[1], c = sp[2], d = sp[3];
    const float s = (hsum4(a) + hsum4(b)) + (hsum4(c) + hsum4(d));
    return rsqrtf(s * (1.0f / DM) + EPS);
}

template <int MODE  > struct EpiScale {
    static constexpr bool PERM = true, AFTER_DRAIN = false;
    bf16_t* O; int ldc; const float* ss;
    DI void operator()(const f32x4 (&acc)[2][2][4][2], const pg8::Unit& u, int wr, int wc, int fr, int fq) const {
        const int row0 = u.pm * 256 + wr * 64 + fr, col0 = u.pn * 256 + wc * 32 + 8 * fq;
#pragma unroll
        for (int ai = 0; ai < 2; ++ai)
#pragma unroll
            for (int m = 0; m < 4; ++m) {
                const int row = row0 + ai * 128 + m * 16;
                float rs = row_rs(ss + (size_t)row * 16); if (MODE == 1) rs *= 0.0625f;
                bf16_t* rowp = O + (size_t)row * ldc + col0;
#pragma unroll
                for (int bj = 0; bj < 2; ++bj) {
                    f32x4 v0 = acc[ai][bj][m][0] * rs, v1 = acc[ai][bj][m][1] * rs;
                    if (MODE == 2) {
#pragma unroll
                        for (int j = 0; j < 4; ++j) { float a = fmaxf(v0[j], 0.f), b = fmaxf(v1[j], 0.f); v0[j] = a * a; v1[j] = b * b; }
                    }
                    u32x4 w; w.x = pk2(v0[0], v0[1]); w.y = pk2(v0[2], v0[3]); w.z = pk2(v1[0], v1[1]); w.w = pk2(v1[2], v1[3]);
                    *(u32x4*)(rowp + bj * 128) = w;
                }
            }
    }
};
struct EpiKV {
    static constexpr bool PERM = true, AFTER_DRAIN = false;
    const float* mss; float* outK; float* outV; bf16_t* KP; bf16_t* VT;
    DI void operator()(const f32x4 (&acc)[2][2][4][2], const pg8::Unit& u, int wr, int wc, int fr, int fq) const {
        const int l = u.pn >> 3, w8 = u.pn & 7, isV = w8 >> 2, h = w8 & 3, b = u.pm;
        const int row0 = u.pm * 256 + wr * 64 + fr, colh0 = h * 256 + wc * 32 + 8 * fq;
        float* outp = (isV ? outV : outK) + (size_t)l * MM * DM;
#pragma unroll
        for (int ai = 0; ai < 2; ++ai)
#pragma unroll
            for (int m = 0; m < 4; ++m) {
                const int row = row0 + ai * 128 + m * 16;
                const float rs = rsqrtf(mss[row] * (1.0f / DM) + EPS);
#pragma unroll
                for (int bj = 0; bj < 2; ++bj) {
                    const int colh = colh0 + bj * 128;
                    const f32x4 v0 = acc[ai][bj][m][0] * rs, v1 = acc[ai][bj][m][1] * rs;
                    *(f32x4*)(outp + (size_t)row * DM + colh) = v0; *(f32x4*)(outp + (size_t)row * DM + colh + 4) = v1;
                    if (!isV) {
                        u32x4 w; w.x = pk2(v0[0], v0[1]); w.y = pk2(v0[2], v0[3]); w.z = pk2(v1[0], v1[1]); w.w = pk2(v1[2], v1[3]);
                        *(u32x4*)(KP + ((size_t)l * MM + row) * DM + colh) = w;
                    } else {
                        bf16_t* vt = VT + ((size_t)((l * NB + b) * 4 + h) * 256 + (colh & 255)) * 256 + (row & 255);
#pragma unroll
                        for (int j = 0; j < 4; ++j) { vt[(size_t)j * 256] = (bf16_t)(pk2(v0[j], 0.f) & 0xffffu); vt[(size_t)(j + 4) * 256] = (bf16_t)(pk2(v1[j], 0.f) & 0xffffu); }
                    }
                }
            }
    }
};
struct EpiRes {
    static constexpr bool PERM = true, AFTER_DRAIN = false;
    bf16_t* xb; float* ss;
    DI void operator()(const f32x4 (&acc)[2][2][4][2], const pg8::Unit& u, int wr, int wc, int fr, int fq) const {
        const int row0 = u.pm * 256 + wr * 64 + fr, col0 = u.pn * 256 + wc * 32 + 8 * fq;
#pragma unroll
        for (int ai = 0; ai < 2; ++ai)
#pragma unroll
            for (int m = 0; m < 4; ++m) {
                const int row = row0 + ai * 128 + m * 16; bf16_t* rowp = xb + (size_t)row * DM + col0;
                const u32x4 o0 = *(const u32x4*)rowp, o1 = *(const u32x4*)(rowp + 128);
                float sq = 0.f;
#pragma unroll
                for (int bj = 0; bj < 2; ++bj) {
                    const u32x4 ov = bj ? o1 : o0;
                    f32x4 v0 = acc[ai][bj][m][0], v1 = acc[ai][bj][m][1];
                    v0.x += bflo(ov.x); v0.y += bfhi(ov.x); v0.z += bflo(ov.y); v0.w += bfhi(ov.y);
                    v1.x += bflo(ov.z); v1.y += bfhi(ov.z); v1.z += bflo(ov.w); v1.w += bfhi(ov.w);
                    sq += hsq4(v0) + hsq4(v1);
                    u32x4 w; w.x = pk2(v0[0], v0[1]); w.y = pk2(v0[2], v0[3]); w.z = pk2(v1[0], v1[1]); w.w = pk2(v1[2], v1[3]);
                    *(u32x4*)(rowp + bj * 128) = w;
                }
                sq += __shfl_xor(sq, 16); sq += __shfl_xor(sq, 32);
                if (fq == 0) ss[(size_t)row * 16 + u.pn * 4 + wc] = sq;
                asm volatile("" ::: "memory");
            }
    }
};

template <int AMODE, bool SSQ, int NSL> DI void sgemm_item(const float* A, int lda, const bf16_t* Bt, int ldb, int n0, int kbase, float* Out, int ldo, const float* ssq_in, float* ssq_out, int wave, int lane) {
    const int r = lane & 15, q = lane >> 4;
    const float* ap = A + (size_t)(16 * wave + r) * lda + kbase + 16 * q;
    const bf16_t* bp = Bt + (size_t)(n0 + r) * ldb + kbase + 16 * q;
    f32x4 av[4][4]; bf16x8 bv[NSL][4][2];
#pragma unroll
    for (int c = 0; c < 4; ++c)
#pragma unroll
        for (int i = 0; i < 4; ++i) av[c][i] = *(const f32x4*)(ap + 64 * c + 4 * i);
#pragma unroll
    for (int sl = 0; sl < NSL; ++sl)
#pragma unroll
        for (int c = 0; c < 4; ++c) { bv[sl][c][0] = *(const bf16x8*)(bp + (size_t)sl * 16 * ldb + 64 * c); bv[sl][c][1] = *(const bf16x8*)(bp + (size_t)sl * 16 * ldb + 64 * c + 8); }
    float rsA = 1.f; if (AMODE == 1) rsA = rsqrtf(ssq_in[16 * wave + r] * (1.0f / DM) + EPS);
    f32x4 acc[NSL]; float ssq = 0.f;
#pragma unroll
    for (int sl = 0; sl < NSL; ++sl) acc[sl] = (f32x4){0.f, 0.f, 0.f, 0.f};
#pragma unroll
    for (int c = 0; c < 4; ++c) {
        if (AMODE == 1) {
#pragma unroll
            for (int i = 0; i < 4; ++i)
#pragma unroll
                for (int j = 0; j < 4; ++j) { const float t = fmaxf(av[c][i][j] * rsA, 0.f); av[c][i][j] = t * t; }
        }
        if (SSQ) ssq += (hsq4(av[c][0]) + hsq4(av[c][1])) + (hsq4(av[c][2]) + hsq4(av[c][3]));
        u32x4 p0, p1; p0.x = pk2(av[c][0].x, av[c][0].y); p0.y = pk2(av[c][0].z, av[c][0].w); p0.z = pk2(av[c][1].x, av[c][1].y); p0.w = pk2(av[c][1].z, av[c][1].w);
        p1.x = pk2(av[c][2].x, av[c][2].y); p1.y = pk2(av[c][2].z, av[c][2].w); p1.z = pk2(av[c][3].x, av[c][3].y); p1.w = pk2(av[c][3].z, av[c][3].w);
#pragma unroll
        for (int sl = 0; sl < NSL; ++sl) {
            acc[sl] = __builtin_amdgcn_mfma_f32_16x16x32_bf16(__builtin_bit_cast(bf16x8, p0), bv[sl][c][0], acc[sl], 0, 0, 0);
            acc[sl] = __builtin_amdgcn_mfma_f32_16x16x32_bf16(__builtin_bit_cast(bf16x8, p1), bv[sl][c][1], acc[sl], 0, 0, 0);
        }
    }
    if (SSQ) { if (n0 == 0) { ssq += __shfl_xor(ssq, 16); ssq += __shfl_xor(ssq, 32); if (q == 0) unsafeAtomicAdd(ssq_out + 16 * wave + r, ssq); } }
#pragma unroll
    for (int sl = 0; sl < NSL; ++sl)
#pragma unroll
        for (int j = 0; j < 4; ++j) unsafeAtomicAdd(Out + (size_t)(16 * wave + 4 * q + j) * ldo + n0 + 16 * sl + r, acc[sl][j]);
}
template <int AMODE, bool SSQ, int NSL> DI void sgemm_phase(const float* A, int K, const bf16_t* Bt, int N, float* Out, const float* ssq_in, float* ssq_out, int bx, int G, int wave, int lane) {
    const int ng = N / (16 * NSL), nit = ng * (K / 256);
    for (int it = bx; it < nit; it += G) { const int sg = it % ng, kp = it / ng; sgemm_item<AMODE, SSQ, NSL>(A, K, Bt, K, sg * 16 * NSL, kp * 256, Out, N, ssq_in, ssq_out, wave, lane); }
}
template <int AMODE, bool SSQ, int NSL> DI void sgemm_phase_p(const float* A, int K, const bf16_t* Bt, int N, float* Out, const float* ssq_in, float* ssq_out, unsigned char* ws, int bx, int G, int wave, int lane) {
    sgemm_phase<AMODE, SSQ, NSL>(A, K, Bt, N, Out, ssq_in, ssq_out, bx, G, wave, lane);
    if (DUPMASK & 8) sgemm_phase<AMODE, SSQ, NSL>(A, K, Bt, N, (float*)(ws + WS_END), ssq_in, (float*)(ws + WS_END) + 1024 * 1024, bx, G, wave, lane);
}

DI void p0_transpose_item(const float* W, const float* g, int K, int N, bf16_t* WT, int row_off, LAS float* scr, int item, int lane) {
    const int nblk = N / 32, kb = item / nblk, nb = item % nblk, k0 = 64 * kb, n0 = 32 * nb;
#pragma unroll 8
    for (int i = 0; i < 32; ++i) { const int kk = 2 * i + (lane >> 5); const float gv = g ? g[k0 + kk] : 1.f; scr[kk * 33 + (lane & 31)] = W[(size_t)(k0 + kk) * N + n0 + (lane & 31)] * gv; }
    asm volatile("s_waitcnt lgkmcnt(0)" ::: "memory");
    const int c = lane & 7;
#pragma unroll
    for (int j = 0; j < 4; ++j) { const int n = (lane >> 3) + 8 * j; const LAS float* s = scr + (8 * c) * 33 + n;
        u32x4 o; o.x = pk2(s[0 * 33], s[1 * 33]); o.y = pk2(s[2 * 33], s[3 * 33]); o.z = pk2(s[4 * 33], s[5 * 33]); o.w = pk2(s[6 * 33], s[7 * 33]);
        *(u32x4*)(WT + (size_t)(row_off + n0 + n) * K + k0 + 8 * c) = o; }
    asm volatile("s_waitcnt lgkmcnt(0)" ::: "memory");
}
DI float row_to_bf16(const float* xrow, bf16_t* orow, int lane) {
    const f32x4* xr = (const f32x4*)xrow + lane; float s = 0.f;
#pragma unroll
    for (int j = 0; j < 4; ++j) { const f32x4 v = xr[64 * j]; s += hsq4(v); st_bf4(orow + 4 * lane + 256 * j, v); }
    return wave_sum(s);
}

struct Args { const float* in[N_IN]; float* out; unsigned char* ws; int ph_lo, ph_hi; };
typedef const __attribute__((address_space(4))) Args* AP;

DI void prologue(AP a, LAS unsigned char* lds, int wave, int lane) {
    unsigned char* ws = a->ws;
    LAS float* scr = (LAS float*)(lds + wave * 16384);
    const int gw = blockIdx.x * NWAVES + wave, NGW = gridDim.x * NWAVES;
    constexpr int IT_IN = 16 * 64, IT_SQ = 16 * 32, IT_F1 = 16 * 128, IT_F2 = 64 * 32, IT_L = IT_IN + 5 * IT_SQ + IT_F1 + IT_F2;
    for (int it = gw; it < NL * IT_L; it += NGW) {
        const int l = it / IT_L; int r = it % IT_L;
        unsigned char* wl = ws + WS_W + (size_t)l * W_LSTRIDE;
        if (r < IT_IN) { p0_transpose_item(a->in[I_WIN] + (size_t)l * DM * DIN, a->in[I_NMIX] + l * DM, DM, DIN, (bf16_t*)(wl + W_IN), 0, scr, r, lane); continue; } r -= IT_IN;
        if (r < IT_SQ) { p0_transpose_item(a->in[I_WOUT] + (size_t)l * DM * DM, nullptr, DM, DM, (bf16_t*)(wl + W_OUT), 0, scr, r, lane); continue; } r -= IT_SQ;
        if (r < IT_SQ) { p0_transpose_item(a->in[I_WQ] + (size_t)l * DM * DM, a->in[I_NXA] + l * DM, DM, DM, (bf16_t*)(wl + W_Q), 0, scr, r, lane); continue; } r -= IT_SQ;
        if (r < IT_SQ) { p0_transpose_item(a->in[I_WK] + (size_t)l * DM * DM, a->in[I_NMEM] + l * DM, DM, DM, (bf16_t*)(ws + WS_WKV), l * 2048, scr, r, lane); continue; } r -= IT_SQ;
        if (r < IT_SQ) { p0_transpose_item(a->in[I_WV] + (size_t)l * DM * DM, a->in[I_NMEM] + l * DM, DM, DM, (bf16_t*)(ws + WS_WKV), l * 2048 + 1024, scr, r, lane); continue; } r -= IT_SQ;
        if (r < IT_SQ) { p0_transpose_item(a->in[I_WO] + (size_t)l * DM * DM, nullptr, DM, DM, (bf16_t*)(wl + W_O), 0, scr, r, lane); continue; } r -= IT_SQ;
        if (r < IT_F1) { p0_transpose_item(a->in[I_WF1] + (size_t)l * DM * DFF, a->in[I_NFF] + l * DM, DM, DFF, (bf16_t*)(wl + W_F1), 0, scr, r, lane); continue; } r -= IT_F1;
        p0_transpose_item(a->in[I_WF2] + (size_t)l * DFF * DM, nullptr, DFF, DM, (bf16_t*)(wl + W_F2), 0, scr, r, lane);
    }
    {
        bf16_t* XB = (bf16_t*)(ws + WS_XB); float* SS = (float*)(ws + WS_SS);
        for (int m = gw; m < MP; m += NGW) { const float s = row_to_bf16(a->in[I_XP] + (size_t)m * DM, XB + (size_t)m * DM, lane); if (lane < 16) SS[(size_t)m * 16 + lane] = lane == 0 ? s : 0.f; }
        bf16_t* MB = (bf16_t*)(ws + WS_MEMB); float* MS = (float*)(ws + WS_MEMSS);
        for (int m = gw; m < MM; m += NGW) { const float s = row_to_bf16(a->in[I_MEM] + (size_t)m * DM, MB + (size_t)m * DM, lane); if (lane == 0) MS[m] = s; }
    }
    {
        const int gt = blockIdx.x * NTHR + wave * 64 + lane, NGT = gridDim.x * NTHR;
        for (int i = gt; i < NL * 4 * 128 * 128; i += NGT) { const int l = i >> 16, r = i & 65535, t = (r >> 7) & 127, s = r & 127;
            ((bf16_t*)(ws + WS_W + (size_t)l * W_LSTRIDE + W_GWS))[r] = (bf16_t)(pk2(s <= t ? a->in[I_GWS][i] : 0.f, 0.f) & 0xffffu); }
        for (int i = gt; i < NL * 4 * 64 * 64; i += NGT) { const int l = i >> 14, r = i & 16383, g = r >> 12, d = (r >> 6) & 63, c = r & 63;
            ((bf16_t*)(ws + WS_W + (size_t)l * W_LSTRIDE + W_PWT))[r] = (bf16_t)(pk2(a->in[I_PW][(size_t)l * 16384 + g * 4096 + c * 64 + d], 0.f) & 0xffffu); }
        for (int i = gt; i < NS * DM / 4; i += NGT) ((f32x4*)(ws + WS_XS))[i] = ((const f32x4*)a->in[I_XS])[i];
        for (int i = gt; i < (int)((WS_END - WS_ZS) / 16); i += NGT) ((f32x4*)(ws + WS_ZS))[i] = (f32x4){0.f, 0.f, 0.f, 0.f};
        for (int i = gt; i < NL * 3 * NS; i += NGT) ((float*)(ws + WS_SSQ))[i] = 0.f;
    }
}

#ifndef MIXP
#define MIXP 15
#endif
constexpr int VNT_P = 136;
constexpr int TT_OFF = 69632, TT_P = 260;
constexpr int CW_OFF = 96256;
constexpr int PL_P = 264;

DI void tt_rows_out(LAS unsigned char* lds, bf16_t* Yrow0, const float* mog, int wave, int lane) {
    const LAS float* TT = (const LAS float*)(lds + TT_OFF);
    const f32x4 g = *(const f32x4*)(mog + 4 * lane);
#pragma unroll
    for (int i = 0; i < 8; ++i) {
        const int tt = 8 * wave + i;
        const f32x4 v = *(const LAS f32x4*)(TT + tt * TT_P + 4 * lane);
        const float r = rsqrtf(wave_sum(hsq4(v)) * (1.0f / DG) + EPS);
        st_bf4(Yrow0 + (size_t)tt * DM + 4 * lane, v * r * g);
    }
}

DI void mixer_unit(AP a, int l, int uidx, LAS unsigned char* lds, int wave, int lane) {
    unsigned char* ws = a->ws;
    const int b = uidx >> 5, ju = uidx & 31, t0 = ju * 64, off = t0 & 127, tc = t0 - off;
    const size_t R0 = (size_t)b * SEQ + t0;
    const bf16_t* Z = (const bf16_t*)(ws + WS_Z);
    bf16_t* Y = (bf16_t*)(ws + WS_Y);
    const float* mog = a->in[I_MOG] + l * DM;
    if (MIXP & 1) {
        int lq_ = lane; asm volatile("" : "+v"(lq_)); const int lane = lq_; const int fr = lane & 15, fq = lane >> 4; (void)fr; (void)fq;
        LAS bf16_t* VNT = (LAS bf16_t*)lds;
        const f32x4 lg = *(const f32x4*)(a->in[I_LNG] + l * DG + 4 * lane), lb = *(const f32x4*)(a->in[I_LNB] + l * DG + 4 * lane);
        const int nrow = off + 64;
        for (int s = wave; s < nrow; s += NWAVES) {
            const f32x4 v = ld_bf4(Z + ((size_t)b * SEQ + tc + s) * DIN + 256 + 4 * lane);
            const float mean = wave_sum(hsum4(v)) * (1.0f / DG); const f32x4 d = v - mean;
            const float rstd = rsqrtf(wave_sum(hsq4(d)) * (1.0f / DG) + EPS);
            const f32x4 vn = d * rstd * lg + lb;
#pragma unroll
            for (int i = 0; i < 4; ++i) VNT[(4 * lane + i) * VNT_P + s] = (bf16_t)(pk2(vn[i], 0.f) & 0xffffu);
        }
        __syncthreads();
        const int mt = wave & 3, hp = wave >> 2, tl0 = off + 16 * mt, nks = (tl0 + 16 + 31) >> 5;
        const bf16_t* GW = (const bf16_t*)(ws + WS_W + (size_t)l * W_LSTRIDE + W_GWS);
        LAS float* TT = (LAS float*)(lds + TT_OFF);
#pragma unroll
        for (int hh = 0; hh < 2; ++hh) {
            const int h = 2 * hp + hh;
            f32x4 acc[4];
#pragma unroll
            for (int dt = 0; dt < 4; ++dt) acc[dt] = (f32x4){0.f, 0.f, 0.f, 0.f};
            for (int ks = 0; ks < nks; ++ks) {
                const bf16x8 af = *(const bf16x8*)(GW + ((size_t)h * 128 + tl0 + fr) * 128 + 32 * ks + 8 * fq);
#pragma unroll
                for (int dt = 0; dt < 4; ++dt) {
                    const bf16x8 bfr = *(const LAS bf16x8*)(VNT + (h * 64 + dt * 16 + fr) * VNT_P + 32 * ks + 8 * fq);
                    acc[dt] = __builtin_amdgcn_mfma_f32_16x16x32_bf16(af, bfr, acc[dt], 0, 0, 0);
                }
            }
#pragma unroll
            for (int dt = 0; dt < 4; ++dt)
#pragma unroll
                for (int j = 0; j < 4; ++j) {
                    const int tl = 16 * mt + 4 * fq + j, d = h * 64 + dt * 16 + fr;
                    const float bs = a->in[I_GBS][(l * 4 + h) * 128 + off + tl];
                    const float uu = bf2f(Z[(R0 + tl) * DIN + d]);
                    TT[tl * TT_P + d] = uu * (acc[dt][j] + bs);
                }
        }
        __syncthreads();
        tt_rows_out(lds, Y + R0 * DM + 0 * DG, mog + 0 * DG, wave, lane);
        __syncthreads();
    }
    if (MIXP & 2) {
        int lq_ = lane; asm volatile("" : "+v"(lq_)); const int lane = lq_; const int fr = lane & 15, fq = lane >> 4; (void)fr; (void)fq;
        LAS float* G = (LAS float*)lds; LAS float* CW = (LAS float*)(lds + CW_OFF);
        for (int rr = wave; rr < 94; rr += NWAVES) {
            const int t = t0 - 30 + rr; f32x4 gl = {0.f, 0.f, 0.f, 0.f};
            if (t >= 0) { const bf16_t* zr = Z + ((size_t)b * SEQ + t) * DIN; const f32x4 ga = ld_bf4(zr + 512 + 4 * lane), gg = ld_bf4(zr + 768 + 4 * lane);
#pragma unroll
                for (int i = 0; i < 4; ++i) gl[i] = ga[i] * sigmoidf_(gg[i]); }
            *(LAS f32x4*)(G + rr * 256 + 4 * lane) = gl;
            if (ju == 31 && rr >= 64) *(f32x4*)(a->out + O_GLUP + ((size_t)(l * NB + b) * 30 + (rr - 64)) * DG + 4 * lane) = gl;
        }
        for (int i = wave * 64 + lane; i < 31 * 64; i += NTHR) ((LAS f32x4*)CW)[i] = ((const f32x4*)(a->in[I_CDW] + (size_t)l * 31 * DG))[i];
        __syncthreads();
        f32x4 acc[8];
#pragma unroll
        for (int i = 0; i < 8; ++i) acc[i] = (f32x4){0.f, 0.f, 0.f, 0.f};
        f32x4 wj[8];
#pragma unroll
        for (int i = 0; i < 38; ++i) {
            const f32x4 g = *(const LAS f32x4*)(G + (8 * wave + i) * 256 + 4 * lane);
            if (i <= 30) wj[i & 7] = *(const LAS f32x4*)(CW + i * 256 + 4 * lane);
#pragma unroll
            for (int tt = 0; tt < 8; ++tt) { const int j = i - tt; if (j >= 0 && j <= 30) acc[tt] += wj[j & 7] * g; }
            if (i & 1) asm volatile("" ::: "memory");
        }
        const f32x4 cb = *(const f32x4*)(a->in[I_CDWB] + l * DG + 4 * lane), lg = *(const f32x4*)(a->in[I_CLNG] + l * DG + 4 * lane), lb = *(const f32x4*)(a->in[I_CLNB] + l * DG + 4 * lane);
        const f32x4 mg = *(const f32x4*)(mog + 1 * DG + 4 * lane);
#pragma unroll
        for (int tt = 0; tt < 8; ++tt) {
            const f32x4 x = acc[tt] + cb;
            const float mean = wave_sum(hsum4(x)) * (1.0f / DG); const f32x4 d = x - mean;
            const float rstd = rsqrtf(wave_sum(hsq4(d)) * (1.0f / DG) + EPS);
            f32x4 y = d * rstd * lg + lb;
#pragma unroll
            for (int i = 0; i < 4; ++i) y[i] = y[i] * sigmoidf_(y[i]);
            const float r = rsqrtf(wave_sum(hsq4(y)) * (1.0f / DG) + EPS);
            st_bf4(Y + (R0 + 8 * wave + tt) * DM + 1 * DG + 4 * lane, y * r * mg);
        }
        __syncthreads();
    }
    asm volatile("" ::: "memory");
    if (MIXP & 4) {
        int lq_ = lane; asm volatile("" : "+v"(lq_)); const int lane = lq_; const int fr = lane & 15, fq = lane >> 4; (void)fr; (void)fq;
        const float* sw = a->in[I_SCDW] + (size_t)l * 3 * DG;
        const f32x4 w0 = *(const f32x4*)(sw + 4 * lane), w1 = *(const f32x4*)(sw + DG + 4 * lane), w2 = *(const f32x4*)(sw + 2 * DG + 4 * lane);
        const f32x4 mg = *(const f32x4*)(mog + 2 * DG + 4 * lane);
        f32x4 s[10];
#pragma unroll
        for (int i = 0; i < 10; ++i) {
            const int t = t0 + 8 * wave - 2 + i; s[i] = (f32x4){0.f, 0.f, 0.f, 0.f};
            if (t >= 0) { const bf16_t* zr = Z + ((size_t)b * SEQ + t) * DIN; s[i] = ld_bf4(zr + 1280 + 4 * lane) * ld_bf4(zr + 1536 + 4 * lane); }
        }
#pragma unroll
        for (int tt = 0; tt < 8; ++tt) {
            const int tl = 8 * wave + tt;
            const f32x4 sb = ld_bf4(Z + (R0 + tl) * DIN + 1024 + 4 * lane);
            const f32x4 y = sb * (w0 * s[tt] + w1 * s[tt + 1] + w2 * s[tt + 2]);
            const float r = rsqrtf(wave_sum(hsq4(y)) * (1.0f / DG) + EPS);
            st_bf4(Y + (R0 + tl) * DM + 2 * DG + 4 * lane, y * r * mg);
            if (ju == 31 && tl >= 62) *(f32x4*)(a->out + O_SHP + ((size_t)(l * NB + b) * 2 + (tl - 62)) * DG + 4 * lane) = s[tt + 2];
        }
    }
    asm volatile("s_waitcnt vmcnt(0)" ::: "memory");
    if (MIXP & 8) {
        int lq_ = lane; asm volatile("" : "+v"(lq_)); const int lane = lq_; const int fr = lane & 15, fq = lane >> 4; (void)fr; (void)fq;
        LAS bf16_t* PL = (LAS bf16_t*)lds; LAS float* TT = (LAS float*)(lds + TT_OFF);
        const int g = lane >> 4, w = 2 << g;
        f32x4 px[23];
#pragma unroll
        for (int i = 0; i < 23; ++i) {
            const int t = t0 + 8 * wave - 15 + i; px[i] = (f32x4){0.f, 0.f, 0.f, 0.f};
            if (t >= 0) px[i] = ld_bf4(Z + ((size_t)b * SEQ + t) * DIN + 1792 + 4 * lane);
        }
#pragma unroll
        for (int tt = 0; tt < 8; ++tt) {
            const int tl = 8 * wave + tt, t = t0 + tl;
            f32x4 sum = {0.f, 0.f, 0.f, 0.f};
#pragma unroll
            for (int i = 0; i < 16; ++i) if (i < w) sum += px[15 + tt - i];
            const float cnt = (float)min(w, t + 1);
            const f32x4 pooled = sum / cnt - px[15 + tt];
            u32x2 pw; pw.x = pk2(pooled.x, pooled.y); pw.y = pk2(pooled.z, pooled.w);
            *(LAS u32x2*)(PL + tl * PL_P + 4 * lane) = pw;
            if (ju == 31 && tl >= 49) *(f32x4*)(a->out + O_PLP + ((size_t)(l * NB + b) * 15 + (tl - 49)) * DG + 4 * lane) = px[15 + tt];
        }
        __syncthreads();
        const int mt = wave & 3, gp = wave >> 2;
        const bf16_t* PWT = (const bf16_t*)(ws + WS_W + (size_t)l * W_LSTRIDE + W_PWT);
#pragma unroll
        for (int gg = 0; gg < 2; ++gg) {
            const int gi = 2 * gp + gg;
#pragma unroll
            for (int nt = 0; nt < 4; ++nt) {
                f32x4 acc = {0.f, 0.f, 0.f, 0.f};
#pragma unroll
                for (int ks = 0; ks < 2; ++ks) {
                    const bf16x8 af = *(const LAS bf16x8*)(PL + (16 * mt + fr) * PL_P + gi * 64 + 32 * ks + 8 * fq);
                    const bf16x8 bfr = *(const bf16x8*)(PWT + ((size_t)gi * 64 + 16 * nt + fr) * 64 + 32 * ks + 8 * fq);
                    acc = __builtin_amdgcn_mfma_f32_16x16x32_bf16(af, bfr, acc, 0, 0, 0);
                }
                const int d = gi * 64 + 16 * nt + fr; const float sc = a->in[I_PSC][l * DG + d];
#pragma unroll
                for (int j = 0; j < 4; ++j) TT[(16 * mt + 4 * fq + j) * TT_P + d] = acc[j] * sc;
            }
        }
        __syncthreads();
        tt_rows_out(lds, Y + R0 * DM + 3 * DG, mog + 3 * DG, wave, lane);
        __syncthreads();
    }
}

DI void mixer_sample(AP a, int l, int bs, LAS unsigned char* lds, int wave, int lane) {
    unsigned char* ws = a->ws;
    const float* z = (const float*)(ws + WS_ZS) + ((size_t)l * NS + bs) * DIN;
    const float zrs = rsqrtf(((const float*)(ws + WS_SSQ))[(l * 3 + 0) * NS + bs] * (1.0f / DM) + EPS);
    float* ys = (float*)(ws + WS_YS) + (size_t)bs * DM;
    const float* mog = a->in[I_MOG] + l * DM;
    const int c4 = 4 * lane;
    {
        const f32x4 u = *(const f32x4*)(z + c4) * zrs, v = *(const f32x4*)(z + 256 + c4) * zrs;
        const f32x4 lg = *(const f32x4*)(a->in[I_LNG] + l * DG + c4), lb = *(const f32x4*)(a->in[I_LNB] + l * DG + c4);
        const float mean = wave_sum(hsum4(v)) * (1.0f / DG); const f32x4 d = v - mean;
        const float rstd = rsqrtf(wave_sum(hsq4(d)) * (1.0f / DG) + EPS);
        const f32x4 vn = d * rstd * lg + lb;
        *(f32x4*)(a->out + O_GV + ((size_t)l * NS + bs) * DG + c4) = vn;
        const int h = lane >> 4;
        const float w00 = a->in[I_GWS][((size_t)(l * 4 + h) * 128) * 128], b0 = a->in[I_GBS][(l * 4 + h) * 128];
        const f32x4 y = u * (vn * w00 + b0);
        const float r = rsqrtf(wave_sum(hsq4(y)) * (1.0f / DG) + EPS);
        *(f32x4*)(ys + c4) = y * r * *(const f32x4*)(mog + c4);
    }
    {
        const f32x4 ga = *(const f32x4*)(z + 512 + c4) * zrs, gg = *(const f32x4*)(z + 768 + c4) * zrs;
        f32x4 glu;
#pragma unroll
        for (int i = 0; i < 4; ++i) glu[i] = ga[i] * sigmoidf_(gg[i]);
        const float* st = a->in[I_SGLU] + ((size_t)(l * NS + bs) * 30) * DG + c4;
        float* so = a->out + O_GLUS + ((size_t)(l * NS + bs) * 30) * DG + c4;
        const float* cw = a->in[I_CDW] + (size_t)l * 31 * DG + c4;
        f32x4 acc = *(const f32x4*)(cw + 30 * DG) * glu;
#pragma unroll 6
        for (int j = 0; j < 30; ++j) { const f32x4 sv = *(const f32x4*)(st + j * DG); acc += *(const f32x4*)(cw + j * DG) * sv; if (j >= 1) *(f32x4*)(so + (j - 1) * DG) = sv; }
        *(f32x4*)(so + 29 * DG) = glu;
        const f32x4 x = acc + *(const f32x4*)(a->in[I_CDWB] + l * DG + c4);
        const float mean = wave_sum(hsum4(x)) * (1.0f / DG); const f32x4 d = x - mean;
        const float rstd = rsqrtf(wave_sum(hsq4(d)) * (1.0f / DG) + EPS);
        f32x4 y = d * rstd * *(const f32x4*)(a->in[I_CLNG] + l * DG + c4) + *(const f32x4*)(a->in[I_CLNB] + l * DG + c4);
#pragma unroll
        for (int i = 0; i < 4; ++i) y[i] = y[i] * sigmoidf_(y[i]);
        const float r = rsqrtf(wave_sum(hsq4(y)) * (1.0f / DG) + EPS);
        *(f32x4*)(ys + DG + c4) = y * r * *(const f32x4*)(mog + DG + c4);
    }
    {
        const f32x4 sb = *(const f32x4*)(z + 1024 + c4) * zrs, s = (*(const f32x4*)(z + 1280 + c4) * zrs) * (*(const f32x4*)(z + 1536 + c4) * zrs);
        const float* st = a->in[I_SSH] + ((size_t)(l * NS + bs) * 2) * DG + c4;
        float* so = a->out + O_SHS + ((size_t)(l * NS + bs) * 2) * DG + c4;
        const float* sw = a->in[I_SCDW] + (size_t)l * 3 * DG + c4;
        const f32x4 s0 = *(const f32x4*)st, s1 = *(const f32x4*)(st + DG);
        const f32x4 y = sb * (*(const f32x4*)sw * s0 + *(const f32x4*)(sw + DG) * s1 + *(const f32x4*)(sw + 2 * DG) * s);
        *(f32x4*)so = s1; *(f32x4*)(so + DG) = s;
        const float r = rsqrtf(wave_sum(hsq4(y)) * (1.0f / DG) + EPS);
        *(f32x4*)(ys + 2 * DG + c4) = y * r * *(const f32x4*)(mog + 2 * DG + c4);
    }
    {
        const f32x4 px = *(const f32x4*)(z + 1792 + c4) * zrs;
        const float* st = a->in[I_SPL] + ((size_t)(l * NS + bs) * 15) * DG + c4;
        float* so = a->out + O_PLS + ((size_t)(l * NS + bs) * 15) * DG + c4;
        const int g = lane >> 4, w = 2 << g;
        f32x4 sum = px;
#pragma unroll
        for (int j = 0; j < 15; ++j) { const f32x4 sv = *(const f32x4*)(st + j * DG); if (15 - j < w) sum += sv; if (j >= 1) *(f32x4*)(so + (j - 1) * DG) = sv; }
        *(f32x4*)(so + 14 * DG) = px;
        const f32x4 pooled = sum / (float)w - px;
        LAS float* PLs = (LAS float*)(lds + wave * 1024);
        *(LAS f32x4*)(PLs + c4) = pooled;
        asm volatile("s_waitcnt lgkmcnt(0)" ::: "memory");
        const float* pw = a->in[I_PW] + (size_t)l * 16384 + (size_t)g * 4096 + 4 * (lane & 15);
        f32x4 acc = {0.f, 0.f, 0.f, 0.f};
#pragma unroll 8
        for (int c = 0; c < 64; ++c) acc += *(const f32x4*)(pw + c * 64) * PLs[g * 64 + c];
        const f32x4 y = acc * *(const f32x4*)(a->in[I_PSC] + l * DG + c4);
        const float r = rsqrtf(wave_sum(hsq4(y)) * (1.0f / DG) + EPS);
        *(f32x4*)(ys + 3 * DG + c4) = y * r * *(const f32x4*)(mog + 3 * DG + c4);
        asm volatile("s_waitcnt lgkmcnt(0)" ::: "memory");
    }
}

constexpr int KVP = 264;
DI void attn_unit(AP a, int l, int uidx, LAS unsigned char* lds, int wave, int lane) {
    unsigned char* ws = a->ws;
    const int b = uidx >> 5, h = (uidx >> 3) & 3, qt = uidx & 7;
    const int r32 = lane & 31, hi = lane >> 5, tid = wave * 64 + lane;
    LAS bf16_t* KV = (LAS bf16_t*)lds;
    const size_t q0 = (size_t)b * SEQ + qt * 256 + 32 * wave;
    const bf16_t* Qp = (const bf16_t*)(ws + WS_Q) + (q0 + r32) * DM + h * 256 + 8 * hi;
    const bf16_t* Kg = (const bf16_t*)(ws + WS_KP) + ((size_t)l * MM + b * 256) * DM + h * 256;
    const bf16_t* Vg = (const bf16_t*)(ws + WS_VT) + ((size_t)((l * NB + b) * 4 + h) * 256) * 256;
    const bf16_t* kgl = Kg + (size_t)(tid >> 5) * DM + (tid & 31) * 8; const bf16_t* vgl = Vg + (size_t)(tid >> 5) * 256 + (tid & 31) * 8;
    LAS bf16_t* kvl = KV + (tid >> 5) * KVP + (tid & 31) * 8;
    bf16x8 qf[16];
#pragma unroll
    for (int ks = 0; ks < 16; ++ks) qf[ks] = *(const bf16x8*)(Qp + 16 * ks);
    u32x4 st[16];
#pragma unroll
    for (int i = 0; i < 16; ++i) st[i] = *(const u32x4*)(kgl + i * 16 * DM);
#pragma unroll
    for (int i = 0; i < 16; ++i) *(LAS u32x4*)(kvl + i * 16 * KVP) = st[i];
    __syncthreads();
    f32x16 S[8];
#pragma unroll
    for (int kt = 0; kt < 8; ++kt) {
#pragma unroll
        for (int i = 0; i < 16; ++i) S[kt][i] = 0.f;
#pragma unroll
        for (int ks = 0; ks < 16; ++ks) {
            const bf16x8 kf = *(const LAS bf16x8*)(KV + (kt * 32 + r32) * KVP + 16 * ks + 8 * hi);
            S[kt] = __builtin_amdgcn_mfma_f32_32x32x16_bf16(kf, qf[ks], S[kt], 0, 0, 0);
        }
    }
    asm volatile("" ::: "memory");
#pragma unroll
    for (int i = 0; i < 8; ++i) st[i] = *(const u32x4*)(vgl + i * 16 * 256);
    float mx = -3.0e38f;
#pragma unroll
    for (int kt = 0; kt < 8; ++kt)
#pragma unroll
        for (int i = 0; i < 16; ++i) mx = fmaxf(mx, S[kt][i]);
    mx = fmaxf(mx, __shfl_xor(mx, 32));
    float sum = 0.f; const float mxl = mx * 1.4426950408889634f;
    bf16x8 pf[16];
#pragma unroll
    for (int kt = 0; kt < 8; ++kt) {
#pragma unroll
        for (int i = 0; i < 16; ++i) { const float p = exp2f(S[kt][i] * 1.4426950408889634f - mxl); S[kt][i] = p; sum += p; }
#pragma unroll
        for (int c = 0; c < 2; ++c) {
            u32x4 p; p.x = pk2(S[kt][8 * c + 0], S[kt][8 * c + 1]); p.y = pk2(S[kt][8 * c + 2], S[kt][8 * c + 3]); p.z = pk2(S[kt][8 * c + 4], S[kt][8 * c + 5]); p.w = pk2(S[kt][8 * c + 6], S[kt][8 * c + 7]);
            pf[2 * kt + c] = __builtin_bit_cast(bf16x8, p);
        }
    }
    sum += __shfl_xor(sum, 32);
    const float inv = 1.0f / sum;
    __syncthreads();
#pragma unroll
    for (int i = 0; i < 8; ++i) *(LAS u32x4*)(kvl + i * 16 * KVP) = st[i];
    asm volatile("" ::: "memory");
#pragma unroll
    for (int i = 0; i < 8; ++i) st[i] = *(const u32x4*)(vgl + (i + 8) * 16 * 256);
    __syncthreads();
    bf16_t* Op = (bf16_t*)(ws + WS_O) + (q0 + r32) * DM + h * 256 + 4 * hi;
#pragma unroll
    for (int dt = 0; dt < 8; ++dt) {
        if (dt == 4) {
#pragma unroll
            for (int i = 0; i < 8; ++i) *(LAS u32x4*)(kvl + (i + 8) * 16 * KVP) = st[i];
            __syncthreads();
        }
        f32x16 o;
#pragma unroll
        for (int i = 0; i < 16; ++i) o[i] = 0.f;
#pragma unroll
        for (int kc = 0; kc < 16; ++kc) {
            const LAS bf16_t* vp = KV + (dt * 32 + r32) * KVP + 16 * kc + 4 * hi;
            const u32x2 v0 = *(const LAS u32x2*)vp, v1 = *(const LAS u32x2*)(vp + 8);
            u32x4 vv; vv.x = v0.x; vv.y = v0.y; vv.z = v1.x; vv.w = v1.y;
            o = __builtin_amdgcn_mfma_f32_32x32x16_bf16(__builtin_bit_cast(bf16x8, vv), pf[kc], o, 0, 0, 0);
        }
#pragma unroll
        for (int rg = 0; rg < 4; ++rg) {
            u32x2 w; w.x = pk2(o[4 * rg] * inv, o[4 * rg + 1] * inv); w.y = pk2(o[4 * rg + 2] * inv, o[4 * rg + 3] * inv);
            *(u32x2*)(Op + 32 * dt + 8 * rg) = w;
        }
    }
    __syncthreads();
}

DI void attn_sample_unit(AP a, int l, int uidx, LAS unsigned char* lds, int wave, int lane) {
    unsigned char* ws = a->ws;
    const int bs = uidx >> 1, hp = uidx & 1;
    LAS float* SC = (LAS float*)lds;
    LAS float* RED = (LAS float*)(lds + 4096);
    const float* qp = (const float*)(ws + WS_QS) + ((size_t)l * NS + bs) * DM + hp * 512 + 8 * lane;
    const float qrs = 0.0625f * rsqrtf(((const float*)(ws + WS_SSQ))[(l * 3 + 1) * NS + bs] * (1.0f / DM) + EPS);
    const f32x4 q0 = *(const f32x4*)qp * qrs, q1 = *(const f32x4*)(qp + 4) * qrs;
    const float* Kb = a->in[I_CK] + ((size_t)(l * NS + bs) * MEM) * DM + hp * 512 + 8 * lane;
    const float* Vb = a->in[I_CV] + ((size_t)(l * NS + bs) * MEM) * DM + hp * 512 + 8 * lane;
#pragma unroll 8
    for (int mi = 0; mi < 32; ++mi) {
        const int m = wave + 8 * mi;
        const f32x4 k0 = *(const f32x4*)(Kb + (size_t)m * DM), k1 = *(const f32x4*)(Kb + (size_t)m * DM + 4);
        float d = hsum4(k0 * q0) + hsum4(k1 * q1);
        d += __shfl_xor(d, 1); d += __shfl_xor(d, 2); d += __shfl_xor(d, 4); d += __shfl_xor(d, 8); d += __shfl_xor(d, 16);
        if ((lane & 31) == 0) SC[(lane >> 5) * 256 + m] = d;
    }
    __syncthreads();
    if (wave < 2) {
        const f32x4 v = *(const LAS f32x4*)(SC + wave * 256 + 4 * lane);
        float mx = fmaxf(fmaxf(v.x, v.y), fmaxf(v.z, v.w));
#pragma unroll
        for (int o = 1; o < 64; o <<= 1) mx = fmaxf(mx, __shfl_xor(mx, o));
        f32x4 e; e.x = __expf(v.x - mx); e.y = __expf(v.y - mx); e.z = __expf(v.z - mx); e.w = __expf(v.w - mx);
        const float inv = 1.0f / wave_sum(hsum4(e));
        *(LAS f32x4*)(SC + wave * 256 + 4 * lane) = e * inv;
    }
    __syncthreads();
    f32x4 o0 = {0.f, 0.f, 0.f, 0.f}, o1 = {0.f, 0.f, 0.f, 0.f};
#pragma unroll 8
    for (int mi = 0; mi < 32; ++mi) {
        const int m = wave + 8 * mi;
        const f32x4 v0 = *(const f32x4*)(Vb + (size_t)m * DM), v1 = *(const f32x4*)(Vb + (size_t)m * DM + 4);
        const float p = SC[(lane >> 5) * 256 + m];
        o0 += v0 * p; o1 += v1 * p;
    }
    *(LAS f32x4*)(RED + wave * 512 + 8 * lane) = o0; *(LAS f32x4*)(RED + wave * 512 + 8 * lane + 4) = o1;
    __syncthreads();
    {
        const int t = wave * 64 + lane; float s = 0.f;
#pragma unroll
        for (int w = 0; w < 8; ++w) s += RED[w * 512 + t];
        ((float*)(ws + WS_OS))[(size_t)bs * DM + hp * 512 + t] = s;
    }
    __syncthreads();
}


#define XB_TMO      128
#define XB_XCNT(j)  (256  + 64 * (j))
#define XB_XSUB(j)  (1280 + 64 * (j))
#define XB_XGEN(j)  (2304 + 64 * (j))
#define XB_TOP      3328
#define XB_TOPGEN   3392
#define XCD_BAR_WORDS 3456
#define XB_SPIN_CAP (1u << 18)
DI unsigned xb_ld(unsigned* p)              { return __hip_atomic_load(p, __ATOMIC_RELAXED, __HIP_MEMORY_SCOPE_AGENT); }
DI unsigned xb_add(unsigned* p, unsigned v) { return __hip_atomic_fetch_add(p, v, __ATOMIC_RELAXED, __HIP_MEMORY_SCOPE_AGENT); }
DI unsigned xb_xcc_id() { return (unsigned)__builtin_amdgcn_s_getreg((3 << 11) | 20) & 0xFu; }
#define XB_SPIN(cond, bar) do { unsigned _sp = 0; while (cond) { __builtin_amdgcn_s_sleep(1); \
    if ((++_sp & 255u) == 0u) { if (xb_ld(&(bar)[XB_TMO])) break; if (_sp > XB_SPIN_CAP) { atomicAdd(&(bar)[XB_TMO], 1u); break; } } } } while (0)
struct XcdBarrier { unsigned* bar; unsigned x; volatile LAS unsigned* st; };
DI XcdBarrier xcd_barrier_post(unsigned* bar, volatile LAS unsigned* st) {
    XcdBarrier b; b.bar = bar; b.x = xb_xcc_id(); b.st = st;
    if (threadIdx.x == 0) (void)xb_add(&bar[XB_XCNT(b.x)], 1u);
    return b;
}
DI void xcd_barrier_complete(unsigned* bar, unsigned x, unsigned& nloc, unsigned& nx) {
    const unsigned G = gridDim.x * gridDim.y * gridDim.z;
    unsigned sum, cnt, mine, sp = 0u;
    for (;;) {
        sum = 0u; cnt = 0u; mine = 0u;
#pragma unroll
        for (unsigned j = 0; j < 16; ++j) { const unsigned c = xb_ld(&bar[XB_XCNT(j)]); sum += c; cnt += (c > 0u) ? 1u : 0u; mine = (j == x) ? c : mine; }
        if (sum == G) break;
        __builtin_amdgcn_s_sleep(1);
        if ((++sp & 255u) == 0u) { if (xb_ld(&bar[XB_TMO])) break; if (sp > XB_SPIN_CAP) { atomicAdd(&bar[XB_TMO], 1u); break; } }
    }
    nloc = mine > 0u ? mine : 1u; nx = cnt > 0u ? cnt : 1u;
}
DI void xcd_barrier(const XcdBarrier& b) {
    asm volatile("s_waitcnt vmcnt(0)" ::: "memory");
    __syncthreads();
    if (threadIdx.x == 0) {
        unsigned* bar = b.bar;
        __builtin_amdgcn_s_waitcnt(0);
        unsigned nloc = b.st[0], nx = b.st[1];
        if (nloc == 0u) { xcd_barrier_complete(bar, b.x, nloc, nx); b.st[0] = nloc; b.st[1] = nx; }
        const unsigned old = xb_add(&bar[XB_XSUB(b.x)], 1u);
        const unsigned gen = old / nloc;
        if (old + 1u == (gen + 1u) * nloc) {
            __builtin_amdgcn_fence(__ATOMIC_RELEASE, "agent");
            asm volatile("s_waitcnt vmcnt(0)" ::: "memory");
            const unsigned og = xb_add(&bar[XB_TOP], 1u);
            const unsigned tg = og / nx;
            if (og + 1u == (tg + 1u) * nx) xb_add(&bar[XB_TOPGEN], 1u);
            else XB_SPIN(xb_ld(&bar[XB_TOPGEN]) == tg, bar);
            __builtin_amdgcn_fence(__ATOMIC_ACQUIRE, "agent");
            xb_add(&bar[XB_XGEN(b.x)], 1u);
            asm volatile("s_waitcnt vmcnt(0)" ::: "memory");
        } else {
            XB_SPIN(xb_ld(&bar[XB_XGEN(b.x)]) == gen, bar);
            __builtin_amdgcn_fence(__ATOMIC_ACQUIRE, "agent");
            asm volatile("s_waitcnt vmcnt(0)" ::: "memory");
        }
    }
    __syncthreads();
}

#ifndef PMASK
#define PMASK 0xffff
#endif
#ifndef DUPMASK
#define DUPMASK 0
#endif
constexpr int N_PHASES = 18;
__global__ void __launch_bounds__(NTHR, 2) fwd_kernel(Args a_) {
    extern __shared__ __attribute__((aligned(16))) unsigned char lds_raw[];
    LAS unsigned char* lds = (LAS unsigned char*)lds_raw;
    cg::grid_group grid = cg::this_grid();
    volatile LAS unsigned* MISC = (volatile LAS unsigned*)(lds + LDS_BYTES - 256);
    if (threadIdx.x < 32) MISC[threadIdx.x] = 0u;
    __syncthreads();
    const XcdBarrier xbar = xcd_barrier_post((unsigned*)(a_.ws + WS_CTL), MISC + 8);
    const int ph_lo = a_.ph_lo, ph_hi = a_.ph_hi;
    for (int ph = ph_lo; ph < ph_hi; ++ph) {
        AP a = (AP)__builtin_amdgcn_kernarg_segment_ptr();
        asm volatile("" : "+s"(a));
        int tid = threadIdx.x; asm volatile("" : "+v"(tid));
        const int lane = tid & 63, wave = __builtin_amdgcn_readfirstlane(tid >> 6);
        int bx = blockIdx.x; asm volatile("" : "+s"(bx));
        const int G = gridDim.x;
        unsigned char* ws = a->ws;
        bf16_t* XB = (bf16_t*)(ws + WS_XB); float* SS = (float*)(ws + WS_SS); float* XF = a->out + O_YP;
        float* XS = (float*)(ws + WS_XS); float* YS = (float*)(ws + WS_YS); float* OS = (float*)(ws + WS_OS);
        if (ph == 0) {
            for (int rep = 0; rep < ((DUPMASK & 64) ? 2 : 1); ++rep) prologue(a, lds, wave, lane);
        } else if (ph == N_PHASES - 1) { if (PMASK & 2) {
            const int gw = bx * NWAVES + wave, NGW = G * NWAVES;
            const float* gf = a->in[I_NFIN];
            for (int m = gw; m < MP + NS; m += NGW) {
                if (m < MP) {
                    const float rs = row_rs(SS + (size_t)m * 16); f32x4* yr = (f32x4*)(XF + (size_t)m * DM) + lane; const bf16_t* xr = XB + (size_t)m * DM + 4 * lane;
#pragma unroll
                    for (int j = 0; j < 4; ++j) yr[64 * j] = ld_bf4(xr + 256 * j) * rs * ((const f32x4*)gf)[lane + 64 * j];
                } else {
                    const int s = m - MP; const f32x4* xr = (const f32x4*)(XS + (size_t)s * DM) + lane; f32x4 v[4]; float sq = 0.f;
#pragma unroll
                    for (int j = 0; j < 4; ++j) { v[j] = xr[64 * j]; sq += hsq4(v[j]); }
                    const float rs = rsqrtf(wave_sum(sq) * (1.0f / DM) + EPS);
                    f32x4* yo = (f32x4*)(a->out + O_YS + (size_t)s * DM) + lane;
#pragma unroll
                    for (int j = 0; j < 4; ++j) yo[64 * j] = v[j] * rs * ((const f32x4*)gf)[lane + 64 * j];
                }
            }
        } } else {
            const int l = (ph - 1) >> 3, sub = (ph - 1) & 7;
            unsigned char* wl = ws + WS_W + (size_t)l * W_LSTRIDE;
            pg8::StaticOrder S;
            if (sub == 0) { if (PMASK & 4) {
                { pg8::Gemm g{XB, (const bf16_t*)(wl + W_IN), MP, DIN, DM}; S.init(MP, DIN, G, bx);
                  EpiScale<0> E{(bf16_t*)(ws + WS_Z), DIN, SS};
                  for (int rep = 0; rep < ((DUPMASK & 256) ? 2 : 1); ++rep) pg8::gemm_phase<EpiScale<0>, pg8::StaticOrder, true, true>(lds, g, S, E); }
                if (l == 0) { pg8::Gemm g{(const bf16_t*)(ws + WS_MEMB), (const bf16_t*)(ws + WS_WKV), MM, 4096, DM}; S.init(MM, 4096, G, bx);
                  EpiKV E{(const float*)(ws + WS_MEMSS), a->out + O_MK, a->out + O_MV, (bf16_t*)(ws + WS_KP), (bf16_t*)(ws + WS_VT)};
                  pg8::gemm_phase<EpiKV, pg8::StaticOrder, true, true>(lds, g, S, E); }
                sgemm_phase_p<0, true, 2>(XS, DM, (const bf16_t*)(wl + W_IN), DIN, (float*)(ws + WS_ZS) + (size_t)l * NS * DIN, nullptr, (float*)(ws + WS_SSQ) + (l * 3 + 0) * NS, ws, bx, G, wave, lane);
            } } else if (sub == 1) {
                for (int rep = 0; rep < ((DUPMASK & 4) ? 2 : 1); ++rep) for (int u = bx; u < 256; u += G) mixer_unit(a, l, u, lds, wave, lane);
                { const int gwr = (G - 1 - bx) * NWAVES + wave; if ((PMASK & 16) && gwr < NS) mixer_sample(a, l, gwr, lds, wave, lane); }
            } else if (sub == 2 || sub == 5 || sub == 7) { if (PMASK & 32) {
                const bf16_t* A = (const bf16_t*)(ws + (sub == 2 ? WS_Y : sub == 5 ? WS_O : WS_H));
                const bf16_t* Bt = (const bf16_t*)(wl + (sub == 2 ? W_OUT : sub == 5 ? W_O : W_F2));
                const int K = sub == 7 ? DFF : DM;
                pg8::Gemm g{A, Bt, MP, DM, K}; S.init(MP, DM, G, bx);
                EpiRes E{XB, SS};
                pg8::gemm_phase<EpiRes, pg8::StaticOrder, true, true>(lds, g, S, E);

                if (sub == 7) sgemm_phase_p<1, false, 2>((const float*)(ws + WS_HS) + (size_t)l * NS * DFF, DFF, Bt, DM, XS, (const float*)(ws + WS_SSQ) + (l * 3 + 2) * NS, nullptr, ws, bx, G, wave, lane);
                else sgemm_phase_p<0, false, 1>(sub == 2 ? YS : OS, DM, Bt, DM, XS, nullptr, nullptr, ws, bx, G, wave, lane);
            } } else if (sub == 3) { if (PMASK & 64) {
                pg8::Gemm g{XB, (const bf16_t*)(wl + W_Q), MP, DM, DM}; S.init(MP, DM, G, bx);
                EpiScale<1> E{(bf16_t*)(ws + WS_Q), DM, SS};
                for (int rep = 0; rep < ((DUPMASK & 512) ? 2 : 1); ++rep) pg8::gemm_phase<EpiScale<1>, pg8::StaticOrder, true, true>(lds, g, S, E);
                sgemm_phase_p<0, true, 1>(XS, DM, (const bf16_t*)(wl + W_Q), DM, (float*)(ws + WS_QS) + (size_t)l * NS * DM, nullptr, (float*)(ws + WS_SSQ) + (l * 3 + 1) * NS, ws, bx, G, wave, lane);
            } } else if (sub == 4) {
                for (int rep = 0; rep < ((DUPMASK & 1) ? 2 : 1); ++rep) for (int u = bx; u < 256; u += G) attn_unit(a, l, u, lds, wave, lane);
                for (int rep = 0; rep < ((DUPMASK & 2) ? 2 : 1); ++rep) for (int u = bx; u < 256; u += G) attn_sample_unit(a, l, u, lds, wave, lane);
            } else { if (PMASK & 512) {
                pg8::Gemm g{XB, (const bf16_t*)(wl + W_F1), MP, DFF, DM}; S.init(MP, DFF, G, bx);
                EpiScale<2> E{(bf16_t*)(ws + WS_H), DFF, SS};
                for (int rep = 0; rep < ((DUPMASK & 32) ? 2 : 1); ++rep) pg8::gemm_phase<EpiScale<2>, pg8::StaticOrder, true, true>(lds, g, S, E);
                sgemm_phase_p<0, true, 4>(XS, DM, (const bf16_t*)(wl + W_F1), DFF, (float*)(ws + WS_HS) + (size_t)l * NS * DFF, nullptr, (float*)(ws + WS_SSQ) + (l * 3 + 2) * NS, ws, bx, G, wave, lane);
            } }
        }
        if (ph + 1 < ph_hi) { if (ph >= N_PHASES) grid.sync();   else { xcd_barrier(xbar); if (DUPMASK & 16) xcd_barrier(xbar); } }
    }
}

#ifndef N_LAUNCH_MODE
#define N_LAUNCH_MODE 1
#endif
extern "C" void kernel_launch(void* const* d_in, const int* in_sizes, int n_in, void* d_out, int out_size, void* d_ws, size_t ws_size, hipStream_t stream) {
    static int grid = 0;
    if (grid == 0) {
        if (n_in != N_IN || (size_t)out_size != O_END || ws_size < WS_END + 106 * MiB) { fprintf(stderr, "kernel_launch: unexpected sizes n_in %d out %d ws %zu\n", n_in, out_size, ws_size); grid = -1; return; }
        int dev = 0, cus = 0, per_cu = 0;
        if (hipGetDevice(&dev) != hipSuccess || hipDeviceGetAttribute(&cus, hipDeviceAttributeMultiprocessorCount, dev) != hipSuccess) { grid = -1; return; }
        if (hipFuncSetAttribute((const void*)fwd_kernel, hipFuncAttributeMaxDynamicSharedMemorySize, LDS_BYTES) != hipSuccess) { fprintf(stderr, "kernel_launch: hipFuncSetAttribute failed\n"); grid = -1; return; }
        if (hipOccupancyMaxActiveBlocksPerMultiprocessor(&per_cu, (const void*)fwd_kernel, NTHR, LDS_BYTES) != hipSuccess || per_cu < 1) { fprintf(stderr, "kernel_launch: occupancy query says %d\n", per_cu); per_cu = 1; }
        (void)hipGetLastError();
        grid = cus;
    }
    if (grid < 0) return;
    if (hipMemsetAsync((char*)d_ws + WS_CTL, 0, CTL_ZERO_BYTES, stream) != hipSuccess) { fprintf(stderr, "kernel_launch: memset failed\n"); return; }
    Args a{};
    for (int i = 0; i < N_IN; ++i) a.in[i] = (const float*)d_in[i];
    a.out = (float*)d_out; a.ws = (unsigned char*)d_ws;
#if N_LAUNCH_MODE == 1
    a.ph_lo = 0; a.ph_hi = N_PHASES;
    void* args[] = {&a};
    hipError_t e = hipLaunchCooperativeKernel((const void*)fwd_kernel, dim3(grid), dim3(NTHR), args, LDS_BYTES, stream);
    if (e != hipSuccess) fprintf(stderr, "cooperative launch failed: %s (grid %d)\n", hipGetErrorString(e), grid);
#else
    for (int ph = 0; ph < N_PHASES; ++ph) {
        a.ph_lo = ph; a.ph_hi = ph + 1;
        hipLaunchKernelGGL(fwd_kernel, dim3(grid), dim3(NTHR), LDS_BYTES, stream, a);
    }
#endif
}
```

```cpp
#define DUPMASK 0
#define SPINSET 0
#define MIXSPIN 0
#include <hip/hip_runtime.h>
#include <hip/hip_cooperative_groups.h>
#include <cstdio>
#include <cstdint>
namespace cg = cooperative_groups;
namespace pg8 {
#define PG8_LAS __attribute__((address_space(3)))
typedef unsigned short bf16_t;
typedef short bf16x8 __attribute__((ext_vector_type(8)));
typedef float f32x4 __attribute__((ext_vector_type(4)));
typedef unsigned u32x4 __attribute__((ext_vector_type(4)));
constexpr int BM = 256, BK = 64, HALF = 128, HTB = HALF * BK * 2  , STAGE_BYTES = 8 * HTB, NXCD = 8, WGM = 8;

__host__ __device__ __forceinline__ int lds_byte(int r, int c) { const int st = (r >> 4) * 2 + (c >> 5), rr = r & 15, cc = c & 31, ob = rr * 64 + cc * 2; return st * 1024 + (ob ^ (((ob >> 9) & 1) << 5)); }
__host__ __device__ __forceinline__ void stage_rc(int b, int& R, int& C) { const int st = b / 1024, sb = b % 1024, swz = sb ^ (((sb >> 9) & 1) << 5); R = (st >> 1) * 16 + swz / 64; C = (st & 1) * 32 + (swz % 64) / 2; }
__host__ __device__ __forceinline__ int perm32(int rho) { const int n = rho >> 4, i = rho & 15; return 8 * (i >> 2) + 4 * n + (i & 3); }

struct Unit { int pm, pn; };
struct Gemm { const bf16_t* A; const bf16_t* Bt; int M, N, K; };

struct StaticOrder {
    int nM, nN, nwg, G, c;
    __host__ __device__ void init(int M, int N, int G_, int c_) { nM = M / BM; nN = N / BM; nwg = nM * nN; G = G_; c = c_; }
    __host__ __device__ bool next(int i, Unit& u) const {
        const long L = (long)i * G + c; if (L >= nwg) return false;
        int wgid = (int)L; { const int q = nwg / NXCD, r = nwg % NXCD, xcd = wgid % NXCD, off = wgid / NXCD; wgid = (xcd < r ? xcd * (q + 1) : r * (q + 1) + (xcd - r) * q) + off; }
        const int nig = WGM * nN, gid = wgid / nig, fm = gid * WGM, gsz = (nM - fm) < WGM ? (nM - fm) : WGM;
        u.pm = fm + ((wgid % nig) % gsz); u.pn = (wgid % nig) / gsz; return true;
    }
    __device__ __forceinline__ void a_ready(const Unit&) const {}
    __device__ __forceinline__ void done(const Unit&) const {}
};

__device__ __forceinline__ unsigned cvt_pk_bf16(float lo, float hi) { unsigned r; asm volatile("v_cvt_pk_bf16_f32 %0, %1, %2" : "=v"(r) : "v"(lo), "v"(hi)); return r; }
typedef float f32x2 __attribute__((ext_vector_type(2)));
template <class Epi, class Sched, bool ALIGN_EPI = false, bool SP2 = false>
__device__ __forceinline__ void gemm_phase(PG8_LAS unsigned char* lds, const Gemm g, const Sched& S, const Epi& E) {
    int tid = threadIdx.x; asm volatile("" : "+v"(tid)); const int wid = __builtin_amdgcn_readfirstlane(tid >> 6), lane = tid & 63, wr = wid >> 2, wc = wid & 3, fr = lane & 15, fq = lane >> 4;
    const int K = g.K, nt = K / BK;
    unsigned voffA[2], voffB[2];
#pragma unroll
    for (int i = 0; i < 2; ++i) { int R, C; stage_rc(tid * 16 + i * 8192, R, C); const int Rb = Epi::PERM ? ((R & ~31) + perm32(R & 31)) : R;
        voffA[i] = (unsigned)(R * K + C) * 2u; voffB[i] = (unsigned)(Rb * K + C) * 2u; }
    const size_t kstep = (size_t)(BK * 2);
    const size_t hstep = (size_t)HALF * K * 2;
    const size_t tstep = 2 * hstep;
    const unsigned ldsw = (unsigned)wid * 1024u;
    const int aoff = lds_byte(wr * 64 + fr, fq * 8), boff = lds_byte(wc * 32 + fr, fq * 8);
#define PG8_SA(b, h) (((b) * 2 + (h)) * HTB)
#define PG8_SB(b, h) ((4 + (b) * 2 + (h)) * HTB)
#define PG8_STAGE(bufoff, gbase, voff) do { _Pragma("unroll") for (int _i = 0; _i < 2; ++_i) \
        __builtin_amdgcn_global_load_lds((const unsigned*)((const char*)(gbase) + (voff)[_i]), (PG8_LAS unsigned*)(lds + (bufoff) + ldsw + _i * 8192), 16, 0, 0); } while (0)
#define PG8_LDA(dst, b, h) do { _Pragma("unroll") for (int m = 0; m < 4; ++m) _Pragma("unroll") for (int k = 0; k < 2; ++k) dst[m][k] = *(const PG8_LAS bf16x8*)(lds + PG8_SA(b, h) + aoff + m * 2048 + k * 1024); } while (0)
#define PG8_LDB(dst, b, h) do { _Pragma("unroll") for (int n = 0; n < 2; ++n) _Pragma("unroll") for (int k = 0; k < 2; ++k) dst[n][k] = *(const PG8_LAS bf16x8*)(lds + PG8_SB(b, h) + boff + n * 2048 + k * 1024); } while (0)
#define PG8_MMA(ai, bj, At, Bt) do { __builtin_amdgcn_s_setprio(1); _Pragma("unroll") for (int m = 0; m < 4; ++m) _Pragma("unroll") for (int n = 0; n < 2; ++n) _Pragma("unroll") for (int k = 0; k < 2; ++k) \
        acc[ai][bj][m][n] = __builtin_amdgcn_mfma_f32_16x16x32_bf16(Bt[n][k], At[m][k], acc[ai][bj][m][n], 0, 0, 0); __builtin_amdgcn_s_setprio(0); } while (0)
#define PG8_WAIT_V(n) asm volatile("s_waitcnt vmcnt(" #n ")" ::: "memory")
#define PG8_WAIT_L(n) asm volatile("s_waitcnt lgkmcnt(" #n ")" ::: "memory")
#define PG8_BAR __builtin_amdgcn_s_barrier()
#define PG8_SCHED __builtin_amdgcn_sched_barrier(0)
    Unit cur, nxt; int ui = 0;
    if (!S.next(0, cur)) return;
    f32x4 acc[2][2][4][2];
#pragma unroll
    for (int a = 0; a < 2; ++a)
#pragma unroll
        for (int b = 0; b < 2; ++b)
#pragma unroll
            for (int m = 0; m < 4; ++m)
#pragma unroll
                for (int n = 0; n < 2; ++n) acc[a][b][m][n] = (f32x4){0.f, 0.f, 0.f, 0.f};
    bf16x8 At[4][2], B0[2][2], B1[2][2];
    const char* cA = (const char*)g.A + (size_t)cur.pm * tstep; const char* cB = (const char*)g.Bt + (size_t)cur.pn * tstep;
    S.a_ready(cur);
    if constexpr (SP2) {
        PG8_STAGE(PG8_SB(0, 0), cB, voffB); PG8_STAGE(PG8_SB(0, 1), cB + hstep, voffB); PG8_STAGE(PG8_SA(0, 0), cA, voffA); PG8_STAGE(PG8_SA(0, 1), cA + hstep, voffA);
        if (wr == 1) PG8_BAR;
        PG8_WAIT_V(2); PG8_BAR;
        PG8_STAGE(PG8_SB(1, 0), cB + kstep, voffB); PG8_STAGE(PG8_SA(1, 0), cA + kstep, voffA); PG8_STAGE(PG8_SB(1, 1), cB + hstep + kstep, voffB);
        PG8_WAIT_V(6); PG8_BAR;
    } else {
        PG8_STAGE(PG8_SB(0, 0), cB, voffB); PG8_STAGE(PG8_SA(0, 0), cA, voffA); PG8_STAGE(PG8_SB(0, 1), cB + hstep, voffB); PG8_STAGE(PG8_SA(0, 1), cA + hstep, voffA);
        if (wr == 1) PG8_BAR;
        PG8_WAIT_V(4); PG8_BAR;
        PG8_STAGE(PG8_SB(1, 0), cB + kstep, voffB); PG8_STAGE(PG8_SA(1, 0), cA + kstep, voffA); PG8_STAGE(PG8_SB(1, 1), cB + hstep + kstep, voffB);
        PG8_WAIT_V(6); PG8_BAR;
    }
    for (;;) {
        const bool has_next = S.next(ui + 1, nxt);
        const char* nA = has_next ? (const char*)g.A + (size_t)nxt.pm * tstep : cA; const char* nB = has_next ? (const char*)g.Bt + (size_t)nxt.pn * tstep : cB;
        for (int t = 0; t < nt; t += 2) {
            const bool last = (t == nt - 2);
            const char* a1 = cA + (size_t)(t + 1) * kstep;
            const char* a2 = last ? nA : cA + (size_t)(t + 2) * kstep; const char* b2 = last ? nB : cB + (size_t)(t + 2) * kstep;
            const char* a3 = a2 + kstep; const char* b3 = b2 + kstep;
            if (last && has_next) S.a_ready(nxt);
            if constexpr (SP2) {
            PG8_LDB(B0, 0, 0); PG8_LDB(B1, 0, 1); PG8_SCHED; PG8_LDA(At, 0, 0); PG8_STAGE(PG8_SA(1, 1), a1 + hstep, voffA);
            PG8_WAIT_V(8); PG8_WAIT_L(0); PG8_BAR; PG8_MMA(0, 0, At, B0); PG8_MMA(0, 1, At, B1); PG8_BAR; PG8_SCHED;
            PG8_LDA(At, 0, 1); PG8_STAGE(PG8_SB(0, 0), b2, voffB); PG8_STAGE(PG8_SB(0, 1), b2 + hstep, voffB); PG8_STAGE(PG8_SA(0, 0), a2, voffA);
            PG8_WAIT_V(8); PG8_WAIT_L(0); PG8_BAR; PG8_MMA(1, 0, At, B0); PG8_MMA(1, 1, At, B1); PG8_BAR; PG8_SCHED;
            PG8_LDB(B0, 1, 0); PG8_LDB(B1, 1, 1); PG8_SCHED; PG8_LDA(At, 1, 0); PG8_STAGE(PG8_SA(0, 1), a2 + hstep, voffA);
            PG8_WAIT_V(8); PG8_WAIT_L(0); PG8_BAR; PG8_MMA(0, 0, At, B0); PG8_MMA(0, 1, At, B1); PG8_BAR; PG8_SCHED;
            PG8_LDA(At, 1, 1); PG8_STAGE(PG8_SB(1, 0), b3, voffB); PG8_STAGE(PG8_SB(1, 1), b3 + hstep, voffB); PG8_STAGE(PG8_SA(1, 0), a3, voffA);
            PG8_WAIT_V(8); PG8_WAIT_L(0); PG8_BAR; PG8_MMA(1, 0, At, B0); PG8_MMA(1, 1, At, B1); PG8_BAR; PG8_SCHED;
            } else {
            PG8_LDB(B0, 0, 0); PG8_SCHED; PG8_LDA(At, 0, 0); PG8_STAGE(PG8_SA(1, 1), a1 + hstep, voffA);
            PG8_WAIT_L(8); PG8_BAR; PG8_WAIT_L(0); PG8_MMA(0, 0, At, B0); PG8_BAR; PG8_SCHED;
            PG8_LDB(B1, 0, 1); PG8_STAGE(PG8_SB(0, 0), b2, voffB);
            PG8_BAR; PG8_WAIT_L(0); PG8_MMA(0, 1, At, B1); PG8_BAR;
            PG8_LDA(At, 0, 1); PG8_STAGE(PG8_SA(0, 0), a2, voffA);
            PG8_BAR; PG8_WAIT_L(0); PG8_MMA(1, 0, At, B0); PG8_BAR; PG8_SCHED;
            PG8_STAGE(PG8_SB(0, 1), b2 + hstep, voffB);
            PG8_WAIT_V(6); PG8_BAR; PG8_MMA(1, 1, At, B1); PG8_BAR;
            PG8_LDB(B0, 1, 0); PG8_SCHED; PG8_LDA(At, 1, 0); PG8_STAGE(PG8_SA(0, 1), a2 + hstep, voffA);
            PG8_WAIT_L(8); PG8_BAR; PG8_WAIT_L(0); PG8_MMA(0, 0, At, B0); PG8_BAR; PG8_SCHED;
            PG8_LDB(B1, 1, 1); PG8_STAGE(PG8_SB(1, 0), b3, voffB);
            PG8_BAR; PG8_WAIT_L(0); PG8_MMA(0, 1, At, B1); PG8_BAR;
            PG8_LDA(At, 1, 1); PG8_STAGE(PG8_SA(1, 0), a3, voffA);
            PG8_BAR; PG8_WAIT_L(0); PG8_MMA(1, 0, At, B0); PG8_BAR; PG8_SCHED;
            PG8_STAGE(PG8_SB(1, 1), b3 + hstep, voffB);
            PG8_WAIT_V(6); PG8_BAR; PG8_MMA(1, 1, At, B1); PG8_BAR;
            }
        }
        if constexpr (ALIGN_EPI) { if (wr == 0) PG8_BAR; }
        if constexpr (!Epi::AFTER_DRAIN) {
#if defined(MIXSPIN) && (MIXSPIN & 4096)
            const unsigned long long te0_ = __builtin_amdgcn_s_memrealtime();
#endif
            E(acc, cur, wr, wc, fr, fq); S.done(cur);
#if defined(MIXSPIN) && (MIXSPIN & 4096)
            { asm volatile("s_waitcnt vmcnt(0)" ::: "memory"); const unsigned long long te1_ = __builtin_amdgcn_s_memrealtime(), tg_ = te1_ + (te1_ - te0_); while (__builtin_amdgcn_s_memrealtime() < tg_) __builtin_amdgcn_s_sleep(8); }
#endif
        }
        if (!has_next) break;
#pragma unroll
        for (int a = 0; a < 2; ++a)
#pragma unroll
            for (int b = 0; b < 2; ++b)
#pragma unroll
                for (int m = 0; m < 4; ++m)
#pragma unroll
                    for (int n = 0; n < 2; ++n) acc[a][b][m][n] = (f32x4){0.f, 0.f, 0.f, 0.f};
        cur = nxt; cA = nA; cB = nB; ++ui;
        if constexpr (ALIGN_EPI) { if (wr == 1) PG8_BAR; }
    }
    PG8_WAIT_V(0);
    if constexpr (!ALIGN_EPI) { if (wr == 0) PG8_BAR; }
    PG8_BAR;
    if constexpr (Epi::AFTER_DRAIN) { E.fused(acc, cur, wr, wc, fr, fq, lds, wid, lane); S.done(cur); }
#undef PG8_SA
#undef PG8_SB
#undef PG8_STAGE
#undef PG8_LDA
#undef PG8_LDB
#undef PG8_MMA
#undef PG8_WAIT_V
#undef PG8_WAIT_L
#undef PG8_BAR
#undef PG8_SCHED
}
}

#define DI __device__ __forceinline__
#ifndef MIXSPIN
#define MIXSPIN 0
#endif
#define PRO_T0() const unsigned long long t_p0 = MIXSPIN ? __builtin_amdgcn_s_memrealtime() : 0ull
#define PRO_T1(bit) do { if (MIXSPIN & (bit)) { const unsigned long long t1_ = __builtin_amdgcn_s_memrealtime(), tg_ = t1_ + (t1_ - t_p0); while (__builtin_amdgcn_s_memrealtime() < tg_) __builtin_amdgcn_s_sleep(8); } } while (0)
#define LAS __attribute__((address_space(3)))
typedef unsigned short bf16_t;
typedef short bf16x8 __attribute__((ext_vector_type(8)));
typedef float f32x4 __attribute__((ext_vector_type(4)));
typedef float f32x16 __attribute__((ext_vector_type(16)));
typedef unsigned u32x4 __attribute__((ext_vector_type(4)));
typedef unsigned u32x2 __attribute__((ext_vector_type(2)));
typedef float f32x2_t __attribute__((ext_vector_type(2)));
typedef __bf16 bf16x2_t __attribute__((ext_vector_type(2)));

constexpr int DM = 1024, NB = 8, SEQ = 2048, MP = NB * SEQ, NL = 2, NS = 128, MEM = 256, MM = NB * MEM, DG = 256, DIN = 2048, DFF = 4096;
constexpr float EPS = 1e-6f;
constexpr int NWAVES = 8, NTHR = 512;
constexpr int LDS_BYTES = 147456;

constexpr size_t MiB = 1u << 20;
constexpr size_t WS_W = 2 * MiB, W_LSTRIDE = 28 * MiB;
constexpr size_t W_IN = 0, W_OUT = 4 * MiB, W_Q = 6 * MiB, W_O = 8 * MiB, W_F1 = 10 * MiB, W_F2 = 18 * MiB, W_GWS = 26 * MiB, W_PWT = 26 * MiB + 512 * 1024;
constexpr size_t WS_WKV = 58 * MiB;
constexpr size_t WS_MEMB = 66 * MiB;
constexpr size_t WS_MEMSS = 70 * MiB;
constexpr size_t WS_SS = 71 * MiB;
constexpr size_t WS_XB = 72 * MiB;
constexpr size_t WS_Z = 264 * MiB;
constexpr size_t WS_Y = 168 * MiB;
constexpr size_t WS_Q = WS_Y;
constexpr size_t WS_O = WS_Y;
constexpr size_t WS_H = 264 * MiB;
constexpr size_t WS_KP = 392 * MiB;
constexpr size_t WS_VT = 400 * MiB;
constexpr size_t WS_XS = 408 * MiB, WS_YS = 408 * MiB + 512 * 1024, WS_OS = 409 * MiB, WS_SSQ = 409 * MiB + 512 * 1024  , WS_ZS = 410 * MiB  , WS_QS = 412 * MiB  , WS_HS = 413 * MiB  , WS_END = 417 * MiB;
constexpr size_t WS_CTL = 0, CTL_ZERO_BYTES = 65536;

constexpr size_t O_YP = 0, O_YS = O_YP + (size_t)MP * DM, O_MK = O_YS + (size_t)NS * DM, O_MV = O_MK + (size_t)NL * MM * DM, O_GLUP = O_MV + (size_t)NL * MM * DM,
                 O_GLUS = O_GLUP + (size_t)NL * NB * 30 * DG, O_SHP = O_GLUS + (size_t)NL * NS * 30 * DG, O_SHS = O_SHP + (size_t)NL * NB * 2 * DG,
                 O_PLP = O_SHS + (size_t)NL * NS * 2 * DG, O_PLS = O_PLP + (size_t)NL * NB * 15 * DG, O_GV = O_PLS + (size_t)NL * NS * 15 * DG, O_END = O_GV + (size_t)NL * NS * DG;

enum { I_XP = 0, I_XS, I_MEM, I_CK, I_CV, I_SGLU, I_SSH, I_SPL, I_NMIX, I_WIN, I_LNG, I_LNB, I_GWS, I_GBS, I_CDW, I_CDWB, I_CLNG, I_CLNB, I_SCDW, I_PW, I_PSC, I_MOG, I_WOUT,
       I_NXA, I_NMEM, I_WQ, I_WK, I_WV, I_WO, I_NFF, I_WF1, I_WF2, I_NFIN, N_IN };

DI unsigned pk2(float lo, float hi) { f32x2_t v = {lo, hi}; bf16x2_t b = __builtin_convertvector(v, bf16x2_t); return __builtin_bit_cast(unsigned, b); }
DI float bf2f(unsigned short u) { return __uint_as_float((unsigned)u << 16); }
DI float bflo(unsigned u) { return __uint_as_float(u << 16); }
DI float bfhi(unsigned u) { return __uint_as_float(u & 0xffff0000u); }
DI f32x4 ld_bf4_nt(const bf16_t* p) { const u32x2 w = __builtin_nontemporal_load((const u32x2*)p); return (f32x4){bflo(w.x), bfhi(w.x), bflo(w.y), bfhi(w.y)}; }
DI f32x4 ld_bf4(const bf16_t* p) { const u32x2 w = *(const u32x2*)p; return (f32x4){bflo(w.x), bfhi(w.x), bflo(w.y), bfhi(w.y)}; }
#ifndef NTST
#define NTST 0
#endif
#if NTST == 2
DI void st_wt8(void* p, u32x2 v) { __hip_atomic_store((unsigned long long*)p, ((unsigned long long)v.y << 32) | v.x, __ATOMIC_RELAXED, __HIP_MEMORY_SCOPE_AGENT); }
#define ST16(p, v) do { const u32x4 v_ = (v); st_wt8((char*)(p), (u32x2){v_.x, v_.y}); st_wt8((char*)(p) + 8, (u32x2){v_.z, v_.w}); } while (0)
#define ST8(p, v) st_wt8((p), (v))
#elif NTST
#define ST16(p, v) __builtin_nontemporal_store((v), (u32x4*)(p))
#define ST8(p, v) __builtin_nontemporal_store((v), (u32x2*)(p))
#else
#define ST16(p, v) (*(u32x4*)(p) = (v))
#define ST8(p, v) (*(u32x2*)(p) = (v))
#endif
DI void st_bf4(bf16_t* p, f32x4 v) { u32x2 w; w.x = pk2(v.x, v.y); w.y = pk2(v.z, v.w); ST8(p, w); }
template <int CTRL> DI float dpp_f(float v) { return __int_as_float(__builtin_amdgcn_update_dpp(0, __float_as_int(v), CTRL, 0xf, 0xf, true)); }
DI float row_sum16(float v) {
    v += dpp_f<0xB1>(v);
    v += dpp_f<0x4E>(v);
    v += dpp_f<0x141>(v);
    v += dpp_f<0x140>(v);
    return v;
}
DI float rl_f(float v, int l) { return __int_as_float(__builtin_amdgcn_readlane(__float_as_int(v), l)); }
DI float wave_sum(float v) { v = row_sum16(v); return (rl_f(v, 0) + rl_f(v, 16)) + (rl_f(v, 32) + rl_f(v, 48)); }
DI float half_sum32(float v, int lane) { v = row_sum16(v); const float a = rl_f(v, 0) + rl_f(v, 16), b = rl_f(v, 32) + rl_f(v, 48); return lane < 32 ? a : b; }
DI float hsum4(f32x4 v) { return (v.x + v.y) + (v.z + v.w); }
DI float hsq4(f32x4 v) { return (v.x * v.x + v.y * v.y) + (v.z * v.z + v.w * v.w); }
DI float sigmoidf_(float x) { return __builtin_amdgcn_rcpf(1.0f + __builtin_amdgcn_exp2f(x * -1.4426950408889634f)); }
DI float row_rs(const float* ss16) {
    const f32x4* sp = (const f32x4*)ss16; const f32x4 a = sp[0], b = sp[1], c = sp[2], d = sp[3];
    const float s = (hsum4(a) + hsum4(b)) + (hsum4(c) + hsum4(d));
    return rsqrtf(s * (1.0f / DM) + EPS);
}

template <int MODE  > struct EpiScale {
    static constexpr bool PERM = true, AFTER_DRAIN = false;
    bf16_t* O; int ldc; const float* ss;
    DI void operator()(const f32x4 (&acc)[2][2][4][2], const pg8::Unit& u, int wr, int wc, int fr, int fq) const {
        const int row0 = u.pm * 256 + wr * 64 + fr, col0 = u.pn * 256 + wc * 32 + 8 * fq;
#pragma unroll
        for (int ai = 0; ai < 2; ++ai)
#pragma unroll
            for (int m = 0; m < 4; ++m) {
                const int row = row0 + ai * 128 + m * 16;
                float rs = row_rs(ss + (size_t)row * 16); if (MODE == 1) rs *= 0.0625f;
                bf16_t* rowp = O + (size_t)row * ldc + col0;
#pragma unroll
                for (int bj = 0; bj < 2; ++bj) {
                    f32x4 v0 = acc[ai][bj][m][0] * rs, v1 = acc[ai][bj][m][1] * rs;
                    if (MODE == 2) {
#pragma unroll
                        for (int j = 0; j < 4; ++j) { float a = fmaxf(v0[j], 0.f), b = fmaxf(v1[j], 0.f); v0[j] = a * a; v1[j] = b * b; }
                    }
                    u32x4 w; w.x = pk2(v0[0], v0[1]); w.y = pk2(v0[2], v0[3]); w.z = pk2(v1[0], v1[1]); w.w = pk2(v1[2], v1[3]);
                    ST16(rowp + bj * 128, w);
                }
            }
    }
};
struct EpiKV {
    static constexpr bool PERM = true, AFTER_DRAIN = false;
    const float* mss; float* outK; float* outV; bf16_t* KP; bf16_t* VT;
    DI void operator()(const f32x4 (&acc)[2][2][4][2], const pg8::Unit& u, int wr, int wc, int fr, int fq) const {
        const int l = u.pn >> 3, w8 = u.pn & 7, isV = w8 >> 2, h = w8 & 3, b = u.pm;
        const int row0 = u.pm * 256 + wr * 64 + fr, colh0 = h * 256 + wc * 32 + 8 * fq;
        float* outp = (isV ? outV : outK) + (size_t)l * MM * DM;
#pragma unroll
        for (int ai = 0; ai < 2; ++ai)
#pragma unroll
            for (int m = 0; m < 4; ++m) {
                const int row = row0 + ai * 128 + m * 16;
                const float rs = rsqrtf(mss[row] * (1.0f / DM) + EPS);
#pragma unroll
                for (int bj = 0; bj < 2; ++bj) {
                    const int colh = colh0 + bj * 128;
                    const f32x4 v0 = acc[ai][bj][m][0] * rs, v1 = acc[ai][bj][m][1] * rs;
                    __builtin_nontemporal_store(v0, (f32x4*)(outp + (size_t)row * DM + colh)); __builtin_nontemporal_store(v1, (f32x4*)(outp + (size_t)row * DM + colh + 4));
                    if (!isV) {
                        u32x4 w; w.x = pk2(v0[0], v0[1]); w.y = pk2(v0[2], v0[3]); w.z = pk2(v1[0], v1[1]); w.w = pk2(v1[2], v1[3]);
                        *(u32x4*)(KP + ((size_t)l * MM + row) * DM + colh) = w;
                    } else {
                        bf16_t* vt = VT + ((size_t)((l * NB + b) * 4 + h) * 256 + (colh & 255)) * 256 + (row & 255);
#pragma unroll
                        for (int j = 0; j < 4; ++j) { vt[(size_t)j * 256] = (bf16_t)(pk2(v0[j], 0.f) & 0xffffu); vt[(size_t)(j + 4) * 256] = (bf16_t)(pk2(v1[j], 0.f) & 0xffffu); }
                    }
                }
            }
    }
};
struct EpiRes {
    static constexpr bool PERM = true, AFTER_DRAIN = false;
    bf16_t* xb; float* ss;
    DI void operator()(const f32x4 (&acc)[2][2][4][2], const pg8::Unit& u, int wr, int wc, int fr, int fq) const {
        const int row0 = u.pm * 256 + wr * 64 + fr, col0 = u.pn * 256 + wc * 32 + 8 * fq;
        bf16_t* base = xb + (size_t)row0 * DM + col0;
        u32x4 ov[2][4][2];
#pragma unroll
        for (int ai = 0; ai < 2; ++ai)
#pragma unroll
            for (int m = 0; m < 4; ++m) { const bf16_t* rowp = base + (size_t)(ai * 128 + m * 16) * DM; ov[ai][m][0] = *(const u32x4*)rowp; ov[ai][m][1] = *(const u32x4*)(rowp + 128); }
#pragma unroll
        for (int ai = 0; ai < 2; ++ai)
#pragma unroll
            for (int m = 0; m < 4; ++m) {
                const int row = row0 + ai * 128 + m * 16; bf16_t* rowp = base + (size_t)(ai * 128 + m * 16) * DM;
                float sq = 0.f;
#pragma unroll
                for (int bj = 0; bj < 2; ++bj) {
                    const u32x4 o = ov[ai][m][bj];
                    f32x4 v0 = acc[ai][bj][m][0], v1 = acc[ai][bj][m][1];
                    v0.x += bflo(o.x); v0.y += bfhi(o.x); v0.z += bflo(o.y); v0.w += bfhi(o.y);
                    v1.x += bflo(o.z); v1.y += bfhi(o.z); v1.z += bflo(o.w); v1.w += bfhi(o.w);
                    sq += hsq4(v0) + hsq4(v1);
                    u32x4 w; w.x = pk2(v0[0], v0[1]); w.y = pk2(v0[2], v0[3]); w.z = pk2(v1[0], v1[1]); w.w = pk2(v1[2], v1[3]);
                    ST16(rowp + bj * 128, w);
                }
                sq += __shfl_xor(sq, 16); sq += __shfl_xor(sq, 32);
                if (fq == 0) ss[(size_t)row * 16 + u.pn * 4 + wc] = sq;
            }
    }
};

struct EpiAny {
    static constexpr bool PERM = true, AFTER_DRAIN = false;
    int mode;
    bf16_t* O; int ldc; const float* ss; float* ssw;
    const float* mss; float* outK; float* outV; bf16_t* KP; bf16_t* VT;
    DI void operator()(const f32x4 (&acc)[2][2][4][2], const pg8::Unit& u, int wr, int wc, int fr, int fq) const {
        if (mode == 0) EpiScale<0>{O, ldc, ss}(acc, u, wr, wc, fr, fq);
        else if (mode == 1) EpiScale<1>{O, ldc, ss}(acc, u, wr, wc, fr, fq);
        else if (mode == 2) EpiScale<2>{O, ldc, ss}(acc, u, wr, wc, fr, fq);
        else if (mode == 3) EpiKV{mss, outK, outV, KP, VT}(acc, u, wr, wc, fr, fq);
        else EpiRes{O, ssw}(acc, u, wr, wc, fr, fq);
    }
};

template <int AMODE, bool SSQ, int NSL, int MT> DI void sgemm_item(const float* A, int lda, const bf16_t* Bt, int ldb, int rowb, int ncol, int kbase, float* Out, int ldo, const float* ssq_in, float* ssq_out, int wave_, int lane) {
    const int r = lane & 15, q = lane >> 4;
    const int wave = (rowb >> 4) + (wave_ % MT), n0 = ncol + (wave_ / MT) * NSL * 16;
    const float* ap = A + (size_t)(16 * wave + r) * lda + kbase + 16 * q;
    const bf16_t* bp = Bt + (size_t)(n0 + r) * ldb + kbase + 16 * q;
    f32x4 av[4][4]; bf16x8 bv[NSL][4][2];
#pragma unroll
    for (int c = 0; c < 4; ++c)
#pragma unroll
        for (int i = 0; i < 4; ++i) av[c][i] = *(const f32x4*)(ap + 64 * c + 4 * i);
#pragma unroll
    for (int sl = 0; sl < NSL; ++sl)
#pragma unroll
        for (int c = 0; c < 4; ++c) { bv[sl][c][0] = *(const bf16x8*)(bp + (size_t)sl * 16 * ldb + 64 * c); bv[sl][c][1] = *(const bf16x8*)(bp + (size_t)sl * 16 * ldb + 64 * c + 8); }
    float rsA = 1.f; if (AMODE == 1) rsA = rsqrtf(ssq_in[16 * wave + r] * (1.0f / DM) + EPS);
    f32x4 acc[NSL]; float ssq = 0.f;
#pragma unroll
    for (int sl = 0; sl < NSL; ++sl) acc[sl] = (f32x4){0.f, 0.f, 0.f, 0.f};
#pragma unroll
    for (int c = 0; c < 4; ++c) {
        if (AMODE == 1) {
#pragma unroll
            for (int i = 0; i < 4; ++i)
#pragma unroll
                for (int j = 0; j < 4; ++j) { const float t = fmaxf(av[c][i][j] * rsA, 0.f); av[c][i][j] = t * t; }
        }
        if (SSQ) ssq += (hsq4(av[c][0]) + hsq4(av[c][1])) + (hsq4(av[c][2]) + hsq4(av[c][3]));
        u32x4 p0, p1; p0.x = pk2(av[c][0].x, av[c][0].y); p0.y = pk2(av[c][0].z, av[c][0].w); p0.z = pk2(av[c][1].x, av[c][1].y); p0.w = pk2(av[c][1].z, av[c][1].w);
        p1.x = pk2(av[c][2].x, av[c][2].y); p1.y = pk2(av[c][2].z, av[c][2].w); p1.z = pk2(av[c][3].x, av[c][3].y); p1.w = pk2(av[c][3].z, av[c][3].w);
#pragma unroll
        for (int sl = 0; sl < NSL; ++sl) {
            acc[sl] = __builtin_amdgcn_mfma_f32_16x16x32_bf16(__builtin_bit_cast(bf16x8, p0), bv[sl][c][0], acc[sl], 0, 0, 0);
            acc[sl] = __builtin_amdgcn_mfma_f32_16x16x32_bf16(__builtin_bit_cast(bf16x8, p1), bv[sl][c][1], acc[sl], 0, 0, 0);
        }
    }
    if (SSQ) { if (n0 == 0) { ssq += __shfl_xor(ssq, 16); ssq += __shfl_xor(ssq, 32); if (q == 0) unsafeAtomicAdd(ssq_out + 16 * wave + r, ssq); } }
#pragma unroll
    for (int sl = 0; sl < NSL; ++sl)
#pragma unroll
        for (int j = 0; j < 4; ++j) unsafeAtomicAdd(Out + (size_t)(16 * wave + 4 * q + j) * ldo + n0 + 16 * sl + r, acc[sl][j]);
}
template <int AMODE, bool SSQ, int NSL, int MT> DI void sgemm_phase(const float* A, int K, const bf16_t* Bt, int N, float* Out, const float* ssq_in, float* ssq_out, int bx, int G, int wave, int lane) {
    constexpr int W = 16 * NSL * (8 / MT), NRB = 8 / MT;
    const int ng = N / W, nit = NRB * ng * (K / 256);
    const int vcu = (G & 7) == 0 ? (bx & 7) * (G >> 3) + (bx >> 3) : bx;
    for (int it = vcu; it < nit; it += G) { const int rb = it % NRB, sg = (it / NRB) % ng, kp = it / (NRB * ng); sgemm_item<AMODE, SSQ, NSL, MT>(A, K, Bt, K, rb * 16 * MT, sg * W, kp * 256, Out, N, ssq_in, ssq_out, wave, lane); }
}
template <int AMODE, bool SSQ, int NSL, int MT> DI void sgemm_phase_p(const float* A, int K, const bf16_t* Bt, int N, float* Out, const float* ssq_in, float* ssq_out, unsigned char* ws, int bx, int G, int wave, int lane) {
    { PRO_T0(); sgemm_phase<AMODE, SSQ, NSL, MT>(A, K, Bt, N, Out, ssq_in, ssq_out, bx, G, wave, lane); if (MIXSPIN & 512) asm volatile("s_waitcnt vmcnt(0)" ::: "memory"); PRO_T1(512); }
    if (DUPMASK & 8) sgemm_phase<AMODE, SSQ, NSL, MT>(A, K, Bt, N, (float*)(ws + WS_END), ssq_in, (float*)(ws + WS_END) + 1024 * 1024, bx, G, wave, lane);
}

struct TrDesc { const float* W; const float* g; bf16_t* WT; int K, N, row_off, item; };
DI void tr_load(const TrDesc& d, f32x4 (&r)[8], float (&gv)[8], int lane) {
    const int nblk = d.N / 32, kb = d.item / nblk, nb = d.item % nblk, k0 = 64 * kb, n0 = 32 * nb;
    const float* p = d.W + (size_t)(k0 + (lane >> 3)) * d.N + n0 + 4 * (lane & 7);
#pragma unroll
    for (int i = 0; i < 8; ++i) { r[i] = __builtin_nontemporal_load((const f32x4*)(p + (size_t)i * 8 * d.N)); gv[i] = d.g ? d.g[k0 + (lane >> 3) + 8 * i] : 1.f; }
}
DI void tr_finish(const TrDesc& d, const f32x4 (&r)[8], const float (&gv)[8], LAS float* scr, int lane) {
    const int nblk = d.N / 32, kb = d.item / nblk, nb = d.item % nblk, k0 = 64 * kb, n0 = 32 * nb;
#pragma unroll
    for (int i = 0; i < 8; ++i) { LAS float* q = scr + ((lane >> 3) + 8 * i) * 33 + 4 * (lane & 7); const f32x4 v = r[i] * gv[i]; q[0] = v.x; q[1] = v.y; q[2] = v.z; q[3] = v.w; }
    asm volatile("s_waitcnt lgkmcnt(0)" ::: "memory");
    const int c = lane & 7;
#pragma unroll
    for (int j = 0; j < 4; ++j) { const int n = (lane >> 3) + 8 * j; const LAS float* s = scr + (8 * c) * 33 + n;
        u32x4 o; o.x = pk2(s[0 * 33], s[1 * 33]); o.y = pk2(s[2 * 33], s[3 * 33]); o.z = pk2(s[4 * 33], s[5 * 33]); o.w = pk2(s[6 * 33], s[7 * 33]);
        *(u32x4*)(d.WT + (size_t)(d.row_off + n0 + n) * d.K + k0 + 8 * c) = o; }
    asm volatile("s_waitcnt lgkmcnt(0)" ::: "memory");
}
DI float row_to_bf16(const float* xrow, bf16_t* orow, int lane) {
    const f32x4* xr = (const f32x4*)xrow + lane; float s = 0.f;
#pragma unroll
    for (int j = 0; j < 4; ++j) { const f32x4 v = __builtin_nontemporal_load(xr + 64 * j); s += hsq4(v); st_bf4(orow + 4 * lane + 256 * j, v); }
    return wave_sum(s);
}

struct Args { const float* in[N_IN]; float* out; unsigned char* ws; int ph_lo, ph_hi; };
typedef const __attribute__((address_space(4))) Args* AP;

DI void prologue(AP a, LAS unsigned char* lds, int wave, int lane_) {
    int lnp_ = lane_; asm volatile("" : "+v"(lnp_)); const int lane = lnp_;
    unsigned char* ws = a->ws;
    LAS float* scr = (LAS float*)(lds + wave * 16384);
    const int gw = blockIdx.x * NWAVES + wave, NGW = gridDim.x * NWAVES;
    constexpr int IT_IN = 16 * 64, IT_SQ = 16 * 32, IT_F1 = 16 * 128, IT_F2 = 64 * 32, IT_L = IT_IN + 5 * IT_SQ + IT_F1 + IT_F2;
    { PRO_T0();
    auto decode = [&](int it) -> TrDesc {
        const int l = it / IT_L; int r = it % IT_L;
        unsigned char* wl = ws + WS_W + (size_t)l * W_LSTRIDE; TrDesc d;
        if (r < IT_IN) { d = TrDesc{a->in[I_WIN] + (size_t)l * DM * DIN, a->in[I_NMIX] + l * DM, (bf16_t*)(wl + W_IN), DM, DIN, 0, r}; return d; } r -= IT_IN;
        if (r < IT_SQ) { d = TrDesc{a->in[I_WOUT] + (size_t)l * DM * DM, nullptr, (bf16_t*)(wl + W_OUT), DM, DM, 0, r}; return d; } r -= IT_SQ;
        if (r < IT_SQ) { d = TrDesc{a->in[I_WQ] + (size_t)l * DM * DM, a->in[I_NXA] + l * DM, (bf16_t*)(wl + W_Q), DM, DM, 0, r}; return d; } r -= IT_SQ;
        if (r < IT_SQ) { d = TrDesc{a->in[I_WK] + (size_t)l * DM * DM, a->in[I_NMEM] + l * DM, (bf16_t*)(ws + WS_WKV), DM, DM, l * 2048, r}; return d; } r -= IT_SQ;
        if (r < IT_SQ) { d = TrDesc{a->in[I_WV] + (size_t)l * DM * DM, a->in[I_NMEM] + l * DM, (bf16_t*)(ws + WS_WKV), DM, DM, l * 2048 + 1024, r}; return d; } r -= IT_SQ;
        if (r < IT_SQ) { d = TrDesc{a->in[I_WO] + (size_t)l * DM * DM, nullptr, (bf16_t*)(wl + W_O), DM, DM, 0, r}; return d; } r -= IT_SQ;
        if (r < IT_F1) { d = TrDesc{a->in[I_WF1] + (size_t)l * DM * DFF, a->in[I_NFF] + l * DM, (bf16_t*)(wl + W_F1), DM, DFF, 0, r}; return d; } r -= IT_F1;
        d = TrDesc{a->in[I_WF2] + (size_t)l * DFF * DM, nullptr, (bf16_t*)(wl + W_F2), DFF, DM, 0, r}; return d;
    };
    constexpr int NIT = NL * IT_L;
    int it = gw; TrDesc d0 = decode(min(it, NIT - 1)); f32x4 r0[8]; float g0[8]; tr_load(d0, r0, g0, lane);
    while (it < NIT) {
        const int itn = it + NGW; const TrDesc d1 = decode(min(itn, NIT - 1)); f32x4 r1[8]; float g1[8]; tr_load(d1, r1, g1, lane);
        tr_finish(d0, r0, g0, scr, lane);
        d0 = d1; it = itn;
#pragma unroll
        for (int i = 0; i < 8; ++i) { r0[i] = r1[i]; g0[i] = g1[i]; }
    }
    PRO_T1(16); }
    { PRO_T0();
        bf16_t* XB = (bf16_t*)(ws + WS_XB); float* SS = (float*)(ws + WS_SS);
        for (int m0 = gw; m0 < MP; m0 += 4 * NGW) {
            f32x4 v[4][4];
#pragma unroll
            for (int k = 0; k < 4; ++k) { const int m = min(m0 + k * NGW, MP - 1);
#pragma unroll
                for (int j = 0; j < 4; ++j) v[k][j] = __builtin_nontemporal_load((const f32x4*)(a->in[I_XP] + (size_t)m * DM) + lane + 64 * j); }
#pragma unroll
            for (int k = 0; k < 4; ++k) { const int m = m0 + k * NGW; if (m < MP) { float sq = 0.f;
#pragma unroll
                for (int j = 0; j < 4; ++j) { sq += hsq4(v[k][j]); st_bf4(XB + (size_t)m * DM + 4 * lane + 256 * j, v[k][j]); }
                sq = wave_sum(sq); if (lane < 16) SS[(size_t)m * 16 + lane] = lane == 0 ? sq : 0.f; } }
        }
        bf16_t* MB = (bf16_t*)(ws + WS_MEMB); float* MS = (float*)(ws + WS_MEMSS);
        for (int m = gw; m < MM; m += NGW) { const float s = row_to_bf16(a->in[I_MEM] + (size_t)m * DM, MB + (size_t)m * DM, lane); if (lane == 0) MS[m] = s; }
    PRO_T1(32); }
    { PRO_T0();
        const int gt = blockIdx.x * NTHR + wave * 64 + lane, NGT = gridDim.x * NTHR;
        for (int i = gt; i < NL * 4 * 128 * 128; i += NGT) { const int l = i >> 16, r = i & 65535, t = (r >> 7) & 127, s = r & 127;
            ((bf16_t*)(ws + WS_W + (size_t)l * W_LSTRIDE + W_GWS))[r] = (bf16_t)(pk2(s <= t ? a->in[I_GWS][i] : 0.f, 0.f) & 0xffffu); }
        for (int i = gt; i < NL * 4 * 64 * 64; i += NGT) { const int l = i >> 14, r = i & 16383, g = r >> 12, d = (r >> 6) & 63, c = r & 63;
            ((bf16_t*)(ws + WS_W + (size_t)l * W_LSTRIDE + W_PWT))[r] = (bf16_t)(pk2(a->in[I_PW][(size_t)l * 16384 + g * 4096 + c * 64 + d], 0.f) & 0xffffu); }
        for (int i = gt; i < NS * DM / 4; i += NGT) ((f32x4*)(ws + WS_XS))[i] = ((const f32x4*)a->in[I_XS])[i];
        for (int i = gt; i < (int)((WS_END - WS_ZS) / 16); i += NGT) ((f32x4*)(ws + WS_ZS))[i] = (f32x4){0.f, 0.f, 0.f, 0.f};
        for (int i = gt; i < NL * 3 * NS; i += NGT) ((float*)(ws + WS_SSQ))[i] = 0.f;
    PRO_T1(64); }
}

#ifndef MIXP
#define MIXP 15
#endif
#ifndef MIXSPIN
#define MIXSPIN 0
#endif
#define MIX_T0() const unsigned long long t_m0 = MIXSPIN ? __builtin_amdgcn_s_memrealtime() : 0ull
#define MIX_T1(bit) do { if (MIXSPIN & (bit)) { const unsigned long long t1_ = __builtin_amdgcn_s_memrealtime(), tg_ = t1_ + (t1_ - t_m0); while (__builtin_amdgcn_s_memrealtime() < tg_) __builtin_amdgcn_s_sleep(8); } } while (0)
constexpr int VNT_P = 136;
constexpr int TT_OFF = 69632, TT_P = 260;
constexpr int CW_OFF = 96256;
constexpr int PL_P = 264;

DI void tt_rows_out(LAS unsigned char* lds, bf16_t* Yrow0, const float* mog, int wave, int lane) {
    const LAS float* TT = (const LAS float*)(lds + TT_OFF);
    const f32x4 g = *(const f32x4*)(mog + 4 * lane);
#pragma unroll
    for (int i = 0; i < 8; ++i) {
        const int tt = 8 * wave + i;
        const f32x4 v = *(const LAS f32x4*)(TT + tt * TT_P + 4 * lane);
        const float r = rsqrtf(wave_sum(hsq4(v)) * (1.0f / DG) + EPS);
        st_bf4(Yrow0 + (size_t)tt * DM + 4 * lane, v * r * g);
    }
}

DI void mixer_unit(AP a, int l, int uidx, LAS unsigned char* lds, int wave, int lane) {
    unsigned char* ws = a->ws;
    const int b = uidx >> 5, ju = uidx & 31, t0 = ju * 64, off = t0 & 127, tc = t0 - off;
    const size_t R0 = (size_t)b * SEQ + t0;
    const bf16_t* Z = (const bf16_t*)(ws + WS_Z);
    bf16_t* Y = (bf16_t*)(ws + WS_Y);
    const float* mog = a->in[I_MOG] + l * DM;
    u32x2 gar[12], ggr[12];
    {
        int lq_ = lane; asm volatile("" : "+v"(lq_));
#pragma unroll
        for (int i = 0; i < 12; ++i) { const int rr = wave + 8 * i, t = t0 - 30 + rr; const int tcl = (rr < 94 && t >= 0) ? t : t0;
            const bf16_t* zr = Z + ((size_t)b * SEQ + tcl) * DIN; gar[i] = *(const u32x2*)(zr + 512 + 4 * lq_); ggr[i] = *(const u32x2*)(zr + 768 + 4 * lq_); }
    }
    { MIX_T0(); if (MIXP & 1) {
        int lq_ = lane; asm volatile("" : "+v"(lq_)); const int lane = lq_; const int fr = lane & 15, fq = lane >> 4; (void)fr; (void)fq;
        LAS bf16_t* VNT = (LAS bf16_t*)lds;
        const f32x4 lg = *(const f32x4*)(a->in[I_LNG] + l * DG + 4 * lane), lb = *(const f32x4*)(a->in[I_LNB] + l * DG + 4 * lane);
        const int nrow = off + 64;
        const bf16_t* Zv = Z + ((size_t)b * SEQ + tc + wave) * DIN + 256 + 4 * lane;
        u32x2 vr[16];
#pragma unroll
        for (int i = 0; i < 16; ++i) vr[i] = *(const u32x2*)(Zv + (size_t)(wave + 8 * i < nrow ? i : 0) * 8 * DIN);
        u32x2 ur[8];
#pragma unroll
        for (int i = 0; i < 8; ++i) ur[i] = *(const u32x2*)(Z + (R0 + 8 * wave + i) * DIN + 4 * lane);
        const int mt = wave & 3, hp = wave >> 2, tl0 = off + 16 * mt, nks = (tl0 + 16 + 31) >> 5;
        const bf16_t* GW = (const bf16_t*)(ws + WS_W + (size_t)l * W_LSTRIDE + W_GWS);
        bf16x8 af[2][4];
#pragma unroll
        for (int hh = 0; hh < 2; ++hh)
#pragma unroll
            for (int ks = 0; ks < 4; ++ks) af[hh][ks] = *(const bf16x8*)(GW + ((size_t)(2 * hp + hh) * 128 + tl0 + fr) * 128 + 32 * (ks < nks ? ks : 0) + 8 * fq);
        const int wsw = lane & 7;
#pragma unroll
        for (int i = 0; i < 16; ++i) if (wave + 8 * i < nrow) {
            const int s = wave + 8 * i;
            const f32x4 v = (f32x4){bflo(vr[i].x), bfhi(vr[i].x), bflo(vr[i].y), bfhi(vr[i].y)};
            const float mean = wave_sum(hsum4(v)) * (1.0f / DG); const f32x4 d = v - mean;
            const float rstd = rsqrtf(wave_sum(hsq4(d)) * (1.0f / DG) + EPS);
            const f32x4 vn = d * rstd * lg + lb;
            LAS bf16_t* wp = VNT + (4 * lane) * VNT_P + (((s >> 3) ^ wsw) << 3) + (s & 7);
#pragma unroll
            for (int k = 0; k < 4; ++k) wp[k * VNT_P] = (bf16_t)(pk2(vn[k], 0.f) & 0xffffu);
        }
        __syncthreads();
        LAS float* TT = (LAS float*)(lds + TT_OFF);
#pragma unroll
        for (int hh = 0; hh < 2; ++hh) {
            const int h = 2 * hp + hh;
            f32x4 acc[4];
#pragma unroll
            for (int dt = 0; dt < 4; ++dt) acc[dt] = (f32x4){0.f, 0.f, 0.f, 0.f};
#pragma unroll
            for (int ks = 0; ks < 4; ++ks) if (ks < nks) {
#pragma unroll
                for (int dt = 0; dt < 4; ++dt) {
                    const int d = h * 64 + dt * 16 + fr;
                    const bf16x8 bfr = *(const LAS bf16x8*)(VNT + d * VNT_P + (((4 * ks + fq) ^ ((d >> 2) & 7)) << 3));
                    acc[dt] = __builtin_amdgcn_mfma_f32_16x16x32_bf16(af[hh][ks], bfr, acc[dt], 0, 0, 0);
                }
            }
#pragma unroll
            for (int dt = 0; dt < 4; ++dt)
#pragma unroll
                for (int j = 0; j < 4; ++j) TT[(16 * mt + 4 * fq + j) * TT_P + h * 64 + dt * 16 + fr] = acc[dt][j];
        }
        __syncthreads();
        {
            const f32x4 g = *(const f32x4*)(mog + 4 * lane); const float* bsp = a->in[I_GBS] + (l * 4 + (lane >> 4)) * 128 + off + 8 * wave;
#pragma unroll
            for (int i = 0; i < 8; ++i) {
                const int tt = 8 * wave + i;
                const f32x4 gate = *(const LAS f32x4*)(TT + tt * TT_P + 4 * lane) + bsp[i];
                const f32x4 v = (f32x4){bflo(ur[i].x), bfhi(ur[i].x), bflo(ur[i].y), bfhi(ur[i].y)} * gate;
                const float r = rsqrtf(wave_sum(hsq4(v)) * (1.0f / DG) + EPS);
                st_bf4(Y + (R0 + tt) * DM + 4 * lane, v * r * g);
            }
        }
        __syncthreads();
    } MIX_T1(1); }
    { MIX_T0(); if (MIXP & 2) {
        int lq_ = lane; asm volatile("" : "+v"(lq_)); const int lane = lq_; const int fr = lane & 15, fq = lane >> 4; (void)fr; (void)fq;
        LAS float* G = (LAS float*)lds; LAS float* CW = (LAS float*)(lds + CW_OFF);
#pragma unroll
        for (int i = 0; i < 12; ++i) { const int rr = wave + 8 * i; if (rr < 94) {
            const int t = t0 - 30 + rr; f32x4 gl = {0.f, 0.f, 0.f, 0.f};
            if (t >= 0) { const f32x4 ga = (f32x4){bflo(gar[i].x), bfhi(gar[i].x), bflo(gar[i].y), bfhi(gar[i].y)}, gg = (f32x4){bflo(ggr[i].x), bfhi(ggr[i].x), bflo(ggr[i].y), bfhi(ggr[i].y)};
#pragma unroll
                for (int k = 0; k < 4; ++k) gl[k] = ga[k] * sigmoidf_(gg[k]); }
            *(LAS f32x4*)(G + rr * 256 + 4 * lane) = gl;
            if (ju == 31 && rr >= 64) *(f32x4*)(a->out + O_GLUP + ((size_t)(l * NB + b) * 30 + (rr - 64)) * DG + 4 * lane) = gl;
        } }
        for (int i = wave * 64 + lane; i < 31 * 64; i += NTHR) ((LAS f32x4*)CW)[i] = ((const f32x4*)(a->in[I_CDW] + (size_t)l * 31 * DG))[i];
        __syncthreads();
        f32x4 acc[8];
#pragma unroll
        for (int i = 0; i < 8; ++i) acc[i] = (f32x4){0.f, 0.f, 0.f, 0.f};
        f32x4 wj[8];
#pragma unroll
        for (int i = 0; i < 38; ++i) {
            const f32x4 g = *(const LAS f32x4*)(G + (8 * wave + i) * 256 + 4 * lane);
            if (i <= 30) wj[i & 7] = *(const LAS f32x4*)(CW + i * 256 + 4 * lane);
#pragma unroll
            for (int tt = 0; tt < 8; ++tt) { const int j = i - tt; if (j >= 0 && j <= 30) acc[tt] += wj[j & 7] * g; }
            if (i & 1) asm volatile("" ::: "memory");
        }
        const f32x4 cb = *(const f32x4*)(a->in[I_CDWB] + l * DG + 4 * lane), lg = *(const f32x4*)(a->in[I_CLNG] + l * DG + 4 * lane), lb = *(const f32x4*)(a->in[I_CLNB] + l * DG + 4 * lane);
        const f32x4 mg = *(const f32x4*)(mog + 1 * DG + 4 * lane);
#pragma unroll
        for (int tt = 0; tt < 8; ++tt) {
            const f32x4 x = acc[tt] + cb;
            const float mean = wave_sum(hsum4(x)) * (1.0f / DG); const f32x4 d = x - mean;
            const float rstd = rsqrtf(wave_sum(hsq4(d)) * (1.0f / DG) + EPS);
            f32x4 y = d * rstd * lg + lb;
#pragma unroll
            for (int i = 0; i < 4; ++i) y[i] = y[i] * sigmoidf_(y[i]);
            const float r = rsqrtf(wave_sum(hsq4(y)) * (1.0f / DG) + EPS);
            st_bf4(Y + (R0 + 8 * wave + tt) * DM + 1 * DG + 4 * lane, y * r * mg);
        }
        __syncthreads();
    } MIX_T1(2); }
    asm volatile("" ::: "memory");
    { MIX_T0(); if (MIXP & 4) {
        int lq_ = lane; asm volatile("" : "+v"(lq_)); const int lane = lq_; const int fr = lane & 15, fq = lane >> 4; (void)fr; (void)fq;
        const float* sw = a->in[I_SCDW] + (size_t)l * 3 * DG;
        const f32x4 w0 = *(const f32x4*)(sw + 4 * lane), w1 = *(const f32x4*)(sw + DG + 4 * lane), w2 = *(const f32x4*)(sw + 2 * DG + 4 * lane);
        const f32x4 mg = *(const f32x4*)(mog + 2 * DG + 4 * lane);
        f32x4 s[10];
#pragma unroll
        for (int i = 0; i < 10; ++i) {
            const int t = t0 + 8 * wave - 2 + i; s[i] = (f32x4){0.f, 0.f, 0.f, 0.f};
            if (t >= 0) { const bf16_t* zr = Z + ((size_t)b * SEQ + t) * DIN; s[i] = ld_bf4(zr + 1280 + 4 * lane) * ld_bf4(zr + 1536 + 4 * lane); }
        }
#pragma unroll
        for (int tt = 0; tt < 8; ++tt) {
            const int tl = 8 * wave + tt;
            const f32x4 sb = ld_bf4(Z + (R0 + tl) * DIN + 1024 + 4 * lane);
            const f32x4 y = sb * (w0 * s[tt] + w1 * s[tt + 1] + w2 * s[tt + 2]);
            const float r = rsqrtf(wave_sum(hsq4(y)) * (1.0f / DG) + EPS);
            st_bf4(Y + (R0 + tl) * DM + 2 * DG + 4 * lane, y * r * mg);
            if (ju == 31 && tl >= 62) *(f32x4*)(a->out + O_SHP + ((size_t)(l * NB + b) * 2 + (tl - 62)) * DG + 4 * lane) = s[tt + 2];
        }
    } MIX_T1(4); }
    asm volatile("s_waitcnt vmcnt(0)" ::: "memory");
    { MIX_T0(); if (MIXP & 8) {
        int lq_ = lane; asm volatile("" : "+v"(lq_)); const int lane = lq_; const int fr = lane & 15, fq = lane >> 4; (void)fr; (void)fq;
        LAS bf16_t* PL = (LAS bf16_t*)lds; LAS float* TT = (LAS float*)(lds + TT_OFF);
        const int g = lane >> 4, w = 2 << g;
        f32x4 px[23];
#pragma unroll
        for (int i = 0; i < 23; ++i) {
            const int t = t0 + 8 * wave - 15 + i; px[i] = (f32x4){0.f, 0.f, 0.f, 0.f};
            if (t >= 0) px[i] = ld_bf4(Z + ((size_t)b * SEQ + t) * DIN + 1792 + 4 * lane);
        }
#pragma unroll
        for (int tt = 0; tt < 8; ++tt) {
            const int tl = 8 * wave + tt, t = t0 + tl;
            f32x4 sum = {0.f, 0.f, 0.f, 0.f};
#pragma unroll
            for (int i = 0; i < 16; ++i) if (i < w) sum += px[15 + tt - i];
            const float icnt = __builtin_amdgcn_rcpf((float)min(w, t + 1));
            const f32x4 pooled = sum * icnt - px[15 + tt];
            u32x2 pw; pw.x = pk2(pooled.x, pooled.y); pw.y = pk2(pooled.z, pooled.w);
            *(LAS u32x2*)(PL + tl * PL_P + 4 * lane) = pw;
            if (ju == 31 && tl >= 49) *(f32x4*)(a->out + O_PLP + ((size_t)(l * NB + b) * 15 + (tl - 49)) * DG + 4 * lane) = px[15 + tt];
        }
        __syncthreads();
        const int mt = wave & 3, gp = wave >> 2;
        const bf16_t* PWT = (const bf16_t*)(ws + WS_W + (size_t)l * W_LSTRIDE + W_PWT);
#pragma unroll
        for (int gg = 0; gg < 2; ++gg) {
            const int gi = 2 * gp + gg;
#pragma unroll
            for (int nt = 0; nt < 4; ++nt) {
                f32x4 acc = {0.f, 0.f, 0.f, 0.f};
#pragma unroll
                for (int ks = 0; ks < 2; ++ks) {
                    const bf16x8 af = *(const LAS bf16x8*)(PL + (16 * mt + fr) * PL_P + gi * 64 + 32 * ks + 8 * fq);
                    const bf16x8 bfr = *(const bf16x8*)(PWT + ((size_t)gi * 64 + 16 * nt + fr) * 64 + 32 * ks + 8 * fq);
                    acc = __builtin_amdgcn_mfma_f32_16x16x32_bf16(af, bfr, acc, 0, 0, 0);
                }
                const int d = gi * 64 + 16 * nt + fr; const float sc = a->in[I_PSC][l * DG + d];
#pragma unroll
                for (int j = 0; j < 4; ++j) TT[(16 * mt + 4 * fq + j) * TT_P + d] = acc[j] * sc;
            }
        }
        __syncthreads();
        tt_rows_out(lds, Y + R0 * DM + 3 * DG, mog + 3 * DG, wave, lane);
        __syncthreads();
    } MIX_T1(8); }
}

DI void mixer_sample(AP a, int l, int bs, int part, LAS unsigned char* lds, int wave, int lane) {
    unsigned char* ws = a->ws;
    const float* z = (const float*)(ws + WS_ZS) + ((size_t)l * NS + bs) * DIN;
    const float zrs = rsqrtf(((const float*)(ws + WS_SSQ))[(l * 3 + 0) * NS + bs] * (1.0f / DM) + EPS);
    float* ys = (float*)(ws + WS_YS) + (size_t)bs * DM;
    const float* mog = a->in[I_MOG] + l * DM;
    const int c4 = 4 * lane;
    if (part == 0) {
        const f32x4 u = *(const f32x4*)(z + c4) * zrs, v = *(const f32x4*)(z + 256 + c4) * zrs;
        const f32x4 lg = *(const f32x4*)(a->in[I_LNG] + l * DG + c4), lb = *(const f32x4*)(a->in[I_LNB] + l * DG + c4);
        const float mean = wave_sum(hsum4(v)) * (1.0f / DG); const f32x4 d = v - mean;
        const float rstd = rsqrtf(wave_sum(hsq4(d)) * (1.0f / DG) + EPS);
        const f32x4 vn = d * rstd * lg + lb;
        *(f32x4*)(a->out + O_GV + ((size_t)l * NS + bs) * DG + c4) = vn;
        const int h = lane >> 4;
        const float w00 = a->in[I_GWS][((size_t)(l * 4 + h) * 128) * 128], b0 = a->in[I_GBS][(l * 4 + h) * 128];
        const f32x4 y = u * (vn * w00 + b0);
        const float r = rsqrtf(wave_sum(hsq4(y)) * (1.0f / DG) + EPS);
        *(f32x4*)(ys + c4) = y * r * *(const f32x4*)(mog + c4);
    }
    else if (part == 1) {
        const f32x4 ga = *(const f32x4*)(z + 512 + c4) * zrs, gg = *(const f32x4*)(z + 768 + c4) * zrs;
        f32x4 glu;
#pragma unroll
        for (int i = 0; i < 4; ++i) glu[i] = ga[i] * sigmoidf_(gg[i]);
        const float* st = a->in[I_SGLU] + ((size_t)(l * NS + bs) * 30) * DG + c4;
        float* so = a->out + O_GLUS + ((size_t)(l * NS + bs) * 30) * DG + c4;
        const float* cw = a->in[I_CDW] + (size_t)l * 31 * DG + c4;
        f32x4 acc = *(const f32x4*)(cw + 30 * DG) * glu;
#pragma unroll 10
        for (int j = 0; j < 30; ++j) { const f32x4 sv = *(const f32x4*)(st + j * DG); acc += *(const f32x4*)(cw + j * DG) * sv; if (j >= 1) *(f32x4*)(so + (j - 1) * DG) = sv; }
        *(f32x4*)(so + 29 * DG) = glu;
        const f32x4 x = acc + *(const f32x4*)(a->in[I_CDWB] + l * DG + c4);
        const float mean = wave_sum(hsum4(x)) * (1.0f / DG); const f32x4 d = x - mean;
        const float rstd = rsqrtf(wave_sum(hsq4(d)) * (1.0f / DG) + EPS);
        f32x4 y = d * rstd * *(const f32x4*)(a->in[I_CLNG] + l * DG + c4) + *(const f32x4*)(a->in[I_CLNB] + l * DG + c4);
#pragma unroll
        for (int i = 0; i < 4; ++i) y[i] = y[i] * sigmoidf_(y[i]);
        const float r = rsqrtf(wave_sum(hsq4(y)) * (1.0f / DG) + EPS);
        *(f32x4*)(ys + DG + c4) = y * r * *(const f32x4*)(mog + DG + c4);
    }
    else if (part == 2) {
        const f32x4 sb = *(const f32x4*)(z + 1024 + c4) * zrs, s = (*(const f32x4*)(z + 1280 + c4) * zrs) * (*(const f32x4*)(z + 1536 + c4) * zrs);
        const float* st = a->in[I_SSH] + ((size_t)(l * NS + bs) * 2) * DG + c4;
        float* so = a->out + O_SHS + ((size_t)(l * NS + bs) * 2) * DG + c4;
        const float* sw = a->in[I_SCDW] + (size_t)l * 3 * DG + c4;
        const f32x4 s0 = *(const f32x4*)st, s1 = *(const f32x4*)(st + DG);
        const f32x4 y = sb * (*(const f32x4*)sw * s0 + *(const f32x4*)(sw + DG) * s1 + *(const f32x4*)(sw + 2 * DG) * s);
        *(f32x4*)so = s1; *(f32x4*)(so + DG) = s;
        const float r = rsqrtf(wave_sum(hsq4(y)) * (1.0f / DG) + EPS);
        *(f32x4*)(ys + 2 * DG + c4) = y * r * *(const f32x4*)(mog + 2 * DG + c4);
    }
    else {
        const f32x4 px = *(const f32x4*)(z + 1792 + c4) * zrs;
        const float* st = a->in[I_SPL] + ((size_t)(l * NS + bs) * 15) * DG + c4;
        float* so = a->out + O_PLS + ((size_t)(l * NS + bs) * 15) * DG + c4;
        const int g = lane >> 4, w = 2 << g;
        f32x4 sum = px;
#pragma unroll
        for (int j = 0; j < 15; ++j) { const f32x4 sv = *(const f32x4*)(st + j * DG); if (15 - j < w) sum += sv; if (j >= 1) *(f32x4*)(so + (j - 1) * DG) = sv; }
        *(f32x4*)(so + 14 * DG) = px;
        const f32x4 pooled = sum / (float)w - px;
        LAS float* PLs = (LAS float*)(lds + wave * 1024);
        *(LAS f32x4*)(PLs + c4) = pooled;
        asm volatile("s_waitcnt lgkmcnt(0)" ::: "memory");
        const float* pw = a->in[I_PW] + (size_t)l * 16384 + (size_t)g * 4096 + 4 * (lane & 15);
        f32x4 acc = {0.f, 0.f, 0.f, 0.f};
#pragma unroll 16
        for (int c = 0; c < 64; ++c) acc += *(const f32x4*)(pw + c * 64) * PLs[g * 64 + c];
        const f32x4 y = acc * *(const f32x4*)(a->in[I_PSC] + l * DG + c4);
        const float r = rsqrtf(wave_sum(hsq4(y)) * (1.0f / DG) + EPS);
        *(f32x4*)(ys + 3 * DG + c4) = y * r * *(const f32x4*)(mog + 3 * DG + c4);
        asm volatile("s_waitcnt lgkmcnt(0)" ::: "memory");
    }
}

constexpr int KVP = 264;
DI void attn_unit(AP a, int l, int uidx, LAS unsigned char* lds, int wave, int lane) {
    unsigned char* ws = a->ws;
    const int b = uidx >> 5, h = (uidx >> 3) & 3, qt = uidx & 7;
    const int r32 = lane & 31, hi = lane >> 5, tid = wave * 64 + lane;
    LAS bf16_t* KV = (LAS bf16_t*)lds;
    const size_t q0 = (size_t)b * SEQ + qt * 256 + 32 * wave;
    const bf16_t* Qp = (const bf16_t*)(ws + WS_Q) + (q0 + r32) * DM + h * 256 + 8 * hi;
    const bf16_t* Kg = (const bf16_t*)(ws + WS_KP) + ((size_t)l * MM + b * 256) * DM + h * 256;
    const bf16_t* Vg = (const bf16_t*)(ws + WS_VT) + ((size_t)((l * NB + b) * 4 + h) * 256) * 256;
    const bf16_t* kgl = Kg + (size_t)(tid >> 5) * DM + (tid & 31) * 8; const bf16_t* vgl = Vg + (size_t)(tid >> 5) * 256 + (tid & 31) * 8;
    LAS bf16_t* kvl = KV + (tid >> 5) * KVP + (tid & 31) * 8;
    bf16x8 qf[16];
#pragma unroll
    for (int ks = 0; ks < 16; ++ks) qf[ks] = __builtin_nontemporal_load((const bf16x8*)(Qp + 16 * ks));
    u32x4 st[16];
#pragma unroll
    for (int i = 0; i < 16; ++i) st[i] = *(const u32x4*)(kgl + i * 16 * DM);
#pragma unroll
    for (int i = 0; i < 16; ++i) *(LAS u32x4*)(kvl + i * 16 * KVP) = st[i];
    __syncthreads();
    f32x16 S[8];
#pragma unroll
    for (int kt = 0; kt < 8; ++kt) {
#pragma unroll
        for (int i = 0; i < 16; ++i) S[kt][i] = 0.f;
#pragma unroll
        for (int ks = 0; ks < 16; ++ks) {
            const bf16x8 kf = *(const LAS bf16x8*)(KV + (kt * 32 + r32) * KVP + 16 * ks + 8 * hi);
            S[kt] = __builtin_amdgcn_mfma_f32_32x32x16_bf16(kf, qf[ks], S[kt], 0, 0, 0);
        }
    }
    asm volatile("" ::: "memory");
#pragma unroll
    for (int i = 0; i < 8; ++i) st[i] = *(const u32x4*)(vgl + i * 16 * 256);
    float mx = -3.0e38f;
#pragma unroll
    for (int kt = 0; kt < 8; ++kt)
#pragma unroll
        for (int i = 0; i < 16; ++i) mx = fmaxf(mx, S[kt][i]);
    mx = fmaxf(mx, __shfl_xor(mx, 32));
    float sum = 0.f; const float mxl = mx * 1.4426950408889634f;
    bf16x8 pf[16];
#pragma unroll
    for (int kt = 0; kt < 8; ++kt) {
#pragma unroll
        for (int i = 0; i < 16; ++i) { const float p = __builtin_amdgcn_exp2f(S[kt][i] * 1.4426950408889634f - mxl); S[kt][i] = p; sum += p; }
#pragma unroll
        for (int c = 0; c < 2; ++c) {
            u32x4 p; p.x = pk2(S[kt][8 * c + 0], S[kt][8 * c + 1]); p.y = pk2(S[kt][8 * c + 2], S[kt][8 * c + 3]); p.z = pk2(S[kt][8 * c + 4], S[kt][8 * c + 5]); p.w = pk2(S[kt][8 * c + 6], S[kt][8 * c + 7]);
            pf[2 * kt + c] = __builtin_bit_cast(bf16x8, p);
        }
    }
    sum += __shfl_xor(sum, 32);
    const float inv = 1.0f / sum;
    __syncthreads();
#pragma unroll
    for (int i = 0; i < 8; ++i) *(LAS u32x4*)(kvl + i * 16 * KVP) = st[i];
    asm volatile("" ::: "memory");
#pragma unroll
    for (int i = 0; i < 8; ++i) st[i] = *(const u32x4*)(vgl + (i + 8) * 16 * 256);
    __syncthreads();
    bf16_t* Op = (bf16_t*)(ws + WS_O) + (q0 + r32) * DM + h * 256 + 4 * hi;
#pragma unroll
    for (int dt = 0; dt < 8; ++dt) {
        if (dt == 4) {
#pragma unroll
            for (int i = 0; i < 8; ++i) *(LAS u32x4*)(kvl + (i + 8) * 16 * KVP) = st[i];
            __syncthreads();
        }
        f32x16 o;
#pragma unroll
        for (int i = 0; i < 16; ++i) o[i] = 0.f;
#pragma unroll
        for (int kc = 0; kc < 16; ++kc) {
            const LAS bf16_t* vp = KV + (dt * 32 + r32) * KVP + 16 * kc + 4 * hi;
            const u32x2 v0 = *(const LAS u32x2*)vp, v1 = *(const LAS u32x2*)(vp + 8);
            u32x4 vv; vv.x = v0.x; vv.y = v0.y; vv.z = v1.x; vv.w = v1.y;
            o = __builtin_amdgcn_mfma_f32_32x32x16_bf16(__builtin_bit_cast(bf16x8, vv), pf[kc], o, 0, 0, 0);
        }
#pragma unroll
        for (int rg = 0; rg < 4; ++rg) {
            u32x2 w; w.x = pk2(o[4 * rg] * inv, o[4 * rg + 1] * inv); w.y = pk2(o[4 * rg + 2] * inv, o[4 * rg + 3] * inv);
            ST8(Op + 32 * dt + 8 * rg, w);
        }
    }
    __syncthreads();
}

DI void attn_sample_unit(AP a, int l, int uidx, LAS unsigned char* lds, int wave, int lane) {
    unsigned char* ws = a->ws;
    const int bs = uidx >> 1, hp = uidx & 1, hh = lane >> 5;
    LAS float* ML = (LAS float*)lds;
    LAS float* RED = (LAS float*)(lds + 4096);
    const float* qp = (const float*)(ws + WS_QS) + ((size_t)l * NS + bs) * DM + hp * 512 + 8 * lane;
    const float qrs = 0.0625f * rsqrtf(((const float*)(ws + WS_SSQ))[(l * 3 + 1) * NS + bs] * (1.0f / DM) + EPS);
    const f32x4 q0 = *(const f32x4*)qp * qrs, q1 = *(const f32x4*)(qp + 4) * qrs;
    const float* Kb = a->in[I_CK] + ((size_t)(l * NS + bs) * MEM + 32 * wave) * DM + hp * 512 + 8 * lane;
    const float* Vb = a->in[I_CV] + ((size_t)(l * NS + bs) * MEM + 32 * wave) * DM + hp * 512 + 8 * lane;
    float mrun = -3.0e38f, lrun = 0.f; f32x4 o0 = {0.f, 0.f, 0.f, 0.f}, o1 = {0.f, 0.f, 0.f, 0.f};
    f32x4 k0[4], k1[4], v0[4], v1[4];
#pragma unroll
    for (int r = 0; r < 4; ++r) { const size_t ro = (size_t)r * DM; k0[r] = __builtin_nontemporal_load((const f32x4*)(Kb + ro)); k1[r] = __builtin_nontemporal_load((const f32x4*)(Kb + ro + 4)); v0[r] = __builtin_nontemporal_load((const f32x4*)(Vb + ro)); v1[r] = __builtin_nontemporal_load((const f32x4*)(Vb + ro + 4)); }
#pragma unroll 1
    for (int bt = 0; bt < 8; ++bt) {
        const float* Kn = Kb + (size_t)(bt < 7 ? 4 * (bt + 1) : 0) * DM; const float* Vn = Vb + (size_t)(bt < 7 ? 4 * (bt + 1) : 0) * DM;
        f32x4 nk0[4], nk1[4], nv0[4], nv1[4]; float sc[4];
#pragma unroll
        for (int r = 0; r < 4; ++r) { const size_t ro = (size_t)r * DM; nk0[r] = __builtin_nontemporal_load((const f32x4*)(Kn + ro)); nk1[r] = __builtin_nontemporal_load((const f32x4*)(Kn + ro + 4)); nv0[r] = __builtin_nontemporal_load((const f32x4*)(Vn + ro)); nv1[r] = __builtin_nontemporal_load((const f32x4*)(Vn + ro + 4)); }
        float bm = -3.0e38f;
#pragma unroll
        for (int r = 0; r < 4; ++r) {
            float d = hsum4(k0[r] * q0) + hsum4(k1[r] * q1);
            d = half_sum32(d, lane);
            sc[r] = d; bm = fmaxf(bm, d);
        }
        const float mnew = fmaxf(mrun, bm), resc = __expf(mrun - mnew);
        lrun *= resc; o0 = o0 * resc; o1 = o1 * resc; mrun = mnew;
#pragma unroll
        for (int r = 0; r < 4; ++r) { const float p = __expf(sc[r] - mnew); lrun += p; o0 += v0[r] * p; o1 += v1[r] * p; }
#pragma unroll
        for (int r = 0; r < 4; ++r) { k0[r] = nk0[r]; k1[r] = nk1[r]; v0[r] = nv0[r]; v1[r] = nv1[r]; }
    }
    if ((lane & 31) == 0) { ML[(wave * 2 + hh) * 2] = mrun; ML[(wave * 2 + hh) * 2 + 1] = lrun; }
    *(LAS f32x4*)(RED + wave * 512 + 8 * lane) = o0; *(LAS f32x4*)(RED + wave * 512 + 8 * lane + 4) = o1;
    __syncthreads();
    {
        const int t = wave * 64 + lane, h2 = t >> 8; float mx = -3.0e38f;
#pragma unroll
        for (int w = 0; w < 8; ++w) mx = fmaxf(mx, ML[(w * 2 + h2) * 2]);
        float num = 0.f, den = 0.f;
#pragma unroll
        for (int w = 0; w < 8; ++w) { const float e = __expf(ML[(w * 2 + h2) * 2] - mx); num += e * RED[w * 512 + t]; den += e * ML[(w * 2 + h2) * 2 + 1]; }
        ((float*)(ws + WS_OS))[(size_t)bs * DM + hp * 512 + t] = num / den;
    }
    __syncthreads();
}

#define XB_TMO      128
#define XB_XCNT(j)  (256  + 64 * (j))
#define XB_XSUB(j)  (1280 + 64 * (j))
#define XB_XGEN(j)  (2304 + 64 * (j))
#define XB_TOP      3328
#define XB_TOPGEN   3392
#define XCD_BAR_WORDS 3456
#define XB_SPIN_CAP (1u << 18)
DI unsigned xb_ld(unsigned* p)              { return __hip_atomic_load(p, __ATOMIC_RELAXED, __HIP_MEMORY_SCOPE_AGENT); }
DI unsigned xb_add(unsigned* p, unsigned v) { return __hip_atomic_fetch_add(p, v, __ATOMIC_RELAXED, __HIP_MEMORY_SCOPE_AGENT); }
DI unsigned xb_xcc_id() { return (unsigned)__builtin_amdgcn_s_getreg((3 << 11) | 20) & 0xFu; }
#define XB_SPIN(cond, bar) do { unsigned _sp = 0; while (cond) { __builtin_amdgcn_s_sleep(1); \
    if ((++_sp & 255u) == 0u) { if (xb_ld(&(bar)[XB_TMO])) break; if (_sp > XB_SPIN_CAP) { atomicAdd(&(bar)[XB_TMO], 1u); break; } } } } while (0)
struct XcdBarrier { unsigned* bar; unsigned x; volatile LAS unsigned* st; };
DI XcdBarrier xcd_barrier_post(unsigned* bar, volatile LAS unsigned* st) {
    XcdBarrier b; b.bar = bar; b.x = xb_xcc_id(); b.st = st;
    if (threadIdx.x == 0) (void)xb_add(&bar[XB_XCNT(b.x)], 1u);
    return b;
}
DI void xcd_barrier_complete(unsigned* bar, unsigned x, unsigned& nloc, unsigned& nx) {
    const unsigned G = gridDim.x * gridDim.y * gridDim.z;
    unsigned sum, cnt, mine, sp = 0u;
    for (;;) {
        sum = 0u; cnt = 0u; mine = 0u;
#pragma unroll
        for (unsigned j = 0; j < 16; ++j) { const unsigned c = xb_ld(&bar[XB_XCNT(j)]); sum += c; cnt += (c > 0u) ? 1u : 0u; mine = (j == x) ? c : mine; }
        if (sum == G) break;
        __builtin_amdgcn_s_sleep(1);
        if ((++sp & 255u) == 0u) { if (xb_ld(&bar[XB_TMO])) break; if (sp > XB_SPIN_CAP) { atomicAdd(&bar[XB_TMO], 1u); break; } }
    }
    nloc = mine > 0u ? mine : 1u; nx = cnt > 0u ? cnt : 1u;
}
DI void xcd_barrier(const XcdBarrier& b) {
    asm volatile("s_waitcnt vmcnt(0)" ::: "memory");
    __syncthreads();
    if (threadIdx.x == 0) {
        unsigned* bar = b.bar;
        __builtin_amdgcn_s_waitcnt(0);
        unsigned nloc = b.st[0], nx = b.st[1];
        if (nloc == 0u) { xcd_barrier_complete(bar, b.x, nloc, nx); b.st[0] = nloc; b.st[1] = nx; }
        const unsigned old = xb_add(&bar[XB_XSUB(b.x)], 1u);
        const unsigned gen = old / nloc;
        if (old + 1u == (gen + 1u) * nloc) {
            __builtin_amdgcn_fence(__ATOMIC_RELEASE, "agent");
            asm volatile("s_waitcnt vmcnt(0)" ::: "memory");
            const unsigned og = xb_add(&bar[XB_TOP], 1u);
            const unsigned tg = og / nx;
            if (og + 1u == (tg + 1u) * nx) xb_add(&bar[XB_TOPGEN], 1u);
            else XB_SPIN(xb_ld(&bar[XB_TOPGEN]) == tg, bar);
            __builtin_amdgcn_fence(__ATOMIC_ACQUIRE, "agent");
            xb_add(&bar[XB_XGEN(b.x)], 1u);
            asm volatile("s_waitcnt vmcnt(0)" ::: "memory");
        } else {
            XB_SPIN(xb_ld(&bar[XB_XGEN(b.x)]) == gen, bar);
            __builtin_amdgcn_fence(__ATOMIC_ACQUIRE, "agent");
            asm volatile("s_waitcnt vmcnt(0)" ::: "memory");
        }
    }
    __syncthreads();
}

template <int NLD> DI unsigned l2_touch(const bf16_t* panel, int share, int tid) {
    const char* p = (const char*)panel + ((size_t)share * NLD * NTHR + tid) * 128;
    unsigned v[NLD];
#pragma unroll
    for (int i = 0; i < NLD; ++i) v[i] = *(const unsigned*)(p + (size_t)i * NTHR * 128);
    unsigned acc = 0u;
#pragma unroll
    for (int i = 0; i < NLD; ++i) acc |= v[i];
    return acc;
}
template <int NR> DI void gemm_touch(const pg8::Gemm& g, const pg8::StaticOrder& S, int tid) {
    pg8::Unit u;
    if (!S.next(0, u)) return;
    unsigned acc = l2_touch<2>(g.A + (size_t)u.pm * 256 * g.K, u.pn & 3, tid);
#pragma unroll
    for (int i = 0; i < NR; ++i) { pg8::Unit w = u; S.next(i, w); acc |= l2_touch<1>(g.Bt + (size_t)w.pn * 256 * g.K, w.pm & 7, tid); }
    asm volatile("" :: "v"(acc));
}

#ifndef PMASK
#define PMASK 0xffff
#endif
#ifndef DUPMASK
#define DUPMASK 0
#endif
#ifndef TOUCH
#define TOUCH 0
#endif
#ifndef SPINSET
#define SPINSET 0
#endif
constexpr int N_PHASES = 18;
__global__ void __launch_bounds__(NTHR, 2) fwd_kernel(Args a_) {
    extern __shared__ __attribute__((aligned(16))) unsigned char lds_raw[];
    LAS unsigned char* lds = (LAS unsigned char*)lds_raw;
    cg::grid_group grid = cg::this_grid();
    volatile LAS unsigned* MISC = (volatile LAS unsigned*)(lds + LDS_BYTES - 256);
    if (threadIdx.x < 32) MISC[threadIdx.x] = 0u;
    __syncthreads();
    const XcdBarrier xbar = xcd_barrier_post((unsigned*)(a_.ws + WS_CTL), MISC + 8);
    const int ph_lo = a_.ph_lo, ph_hi = a_.ph_hi;
    for (int ph = ph_lo; ph < ph_hi; ++ph) {
        AP a = (AP)__builtin_amdgcn_kernarg_segment_ptr();
        asm volatile("" : "+s"(a));
        int tid = threadIdx.x; asm volatile("" : "+v"(tid));
        const int lane = tid & 63, wave = __builtin_amdgcn_readfirstlane(tid >> 6);
        int bx = blockIdx.x; asm volatile("" : "+s"(bx));
        const int G = gridDim.x;
        const unsigned long long t_ph0 = SPINSET ? __builtin_amdgcn_s_memrealtime() : 0ull;
        unsigned char* ws = a->ws;
        bf16_t* XB = (bf16_t*)(ws + WS_XB); float* SS = (float*)(ws + WS_SS); float* XF = a->out + O_YP;
        float* XS = (float*)(ws + WS_XS); float* YS = (float*)(ws + WS_YS); float* OS = (float*)(ws + WS_OS);
        if (ph == 0) {
            for (int rep = 0; rep < ((DUPMASK & 64) ? 2 : 1); ++rep) prologue(a, lds, wave, lane);
        } else if (ph == N_PHASES - 1) { if (PMASK & 2) {
            int lnf_ = lane; asm volatile("" : "+v"(lnf_)); const int lane = lnf_;
            const int gw = bx * NWAVES + wave, NGW = G * NWAVES;
            const float* gf = a->in[I_NFIN];
            for (int m0 = gw; m0 < MP; m0 += 4 * NGW) {
                u32x2 xv[4][4]; float rs[4];
#pragma unroll
                for (int k = 0; k < 4; ++k) { const int m = min(m0 + k * NGW, MP - 1); rs[k] = row_rs(SS + (size_t)m * 16);
#pragma unroll
                    for (int j = 0; j < 4; ++j) xv[k][j] = __builtin_nontemporal_load((const u32x2*)(XB + (size_t)m * DM + 4 * lane + 256 * j)); }
#pragma unroll
                for (int k = 0; k < 4; ++k) { const int m = m0 + k * NGW; if (m < MP) { f32x4* yr = (f32x4*)(XF + (size_t)m * DM) + lane;
#pragma unroll
                    for (int j = 0; j < 4; ++j) __builtin_nontemporal_store((f32x4){bflo(xv[k][j].x), bfhi(xv[k][j].x), bflo(xv[k][j].y), bfhi(xv[k][j].y)} * rs[k] * ((const f32x4*)gf)[lane + 64 * j], yr + 64 * j); } }
            }
            for (int m = MP + gw; m < MP + NS; m += NGW) {
                if (m < MP) {
                } else {
                    const int s = m - MP; const f32x4* xr = (const f32x4*)(XS + (size_t)s * DM) + lane; f32x4 v[4]; float sq = 0.f;
#pragma unroll
                    for (int j = 0; j < 4; ++j) { v[j] = xr[64 * j]; sq += hsq4(v[j]); }
                    const float rs = rsqrtf(wave_sum(sq) * (1.0f / DM) + EPS);
                    f32x4* yo = (f32x4*)(a->out + O_YS + (size_t)s * DM) + lane;
#pragma unroll
                    for (int j = 0; j < 4; ++j) yo[64 * j] = v[j] * rs * ((const f32x4*)gf)[lane + 64 * j];
                }
            }
        } } else {
            const int l = (ph - 1) >> 3, sub = (ph - 1) & 7;
            unsigned char* wl = ws + WS_W + (size_t)l * W_LSTRIDE;
            float* SSQ = (float*)(ws + WS_SSQ);
            if (sub == 1) {
                { const bool light = (G == 256) && (((bx >> 3) & 3) == 0); const int gwr = (G == 256) ? (light ? (((bx >> 5) * 8 + (bx & 7)) * NWAVES + wave) : 4 * NS) : (G - 1 - bx) * NWAVES + wave; if (gwr < 4 * NS) mixer_sample(a, l, gwr >> 2, gwr & 3, lds, wave, lane); }
                __syncthreads();
                { const int vcu = (G & 7) == 0 ? (bx & 7) * (G >> 3) + (bx >> 3) : bx; for (int u = vcu; u < 256; u += G) mixer_unit(a, l, u, lds, wave, lane); }
            } else if (sub == 4) {
                for (int u = bx; u < 256; u += G) attn_sample_unit(a, l, u, lds, wave, lane);
                { const int vcu = (G & 7) == 0 ? (bx & 7) * (G >> 3) + (bx >> 3) : bx; for (int u = vcu; u < 256; u += G) attn_unit(a, l, u, lds, wave, lane); }
            } else {
                if (sub == 0) sgemm_phase_p<0, true, 2, 2>(XS, DM, (const bf16_t*)(wl + W_IN), DIN, (float*)(ws + WS_ZS) + (size_t)l * NS * DIN, nullptr, SSQ + (l * 3 + 0) * NS, ws, bx, G, wave, lane);
                else if (sub == 2) sgemm_phase_p<0, false, 1, 2>(YS, DM, (const bf16_t*)(wl + W_OUT), DM, XS, nullptr, nullptr, ws, bx, G, wave, lane);
                else if (sub == 3) sgemm_phase_p<0, true, 1, 2>(XS, DM, (const bf16_t*)(wl + W_Q), DM, (float*)(ws + WS_QS) + (size_t)l * NS * DM, nullptr, SSQ + (l * 3 + 1) * NS, ws, bx, G, wave, lane);
                else if (sub == 5) sgemm_phase_p<0, false, 1, 2>(OS, DM, (const bf16_t*)(wl + W_O), DM, XS, nullptr, nullptr, ws, bx, G, wave, lane);
                else if (sub == 6) sgemm_phase_p<0, true, 4, 4>(XS, DM, (const bf16_t*)(wl + W_F1), DFF, (float*)(ws + WS_HS) + (size_t)l * NS * DFF, nullptr, SSQ + (l * 3 + 2) * NS, ws, bx, G, wave, lane);
                else sgemm_phase_p<1, false, 2, 4>((const float*)(ws + WS_HS) + (size_t)l * NS * DFF, DFF, (const bf16_t*)(wl + W_F2), DM, XS, SSQ + (l * 3 + 2) * NS, nullptr, ws, bx, G, wave, lane);
                const int ngemm = (sub == 0 && l == 0) ? 2 : 1;
                for (int gi = 0; gi < ngemm; ++gi) {
                    pg8::Gemm g; EpiAny E{};
                    if (gi == 1) { g = pg8::Gemm{(const bf16_t*)(ws + WS_MEMB), (const bf16_t*)(ws + WS_WKV), MM, 4096, DM};
                        E.mode = 3; E.mss = (const float*)(ws + WS_MEMSS); E.outK = a->out + O_MK; E.outV = a->out + O_MV; E.KP = (bf16_t*)(ws + WS_KP); E.VT = (bf16_t*)(ws + WS_VT); }
                    else if (sub == 0) { g = pg8::Gemm{XB, (const bf16_t*)(wl + W_IN), MP, DIN, DM}; E.mode = 0; E.O = (bf16_t*)(ws + WS_Z); E.ldc = DIN; E.ss = SS; }
                    else if (sub == 3) { g = pg8::Gemm{XB, (const bf16_t*)(wl + W_Q), MP, DM, DM}; E.mode = 1; E.O = (bf16_t*)(ws + WS_Q); E.ldc = DM; E.ss = SS; }
                    else if (sub == 6) { g = pg8::Gemm{XB, (const bf16_t*)(wl + W_F1), MP, DFF, DM}; E.mode = 2; E.O = (bf16_t*)(ws + WS_H); E.ldc = DFF; E.ss = SS; }
                    else { g = pg8::Gemm{(const bf16_t*)(ws + (sub == 2 ? WS_Y : sub == 5 ? WS_O : WS_H)), (const bf16_t*)(wl + (sub == 2 ? W_OUT : sub == 5 ? W_O : W_F2)), MP, DM, sub == 7 ? DFF : DM};
                        E.mode = 4; E.O = XB; E.ssw = SS; }
                    pg8::StaticOrder S; S.init(g.M, g.N, G, bx);
                    pg8::gemm_phase<EpiAny, pg8::StaticOrder, true, true>(lds, g, S, E);
                }
            }
        }
        if (ph + 1 < ph_hi) { if (ph >= N_PHASES) grid.sync();   else { PRO_T0(); xcd_barrier(xbar); PRO_T1(8192); if (DUPMASK & 16) xcd_barrier(xbar); } }
        if (SPINSET) {
            const int cls = ph == 0 ? 0 : ph == N_PHASES - 1 ? 9 : 1 + ((ph - 1) & 7);
            if ((SPINSET >> cls) & 1) { const unsigned long long t1 = __builtin_amdgcn_s_memrealtime(), tgt = t1 + (t1 - t_ph0); while (__builtin_amdgcn_s_memrealtime() < tgt) __builtin_amdgcn_s_sleep(8); }
        }
    }
}

#ifndef N_LAUNCH_MODE
#define N_LAUNCH_MODE 1
#endif
extern "C" void kernel_launch(void* const* d_in, const int* in_sizes, int n_in, void* d_out, int out_size, void* d_ws, size_t ws_size, hipStream_t stream) {
    static int grid = 0;
    if (grid == 0) {
        if (n_in != N_IN || (size_t)out_size != O_END || ws_size < WS_END + 106 * MiB) { fprintf(stderr, "kernel_launch: unexpected sizes n_in %d out %d ws %zu\n", n_in, out_size, ws_size); grid = -1; return; }
        int dev = 0, cus = 0, per_cu = 0;
        if (hipGetDevice(&dev) != hipSuccess || hipDeviceGetAttribute(&cus, hipDeviceAttributeMultiprocessorCount, dev) != hipSuccess) { grid = -1; return; }
        if (hipFuncSetAttribute((const void*)fwd_kernel, hipFuncAttributeMaxDynamicSharedMemorySize, LDS_BYTES) != hipSuccess) { fprintf(stderr, "kernel_launch: hipFuncSetAttribute failed\n"); grid = -1; return; }
        if (hipOccupancyMaxActiveBlocksPerMultiprocessor(&per_cu, (const void*)fwd_kernel, NTHR, LDS_BYTES) != hipSuccess || per_cu < 1) { fprintf(stderr, "kernel_launch: occupancy query says %d\n", per_cu); per_cu = 1; }
        (void)hipGetLastError();
        grid = cus;
    }
    if (grid < 0) return;
    if (hipMemsetAsync((char*)d_ws + WS_CTL, 0, CTL_ZERO_BYTES, stream) != hipSuccess) { fprintf(stderr, "kernel_launch: memset failed\n"); return; }
    Args a{};
    for (int i = 0; i < N_IN; ++i) a.in[i] = (const float*)d_in[i];
    a.out = (float*)d_out; a.ws = (unsigned char*)d_ws;
#if N_LAUNCH_MODE == 1
    a.ph_lo = 0; a.ph_hi = N_PHASES;
    void* args[] = {&a};
    hipError_t e = hipLaunchCooperativeKernel((const void*)fwd_kernel, dim3(grid), dim3(NTHR), args, LDS_BYTES, stream);
    if (e != hipSuccess) fprintf(stderr, "cooperative launch failed: %s (grid %d)\n", hipGetErrorString(e), grid);
#else
    for (int ph = 0; ph < N_PHASES; ++ph) {
        a.ph_lo = ph; a.ph_hi = ph + 1;
        hipLaunchKernelGGL(fwd_kernel, dim3(grid), dim3(NTHR), LDS_BYTES, stream, a);
    }
#endif
}
```

```cpp
#define DUPMASK 0
#define SPINSET 0
#define MIXSPIN 0
#include <hip/hip_runtime.h>
#include <hip/hip_cooperative_groups.h>
#include <cstdio>
#include <cstdint>
namespace cg = cooperative_groups;
namespace pg8 {
#define PG8_LAS __attribute__((address_space(3)))
typedef unsigned short bf16_t;
typedef short bf16x8 __attribute__((ext_vector_type(8)));
typedef float f32x4 __attribute__((ext_vector_type(4)));
typedef unsigned u32x4 __attribute__((ext_vector_type(4)));
constexpr int BM = 256, BK = 64, HALF = 128, HTB = HALF * BK * 2  , STAGE_BYTES = 8 * HTB, NXCD = 8, WGM = 8;

__host__ __device__ __forceinline__ int lds_byte(int r, int c) { const int st = (r >> 4) * 2 + (c >> 5), rr = r & 15, cc = c & 31, ob = rr * 64 + cc * 2; return st * 1024 + (ob ^ (((ob >> 9) & 1) << 5)); }
__host__ __device__ __forceinline__ void stage_rc(int b, int& R, int& C) { const int st = b / 1024, sb = b % 1024, swz = sb ^ (((sb >> 9) & 1) << 5); R = (st >> 1) * 16 + swz / 64; C = (st & 1) * 32 + (swz % 64) / 2; }
__host__ __device__ __forceinline__ int perm32(int rho) { const int n = rho >> 4, i = rho & 15; return 8 * (i >> 2) + 4 * n + (i & 3); }

struct Unit { int pm, pn; };
struct Gemm { const bf16_t* A; const bf16_t* Bt; int M, N, K; };

struct StaticOrder {
    int nM, nN, nwg, G, c;
    __host__ __device__ void init(int M, int N, int G_, int c_) { nM = M / BM; nN = N / BM; nwg = nM * nN; G = G_; c = c_; }
    __host__ __device__ bool next(int i, Unit& u) const {
        const long L = (long)i * G + c; if (L >= nwg) return false;
        int wgid = (int)L; { const int q = nwg / NXCD, r = nwg % NXCD, xcd = wgid % NXCD, off = wgid / NXCD; wgid = (xcd < r ? xcd * (q + 1) : r * (q + 1) + (xcd - r) * q) + off; }
        const int nig = WGM * nN, gid = wgid / nig, fm = gid * WGM, gsz = (nM - fm) < WGM ? (nM - fm) : WGM;
        u.pm = fm + ((wgid % nig) % gsz); u.pn = (wgid % nig) / gsz; return true;
    }
    __device__ __forceinline__ void a_ready(const Unit&) const {}
    __device__ __forceinline__ void done(const Unit&) const {}
};

__device__ __forceinline__ unsigned cvt_pk_bf16(float lo, float hi) { unsigned r; asm volatile("v_cvt_pk_bf16_f32 %0, %1, %2" : "=v"(r) : "v"(lo), "v"(hi)); return r; }
typedef float f32x2 __attribute__((ext_vector_type(2)));
template <class Epi, class Sched, bool ALIGN_EPI = false, bool SP2 = false>
__device__ __forceinline__ void gemm_phase(PG8_LAS unsigned char* lds, const Gemm g, const Sched& S, const Epi& E) {
    int tid = threadIdx.x; asm volatile("" : "+v"(tid)); const int wid = __builtin_amdgcn_readfirstlane(tid >> 6), lane = tid & 63, wr = wid >> 2, wc = wid & 3, fr = lane & 15, fq = lane >> 4;
    const int K = g.K, nt = K / BK;
    unsigned voffA[2], voffB[2];
#pragma unroll
    for (int i = 0; i < 2; ++i) { int R, C; stage_rc(tid * 16 + i * 8192, R, C); const int Rb = Epi::PERM ? ((R & ~31) + perm32(R & 31)) : R;
        voffA[i] = (unsigned)(R * K + C) * 2u; voffB[i] = (unsigned)(Rb * K + C) * 2u; }
    const size_t kstep = (size_t)(BK * 2);
    const size_t hstep = (size_t)HALF * K * 2;
    const size_t tstep = 2 * hstep;
    const unsigned ldsw = (unsigned)wid * 1024u;
    const int aoff = lds_byte(wr * 64 + fr, fq * 8), boff = lds_byte(wc * 32 + fr, fq * 8);
#define PG8_SA(b, h) (((b) * 2 + (h)) * HTB)
#define PG8_SB(b, h) ((4 + (b) * 2 + (h)) * HTB)
#define PG8_STAGE(bufoff, gbase, voff) do { _Pragma("unroll") for (int _i = 0; _i < 2; ++_i) \
        __builtin_amdgcn_global_load_lds((const unsigned*)((const char*)(gbase) + (voff)[_i]), (PG8_LAS unsigned*)(lds + (bufoff) + ldsw + _i * 8192), 16, 0, 0); } while (0)
#define PG8_LDA(dst, b, h) do { _Pragma("unroll") for (int m = 0; m < 4; ++m) _Pragma("unroll") for (int k = 0; k < 2; ++k) dst[m][k] = *(const PG8_LAS bf16x8*)(lds + PG8_SA(b, h) + aoff + m * 2048 + k * 1024); } while (0)
#define PG8_LDB(dst, b, h) do { _Pragma("unroll") for (int n = 0; n < 2; ++n) _Pragma("unroll") for (int k = 0; k < 2; ++k) dst[n][k] = *(const PG8_LAS bf16x8*)(lds + PG8_SB(b, h) + boff + n * 2048 + k * 1024); } while (0)
#define PG8_MMA(ai, bj, At, Bt) do { __builtin_amdgcn_s_setprio(1); _Pragma("unroll") for (int m = 0; m < 4; ++m) _Pragma("unroll") for (int n = 0; n < 2; ++n) _Pragma("unroll") for (int k = 0; k < 2; ++k) \
        acc[ai][bj][m][n] = __builtin_amdgcn_mfma_f32_16x16x32_bf16(Bt[n][k], At[m][k], acc[ai][bj][m][n], 0, 0, 0); __builtin_amdgcn_s_setprio(0); } while (0)
#define PG8_WAIT_V(n) asm volatile("s_waitcnt vmcnt(" #n ")" ::: "memory")
#define PG8_WAIT_L(n) asm volatile("s_waitcnt lgkmcnt(" #n ")" ::: "memory")
#define PG8_BAR __builtin_amdgcn_s_barrier()
#define PG8_SCHED __builtin_amdgcn_sched_barrier(0)
    Unit cur, nxt; int ui = 0;
    if (!S.next(0, cur)) return;
    f32x4 acc[2][2][4][2];
#pragma unroll
    for (int a = 0; a < 2; ++a)
#pragma unroll
        for (int b = 0; b < 2; ++b)
#pragma unroll
            for (int m = 0; m < 4; ++m)
#pragma unroll
                for (int n = 0; n < 2; ++n) acc[a][b][m][n] = (f32x4){0.f, 0.f, 0.f, 0.f};
    bf16x8 At[4][2], B0[2][2], B1[2][2];
    const char* cA = (const char*)g.A + (size_t)cur.pm * tstep; const char* cB = (const char*)g.Bt + (size_t)cur.pn * tstep;
    S.a_ready(cur);
    if constexpr (SP2) {
        PG8_STAGE(PG8_SB(0, 0), cB, voffB); PG8_STAGE(PG8_SB(0, 1), cB + hstep, voffB); PG8_STAGE(PG8_SA(0, 0), cA, voffA); PG8_STAGE(PG8_SA(0, 1), cA + hstep, voffA);
        if (wr == 1) PG8_BAR;
        PG8_WAIT_V(2); PG8_BAR;
        PG8_STAGE(PG8_SB(1, 0), cB + kstep, voffB); PG8_STAGE(PG8_SA(1, 0), cA + kstep, voffA); PG8_STAGE(PG8_SB(1, 1), cB + hstep + kstep, voffB);
        PG8_WAIT_V(6); PG8_BAR;
    } else {
        PG8_STAGE(PG8_SB(0, 0), cB, voffB); PG8_STAGE(PG8_SA(0, 0), cA, voffA); PG8_STAGE(PG8_SB(0, 1), cB + hstep, voffB); PG8_STAGE(PG8_SA(0, 1), cA + hstep, voffA);
        if (wr == 1) PG8_BAR;
        PG8_WAIT_V(4); PG8_BAR;
        PG8_STAGE(PG8_SB(1, 0), cB + kstep, voffB); PG8_STAGE(PG8_SA(1, 0), cA + kstep, voffA); PG8_STAGE(PG8_SB(1, 1), cB + hstep + kstep, voffB);
        PG8_WAIT_V(6); PG8_BAR;
    }
    for (;;) {
        const bool has_next = S.next(ui + 1, nxt);
        const char* nA = has_next ? (const char*)g.A + (size_t)nxt.pm * tstep : cA; const char* nB = has_next ? (const char*)g.Bt + (size_t)nxt.pn * tstep : cB;
        for (int t = 0; t < nt; t += 2) {
            const bool last = (t == nt - 2);
            const char* a1 = cA + (size_t)(t + 1) * kstep;
            const char* a2 = last ? nA : cA + (size_t)(t + 2) * kstep; const char* b2 = last ? nB : cB + (size_t)(t + 2) * kstep;
            const char* a3 = a2 + kstep; const char* b3 = b2 + kstep;
            if (last && has_next) S.a_ready(nxt);
            if constexpr (SP2) {
            PG8_LDB(B0, 0, 0); PG8_LDB(B1, 0, 1); PG8_SCHED; PG8_LDA(At, 0, 0); PG8_STAGE(PG8_SA(1, 1), a1 + hstep, voffA);
            PG8_WAIT_V(8); PG8_WAIT_L(0); PG8_BAR; PG8_MMA(0, 0, At, B0); PG8_MMA(0, 1, At, B1); PG8_BAR; PG8_SCHED;
            PG8_LDA(At, 0, 1); PG8_STAGE(PG8_SB(0, 0), b2, voffB); PG8_STAGE(PG8_SB(0, 1), b2 + hstep, voffB); PG8_STAGE(PG8_SA(0, 0), a2, voffA);
            PG8_WAIT_V(8); PG8_WAIT_L(0); PG8_BAR; PG8_MMA(1, 0, At, B0); PG8_MMA(1, 1, At, B1); PG8_BAR; PG8_SCHED;
            PG8_LDB(B0, 1, 0); PG8_LDB(B1, 1, 1); PG8_SCHED; PG8_LDA(At, 1, 0); PG8_STAGE(PG8_SA(0, 1), a2 + hstep, voffA);
            PG8_WAIT_V(8); PG8_WAIT_L(0); PG8_BAR; PG8_MMA(0, 0, At, B0); PG8_MMA(0, 1, At, B1); PG8_BAR; PG8_SCHED;
            PG8_LDA(At, 1, 1); PG8_STAGE(PG8_SB(1, 0), b3, voffB); PG8_STAGE(PG8_SB(1, 1), b3 + hstep, voffB); PG8_STAGE(PG8_SA(1, 0), a3, voffA);
            PG8_WAIT_V(8); PG8_WAIT_L(0); PG8_BAR; PG8_MMA(1, 0, At, B0); PG8_MMA(1, 1, At, B1); PG8_BAR; PG8_SCHED;
            } else {
            PG8_LDB(B0, 0, 0); PG8_SCHED; PG8_LDA(At, 0, 0); PG8_STAGE(PG8_SA(1, 1), a1 + hstep, voffA);
            PG8_WAIT_L(8); PG8_BAR; PG8_WAIT_L(0); PG8_MMA(0, 0, At, B0); PG8_BAR; PG8_SCHED;
            PG8_LDB(B1, 0, 1); PG8_STAGE(PG8_SB(0, 0), b2, voffB);
            PG8_BAR; PG8_WAIT_L(0); PG8_MMA(0, 1, At, B1); PG8_BAR;
            PG8_LDA(At, 0, 1); PG8_STAGE(PG8_SA(0, 0), a2, voffA);
            PG8_BAR; PG8_WAIT_L(0); PG8_MMA(1, 0, At, B0); PG8_BAR; PG8_SCHED;
            PG8_STAGE(PG8_SB(0, 1), b2 + hstep, voffB);
            PG8_WAIT_V(6); PG8_BAR; PG8_MMA(1, 1, At, B1); PG8_BAR;
            PG8_LDB(B0, 1, 0); PG8_SCHED; PG8_LDA(At, 1, 0); PG8_STAGE(PG8_SA(0, 1), a2 + hstep, voffA);
            PG8_WAIT_L(8); PG8_BAR; PG8_WAIT_L(0); PG8_MMA(0, 0, At, B0); PG8_BAR; PG8_SCHED;
            PG8_LDB(B1, 1, 1); PG8_STAGE(PG8_SB(1, 0), b3, voffB);
            PG8_BAR; PG8_WAIT_L(0); PG8_MMA(0, 1, At, B1); PG8_BAR;
            PG8_LDA(At, 1, 1); PG8_STAGE(PG8_SA(1, 0), a3, voffA);
            PG8_BAR; PG8_WAIT_L(0); PG8_MMA(1, 0, At, B0); PG8_BAR; PG8_SCHED;
            PG8_STAGE(PG8_SB(1, 1), b3 + hstep, voffB);
            PG8_WAIT_V(6); PG8_BAR; PG8_MMA(1, 1, At, B1); PG8_BAR;
            }
        }
        if constexpr (ALIGN_EPI) { if (wr == 0) PG8_BAR; }
        if constexpr (!Epi::AFTER_DRAIN) {
#if defined(MIXSPIN) && (MIXSPIN & 4096)
            const unsigned long long te0_ = __builtin_amdgcn_s_memrealtime();
#endif
            E(acc, cur, wr, wc, fr, fq); S.done(cur);
#if defined(MIXSPIN) && (MIXSPIN & 4096)
            { asm volatile("s_waitcnt vmcnt(0)" ::: "memory"); const unsigned long long te1_ = __builtin_amdgcn_s_memrealtime(), tg_ = te1_ + (te1_ - te0_); while (__builtin_amdgcn_s_memrealtime() < tg_) __builtin_amdgcn_s_sleep(8); }
#endif
        }
        if (!has_next) break;
#pragma unroll
        for (int a = 0; a < 2; ++a)
#pragma unroll
            for (int b = 0; b < 2; ++b)
#pragma unroll
                for (int m = 0; m < 4; ++m)
#pragma unroll
                    for (int n = 0; n < 2; ++n) acc[a][b][m][n] = (f32x4){0.f, 0.f, 0.f, 0.f};
        cur = nxt; cA = nA; cB = nB; ++ui;
        if constexpr (ALIGN_EPI) { if (wr == 1) PG8_BAR; }
    }
    PG8_WAIT_V(0);
    if constexpr (!ALIGN_EPI) { if (wr == 0) PG8_BAR; }
    PG8_BAR;
    if constexpr (Epi::AFTER_DRAIN) { E.fused(acc, cur, wr, wc, fr, fq, lds, wid, lane); S.done(cur); }
#undef PG8_SA
#undef PG8_SB
#undef PG8_STAGE
#undef PG8_LDA
#undef PG8_LDB
#undef PG8_MMA
#undef PG8_WAIT_V
#undef PG8_WAIT_L
#undef PG8_BAR
#undef PG8_SCHED
}
}

#define DI __device__ __forceinline__
#ifndef MIXSPIN
#define MIXSPIN 0
#endif
#define PRO_T0() const unsigned long long t_p0 = MIXSPIN ? __builtin_amdgcn_s_memrealtime() : 0ull
#define PRO_T1(bit) do { if (MIXSPIN & (bit)) { const unsigned long long t1_ = __builtin_amdgcn_s_memrealtime(), tg_ = t1_ + (t1_ - t_p0); while (__builtin_amdgcn_s_memrealtime() < tg_) __builtin_amdgcn_s_sleep(8); } } while (0)
#define LAS __attribute__((address_space(3)))
typedef unsigned short bf16_t;
typedef short bf16x8 __attribute__((ext_vector_type(8)));
typedef float f32x4 __attribute__((ext_vector_type(4)));
typedef float f32x16 __attribute__((ext_vector_type(16)));
typedef unsigned u32x4 __attribute__((ext_vector_type(4)));
typedef unsigned u32x2 __attribute__((ext_vector_type(2)));
typedef float f32x2_t __attribute__((ext_vector_type(2)));
typedef __bf16 bf16x2_t __attribute__((ext_vector_type(2)));

constexpr int DM = 1024, NB = 8, SEQ = 2048, MP = NB * SEQ, NL = 2, NS = 128, MEM = 256, MM = NB * MEM, DG = 256, DIN = 2048, DFF = 4096;
constexpr float EPS = 1e-6f;
constexpr int NWAVES = 8, NTHR = 512;
constexpr int LDS_BYTES = 147456;

constexpr size_t MiB = 1u << 20;
constexpr size_t WS_W = 2 * MiB, W_LSTRIDE = 28 * MiB;
constexpr size_t W_IN = 0, W_OUT = 4 * MiB, W_Q = 6 * MiB, W_O = 8 * MiB, W_F1 = 10 * MiB, W_F2 = 18 * MiB, W_GWS = 26 * MiB, W_PWT = 26 * MiB + 512 * 1024;
constexpr size_t WS_WKV = 58 * MiB;
constexpr size_t WS_MEMB = 66 * MiB;
constexpr size_t WS_MEMSS = 70 * MiB;
constexpr size_t WS_SS = 71 * MiB;
constexpr size_t WS_XB = 72 * MiB;
constexpr size_t WS_Z = 264 * MiB;
constexpr size_t WS_Y = 168 * MiB;
constexpr size_t WS_Q = WS_Y;
constexpr size_t WS_O = WS_Y;
constexpr size_t WS_H = 264 * MiB;
constexpr size_t WS_KP = 392 * MiB;
constexpr size_t WS_VT = 400 * MiB;
constexpr size_t WS_XS = 408 * MiB, WS_YS = 408 * MiB + 512 * 1024, WS_OS = 409 * MiB, WS_SSQ = 409 * MiB + 512 * 1024  , WS_ZS = 410 * MiB  , WS_QS = 412 * MiB  , WS_HS = 413 * MiB  , WS_END = 417 * MiB;
constexpr size_t WS_CTL = 0, CTL_ZERO_BYTES = 65536;

constexpr size_t O_YP = 0, O_YS = O_YP + (size_t)MP * DM, O_MK = O_YS + (size_t)NS * DM, O_MV = O_MK + (size_t)NL * MM * DM, O_GLUP = O_MV + (size_t)NL * MM * DM,
                 O_GLUS = O_GLUP + (size_t)NL * NB * 30 * DG, O_SHP = O_GLUS + (size_t)NL * NS * 30 * DG, O_SHS = O_SHP + (size_t)NL * NB * 2 * DG,
                 O_PLP = O_SHS + (size_t)NL * NS * 2 * DG, O_PLS = O_PLP + (size_t)NL * NB * 15 * DG, O_GV = O_PLS + (size_t)NL * NS * 15 * DG, O_END = O_GV + (size_t)NL * NS * DG;

enum { I_XP = 0, I_XS, I_MEM, I_CK, I_CV, I_SGLU, I_SSH, I_SPL, I_NMIX, I_WIN, I_LNG, I_LNB, I_GWS, I_GBS, I_CDW, I_CDWB, I_CLNG, I_CLNB, I_SCDW, I_PW, I_PSC, I_MOG, I_WOUT,
       I_NXA, I_NMEM, I_WQ, I_WK, I_WV, I_WO, I_NFF, I_WF1, I_WF2, I_NFIN, N_IN };

DI unsigned pk2(float lo, float hi) { f32x2_t v = {lo, hi}; bf16x2_t b = __builtin_convertvector(v, bf16x2_t); return __builtin_bit_cast(unsigned, b); }
DI float bf2f(unsigned short u) { return __uint_as_float((unsigned)u << 16); }
DI float bflo(unsigned u) { return __uint_as_float(u << 16); }
DI float bfhi(unsigned u) { return __uint_as_float(u & 0xffff0000u); }
DI f32x4 ld_bf4_nt(const bf16_t* p) { const u32x2 w = __builtin_nontemporal_load((const u32x2*)p); return (f32x4){bflo(w.x), bfhi(w.x), bflo(w.y), bfhi(w.y)}; }
DI f32x4 ld_bf4(const bf16_t* p) { const u32x2 w = *(const u32x2*)p; return (f32x4){bflo(w.x), bfhi(w.x), bflo(w.y), bfhi(w.y)}; }
#ifndef NTST
#define NTST 0
#endif
#if NTST == 2
DI void st_wt8(void* p, u32x2 v) { __hip_atomic_store((unsigned long long*)p, ((unsigned long long)v.y << 32) | v.x, __ATOMIC_RELAXED, __HIP_MEMORY_SCOPE_AGENT); }
#define ST16(p, v) do { const u32x4 v_ = (v); st_wt8((char*)(p), (u32x2){v_.x, v_.y}); st_wt8((char*)(p) + 8, (u32x2){v_.z, v_.w}); } while (0)
#define ST8(p, v) st_wt8((p), (v))
#elif NTST
#define ST16(p, v) __builtin_nontemporal_store((v), (u32x4*)(p))
#define ST8(p, v) __builtin_nontemporal_store((v), (u32x2*)(p))
#else
#define ST16(p, v) (*(u32x4*)(p) = (v))
#define ST8(p, v) (*(u32x2*)(p) = (v))
#endif
DI void st_bf4(bf16_t* p, f32x4 v) { u32x2 w; w.x = pk2(v.x, v.y); w.y = pk2(v.z, v.w); ST8(p, w); }
template <int CTRL> DI float dpp_f(float v) { return __int_as_float(__builtin_amdgcn_update_dpp(0, __float_as_int(v), CTRL, 0xf, 0xf, true)); }
DI float row_sum16(float v) {
    v += dpp_f<0xB1>(v);
    v += dpp_f<0x4E>(v);
    v += dpp_f<0x141>(v);
    v += dpp_f<0x140>(v);
    return v;
}
DI float rl_f(float v, int l) { return __int_as_float(__builtin_amdgcn_readlane(__float_as_int(v), l)); }
DI float wave_sum(float v) { v = row_sum16(v); return (rl_f(v, 0) + rl_f(v, 16)) + (rl_f(v, 32) + rl_f(v, 48)); }
DI float half_sum32(float v, int lane) { v = row_sum16(v); const float a = rl_f(v, 0) + rl_f(v, 16), b = rl_f(v, 32) + rl_f(v, 48); return lane < 32 ? a : b; }
DI float hsum4(f32x4 v) { return (v.x + v.y) + (v.z + v.w); }
DI float hsq4(f32x4 v) { return (v.x * v.x + v.y * v.y) + (v.z * v.z + v.w * v.w); }
DI float sigmoidf_(float x) { return __builtin_amdgcn_rcpf(1.0f + __builtin_amdgcn_exp2f(x * -1.4426950408889634f)); }
DI float row_rs(const float* ss16) {
    const f32x4* sp = (const f32x4*)ss16; const f32x4 a = sp[0], b = sp[1], c = sp[2], d = sp[3];
    const float s = (hsum4(a) + hsum4(b)) + (hsum4(c) + hsum4(d));
    return rsqrtf(s * (1.0f / DM) + EPS);
}

template <int MODE  > struct EpiScale {
    static constexpr bool PERM = true, AFTER_DRAIN = false;
    bf16_t* O; int ldc; const float* ss;
    DI void operator()(const f32x4 (&acc)[2][2][4][2], const pg8::Unit& u, int wr, int wc, int fr, int fq) const {
        const int row0 = u.pm * 256 + wr * 64 + fr, col0 = u.pn * 256 + wc * 32 + 8 * fq;
#pragma unroll
        for (int ai = 0; ai < 2; ++ai)
#pragma unroll
            for (int m = 0; m < 4; ++m) {
                const int row = row0 + ai * 128 + m * 16;
                float rs = row_rs(ss + (size_t)row * 16); if (MODE == 1) rs *= 0.0625f;
                bf16_t* rowp = O + (size_t)row * ldc + col0;
#pragma unroll
                for (int bj = 0; bj < 2; ++bj) {
                    f32x4 v0 = acc[ai][bj][m][0] * rs, v1 = acc[ai][bj][m][1] * rs;
                    if (MODE == 2) {
#pragma unroll
                        for (int j = 0; j < 4; ++j) { float a = fmaxf(v0[j], 0.f), b = fmaxf(v1[j], 0.f); v0[j] = a * a; v1[j] = b * b; }
                    }
                    u32x4 w; w.x = pk2(v0[0], v0[1]); w.y = pk2(v0[2], v0[3]); w.z = pk2(v1[0], v1[1]); w.w = pk2(v1[2], v1[3]);
                    ST16(rowp + bj * 128, w);
                }
            }
    }
};
struct EpiKV {
    static constexpr bool PERM = true, AFTER_DRAIN = false;
    const float* mss; float* outK; float* outV; bf16_t* KP; bf16_t* VT;
    DI void operator()(const f32x4 (&acc)[2][2][4][2], const pg8::Unit& u, int wr, int wc, int fr, int fq) const {
        const int l = u.pn >> 3, w8 = u.pn & 7, isV = w8 >> 2, h = w8 & 3, b = u.pm;
        const int row0 = u.pm * 256 + wr * 64 + fr, colh0 = h * 256 + wc * 32 + 8 * fq;
        float* outp = (isV ? outV : outK) + (size_t)l * MM * DM;
#pragma unroll
        for (int ai = 0; ai < 2; ++ai)
#pragma unroll
            for (int m = 0; m < 4; ++m) {
                const int row = row0 + ai * 128 + m * 16;
                const float rs = rsqrtf(mss[row] * (1.0f / DM) + EPS);
#pragma unroll
                for (int bj = 0; bj < 2; ++bj) {
                    const int colh = colh0 + bj * 128;
                    const f32x4 v0 = acc[ai][bj][m][0] * rs, v1 = acc[ai][bj][m][1] * rs;
                    __builtin_nontemporal_store(v0, (f32x4*)(outp + (size_t)row * DM + colh)); __builtin_nontemporal_store(v1, (f32x4*)(outp + (size_t)row * DM + colh + 4));
                    if (!isV) {
                        u32x4 w; w.x = pk2(v0[0], v0[1]); w.y = pk2(v0[2], v0[3]); w.z = pk2(v1[0], v1[1]); w.w = pk2(v1[2], v1[3]);
                        *(u32x4*)(KP + ((size_t)l * MM + row) * DM + colh) = w;
                    } else {
                        bf16_t* vt = VT + ((size_t)((l * NB + b) * 4 + h) * 256 + (colh & 255)) * 256 + (row & 255);
#pragma unroll
                        for (int j = 0; j < 4; ++j) { vt[(size_t)j * 256] = (bf16_t)(pk2(v0[j], 0.f) & 0xffffu); vt[(size_t)(j + 4) * 256] = (bf16_t)(pk2(v1[j], 0.f) & 0xffffu); }
                    }
                }
            }
    }
};
struct EpiRes {
    static constexpr bool PERM = true, AFTER_DRAIN = false;
    bf16_t* xb; float* ss;
    DI void operator()(const f32x4 (&acc)[2][2][4][2], const pg8::Unit& u, int wr, int wc, int fr, int fq) const {
        const int row0 = u.pm * 256 + wr * 64 + fr, col0 = u.pn * 256 + wc * 32 + 8 * fq;
        bf16_t* base = xb + (size_t)row0 * DM + col0;
        u32x4 ov[2][4][2];
#pragma unroll
        for (int ai = 0; ai < 2; ++ai)
#pragma unroll
            for (int m = 0; m < 4; ++m) { const bf16_t* rowp = base + (size_t)(ai * 128 + m * 16) * DM; ov[ai][m][0] = *(const u32x4*)rowp; ov[ai][m][1] = *(const u32x4*)(rowp + 128); }
#pragma unroll
        for (int ai = 0; ai < 2; ++ai)
#pragma unroll
            for (int m = 0; m < 4; ++m) {
                const int row = row0 + ai * 128 + m * 16; bf16_t* rowp = base + (size_t)(ai * 128 + m * 16) * DM;
                float sq = 0.f;
#pragma unroll
                for (int bj = 0; bj < 2; ++bj) {
                    const u32x4 o = ov[ai][m][bj];
                    f32x4 v0 = acc[ai][bj][m][0], v1 = acc[ai][bj][m][1];
                    v0.x += bflo(o.x); v0.y += bfhi(o.x); v0.z += bflo(o.y); v0.w += bfhi(o.y);
                    v1.x += bflo(o.z); v1.y += bfhi(o.z); v1.z += bflo(o.w); v1.w += bfhi(o.w);
                    sq += hsq4(v0) + hsq4(v1);
                    u32x4 w; w.x = pk2(v0[0], v0[1]); w.y = pk2(v0[2], v0[3]); w.z = pk2(v1[0], v1[1]); w.w = pk2(v1[2], v1[3]);
                    ST16(rowp + bj * 128, w);
                }
                sq += __shfl_xor(sq, 16); sq += __shfl_xor(sq, 32);
                if (fq == 0) ss[(size_t)row * 16 + u.pn * 4 + wc] = sq;
            }
    }
};

struct EpiAny {
    static constexpr bool PERM = true, AFTER_DRAIN = false;
    int mode;
    bf16_t* O; int ldc; const float* ss; float* ssw;
    const float* mss; float* outK; float* outV; bf16_t* KP; bf16_t* VT;
    DI void operator()(const f32x4 (&acc)[2][2][4][2], const pg8::Unit& u, int wr, int wc, int fr, int fq) const {
        if (mode == 0) EpiScale<0>{O, ldc, ss}(acc, u, wr, wc, fr, fq);
        else if (mode == 1) EpiScale<1>{O, ldc, ss}(acc, u, wr, wc, fr, fq);
        else if (mode == 2) EpiScale<2>{O, ldc, ss}(acc, u, wr, wc, fr, fq);
        else if (mode == 3) EpiKV{mss, outK, outV, KP, VT}(acc, u, wr, wc, fr, fq);
        else EpiRes{O, ssw}(acc, u, wr, wc, fr, fq);
    }
};

template <int AMODE, bool SSQ, int NSL, int MT> DI void sgemm_item(const float* A, int lda, const bf16_t* Bt, int ldb, int rowb, int ncol, int kbase, float* Out, int ldo, const float* ssq_in, float* ssq_out, int wave_, int lane) {
    const int r = lane & 15, q = lane >> 4;
    const int wave = (rowb >> 4) + (wave_ % MT), n0 = ncol + (wave_ / MT) * NSL * 16;
    const float* ap = A + (size_t)(16 * wave + r) * lda + kbase + 16 * q;
    const bf16_t* bp = Bt + (size_t)(n0 + r) * ldb + kbase + 16 * q;
    f32x4 av[4][4]; bf16x8 bv[NSL][4][2];
#pragma unroll
    for (int c = 0; c < 4; ++c)
#pragma unroll
        for (int i = 0; i < 4; ++i) av[c][i] = *(const f32x4*)(ap + 64 * c + 4 * i);
#pragma unroll
    for (int sl = 0; sl < NSL; ++sl)
#pragma unroll
        for (int c = 0; c < 4; ++c) { bv[sl][c][0] = *(const bf16x8*)(bp + (size_t)sl * 16 * ldb + 64 * c); bv[sl][c][1] = *(const bf16x8*)(bp + (size_t)sl * 16 * ldb + 64 * c + 8); }
    float rsA = 1.f; if (AMODE == 1) rsA = rsqrtf(ssq_in[16 * wave + r] * (1.0f / DM) + EPS);
    f32x4 acc[NSL]; float ssq = 0.f;
#pragma unroll
    for (int sl = 0; sl < NSL; ++sl) acc[sl] = (f32x4){0.f, 0.f, 0.f, 0.f};
#pragma unroll
    for (int c = 0; c < 4; ++c) {
        if (AMODE == 1) {
#pragma unroll
            for (int i = 0; i < 4; ++i)
#pragma unroll
                for (int j = 0; j < 4; ++j) { const float t = fmaxf(av[c][i][j] * rsA, 0.f); av[c][i][j] = t * t; }
        }
        if (SSQ) ssq += (hsq4(av[c][0]) + hsq4(av[c][1])) + (hsq4(av[c][2]) + hsq4(av[c][3]));
        u32x4 p0, p1; p0.x = pk2(av[c][0].x, av[c][0].y); p0.y = pk2(av[c][0].z, av[c][0].w); p0.z = pk2(av[c][1].x, av[c][1].y); p0.w = pk2(av[c][1].z, av[c][1].w);
        p1.x = pk2(av[c][2].x, av[c][2].y); p1.y = pk2(av[c][2].z, av[c][2].w); p1.z = pk2(av[c][3].x, av[c][3].y); p1.w = pk2(av[c][3].z, av[c][3].w);
#pragma unroll
        for (int sl = 0; sl < NSL; ++sl) {
            acc[sl] = __builtin_amdgcn_mfma_f32_16x16x32_bf16(__builtin_bit_cast(bf16x8, p0), bv[sl][c][0], acc[sl], 0, 0, 0);
            acc[sl] = __builtin_amdgcn_mfma_f32_16x16x32_bf16(__builtin_bit_cast(bf16x8, p1), bv[sl][c][1], acc[sl], 0, 0, 0);
        }
    }
    if (SSQ) { if (n0 == 0) { ssq += __shfl_xor(ssq, 16); ssq += __shfl_xor(ssq, 32); if (q == 0) unsafeAtomicAdd(ssq_out + 16 * wave + r, ssq); } }
#pragma unroll
    for (int sl = 0; sl < NSL; ++sl)
#pragma unroll
        for (int j = 0; j < 4; ++j) unsafeAtomicAdd(Out + (size_t)(16 * wave + 4 * q + j) * ldo + n0 + 16 * sl + r, acc[sl][j]);
}
template <int AMODE, bool SSQ, int NSL, int MT> DI void sgemm_phase(const float* A, int K, const bf16_t* Bt, int N, float* Out, const float* ssq_in, float* ssq_out, int bx, int G, int wave, int lane) {
    constexpr int W = 16 * NSL * (8 / MT), NRB = 8 / MT;
    const int ng = N / W, nit = NRB * ng * (K / 256);
    const int vcu = (G & 7) == 0 ? (bx & 7) * (G >> 3) + (bx >> 3) : bx;
    for (int it = vcu; it < nit; it += G) { const int rb = it % NRB, sg = (it / NRB) % ng, kp = it / (NRB * ng); sgemm_item<AMODE, SSQ, NSL, MT>(A, K, Bt, K, rb * 16 * MT, sg * W, kp * 256, Out, N, ssq_in, ssq_out, wave, lane); }
}
template <int AMODE, bool SSQ, int NSL, int MT> DI void sgemm_phase_p(const float* A, int K, const bf16_t* Bt, int N, float* Out, const float* ssq_in, float* ssq_out, unsigned char* ws, int bx, int G, int wave, int lane) {
    { PRO_T0(); sgemm_phase<AMODE, SSQ, NSL, MT>(A, K, Bt, N, Out, ssq_in, ssq_out, bx, G, wave, lane); if (MIXSPIN & 512) asm volatile("s_waitcnt vmcnt(0)" ::: "memory"); PRO_T1(512); }
    if (DUPMASK & 8) sgemm_phase<AMODE, SSQ, NSL, MT>(A, K, Bt, N, (float*)(ws + WS_END), ssq_in, (float*)(ws + WS_END) + 1024 * 1024, bx, G, wave, lane);
}

struct TrDesc { const float* W; const float* g; bf16_t* WT; int K, N, row_off, item; };
DI void tr_load(const TrDesc& d, f32x4 (&r)[8], float (&gv)[8], int lane) {
    const int nblk = d.N / 32, kb = d.item / nblk, nb = d.item % nblk, k0 = 64 * kb, n0 = 32 * nb;
    const float* p = d.W + (size_t)(k0 + (lane >> 3)) * d.N + n0 + 4 * (lane & 7);
#pragma unroll
    for (int i = 0; i < 8; ++i) { r[i] = __builtin_nontemporal_load((const f32x4*)(p + (size_t)i * 8 * d.N)); gv[i] = d.g ? d.g[k0 + (lane >> 3) + 8 * i] : 1.f; }
}
DI void tr_finish(const TrDesc& d, const f32x4 (&r)[8], const float (&gv)[8], LAS float* scr, int lane) {
    const int nblk = d.N / 32, kb = d.item / nblk, nb = d.item % nblk, k0 = 64 * kb, n0 = 32 * nb;
#pragma unroll
    for (int i = 0; i < 8; ++i) { LAS float* q = scr + ((lane >> 3) + 8 * i) * 33 + 4 * (lane & 7); const f32x4 v = r[i] * gv[i]; q[0] = v.x; q[1] = v.y; q[2] = v.z; q[3] = v.w; }
    asm volatile("s_waitcnt lgkmcnt(0)" ::: "memory");
    const int c = lane & 7;
#pragma unroll
    for (int j = 0; j < 4; ++j) { const int n = (lane >> 3) + 8 * j; const LAS float* s = scr + (8 * c) * 33 + n;
        u32x4 o; o.x = pk2(s[0 * 33], s[1 * 33]); o.y = pk2(s[2 * 33], s[3 * 33]); o.z = pk2(s[4 * 33], s[5 * 33]); o.w = pk2(s[6 * 33], s[7 * 33]);
        *(u32x4*)(d.WT + (size_t)(d.row_off + n0 + n) * d.K + k0 + 8 * c) = o; }
    asm volatile("s_waitcnt lgkmcnt(0)" ::: "memory");
}
DI float row_to_bf16(const float* xrow, bf16_t* orow, int lane) {
    const f32x4* xr = (const f32x4*)xrow + lane; float s = 0.f;
#pragma unroll
    for (int j = 0; j < 4; ++j) { const f32x4 v = __builtin_nontemporal_load(xr + 64 * j); s += hsq4(v); st_bf4(orow + 4 * lane + 256 * j, v); }
    return wave_sum(s);
}

struct Args { const float* in[N_IN]; float* out; unsigned char* ws; int ph_lo, ph_hi; };
typedef const __attribute__((address_space(4))) Args* AP;

DI void prologue(AP a, LAS unsigned char* lds, int wave, int lane_) {
    int lnp_ = lane_; asm volatile("" : "+v"(lnp_)); const int lane = lnp_;
    unsigned char* ws = a->ws;
    LAS float* scr = (LAS float*)(lds + wave * 16384);
    const int gw = blockIdx.x * NWAVES + wave, NGW = gridDim.x * NWAVES;
    constexpr int IT_IN = 16 * 64, IT_SQ = 16 * 32, IT_F1 = 16 * 128, IT_F2 = 64 * 32, IT_L = IT_IN + 5 * IT_SQ + IT_F1 + IT_F2;
    { PRO_T0();
    auto decode = [&](int it) -> TrDesc {
        const int l = it / IT_L; int r = it % IT_L;
        unsigned char* wl = ws + WS_W + (size_t)l * W_LSTRIDE; TrDesc d;
        if (r < IT_IN) { d = TrDesc{a->in[I_WIN] + (size_t)l * DM * DIN, a->in[I_NMIX] + l * DM, (bf16_t*)(wl + W_IN), DM, DIN, 0, r}; return d; } r -= IT_IN;
        if (r < IT_SQ) { d = TrDesc{a->in[I_WOUT] + (size_t)l * DM * DM, nullptr, (bf16_t*)(wl + W_OUT), DM, DM, 0, r}; return d; } r -= IT_SQ;
        if (r < IT_SQ) { d = TrDesc{a->in[I_WQ] + (size_t)l * DM * DM, a->in[I_NXA] + l * DM, (bf16_t*)(wl + W_Q), DM, DM, 0, r}; return d; } r -= IT_SQ;
        if (r < IT_SQ) { d = TrDesc{a->in[I_WK] + (size_t)l * DM * DM, a->in[I_NMEM] + l * DM, (bf16_t*)(ws + WS_WKV), DM, DM, l * 2048, r}; return d; } r -= IT_SQ;
        if (r < IT_SQ) { d = TrDesc{a->in[I_WV] + (size_t)l * DM * DM, a->in[I_NMEM] + l * DM, (bf16_t*)(ws + WS_WKV), DM, DM, l * 2048 + 1024, r}; return d; } r -= IT_SQ;
        if (r < IT_SQ) { d = TrDesc{a->in[I_WO] + (size_t)l * DM * DM, nullptr, (bf16_t*)(wl + W_O), DM, DM, 0, r}; return d; } r -= IT_SQ;
        if (r < IT_F1) { d = TrDesc{a->in[I_WF1] + (size_t)l * DM * DFF, a->in[I_NFF] + l * DM, (bf16_t*)(wl + W_F1), DM, DFF, 0, r}; return d; } r -= IT_F1;
        d = TrDesc{a->in[I_WF2] + (size_t)l * DFF * DM, nullptr, (bf16_t*)(wl + W_F2), DFF, DM, 0, r}; return d;
    };
    constexpr int NIT = NL * IT_L;
    int it = gw; TrDesc d0 = decode(min(it, NIT - 1)); f32x4 r0[8]; float g0[8]; tr_load(d0, r0, g0, lane);
    while (it < NIT) {
        const int itn = it + NGW; const TrDesc d1 = decode(min(itn, NIT - 1)); f32x4 r1[8]; float g1[8]; tr_load(d1, r1, g1, lane);
        tr_finish(d0, r0, g0, scr, lane);
        d0 = d1; it = itn;
#pragma unroll
        for (int i = 0; i < 8; ++i) { r0[i] = r1[i]; g0[i] = g1[i]; }
    }
    PRO_T1(16); }
    { PRO_T0();
        bf16_t* XB = (bf16_t*)(ws + WS_XB); float* SS = (float*)(ws + WS_SS);
        for (int m0 = gw; m0 < MP; m0 += 4 * NGW) {
            f32x4 v[4][4];
#pragma unroll
            for (int k = 0; k < 4; ++k) { const int m = min(m0 + k * NGW, MP - 1);
#pragma unroll
                for (int j = 0; j < 4; ++j) v[k][j] = __builtin_nontemporal_load((const f32x4*)(a->in[I_XP] + (size_t)m * DM) + lane + 64 * j); }
#pragma unroll
            for (int k = 0; k < 4; ++k) { const int m = m0 + k * NGW; if (m < MP) { float sq = 0.f;
#pragma unroll
                for (int j = 0; j < 4; ++j) { sq += hsq4(v[k][j]); st_bf4(XB + (size_t)m * DM + 4 * lane + 256 * j, v[k][j]); }
                sq = wave_sum(sq); if (lane < 16) SS[(size_t)m * 16 + lane] = lane == 0 ? sq : 0.f; } }
        }
        bf16_t* MB = (bf16_t*)(ws + WS_MEMB); float* MS = (float*)(ws + WS_MEMSS);
        for (int m = gw; m < MM; m += NGW) { const float s = row_to_bf16(a->in[I_MEM] + (size_t)m * DM, MB + (size_t)m * DM, lane); if (lane == 0) MS[m] = s; }
    PRO_T1(32); }
    { PRO_T0();
        const int gt = blockIdx.x * NTHR + wave * 64 + lane, NGT = gridDim.x * NTHR;
        for (int i = gt; i < NL * 4 * 128 * 128; i += NGT) { const int l = i >> 16, r = i & 65535, t = (r >> 7) & 127, s = r & 127;
            ((bf16_t*)(ws + WS_W + (size_t)l * W_LSTRIDE + W_GWS))[r] = (bf16_t)(pk2(s <= t ? a->in[I_GWS][i] : 0.f, 0.f) & 0xffffu); }
        for (int i = gt; i < NL * 4 * 64 * 64; i += NGT) { const int l = i >> 14, r = i & 16383, g = r >> 12, d = (r >> 6) & 63, c = r & 63;
            ((bf16_t*)(ws + WS_W + (size_t)l * W_LSTRIDE + W_PWT))[r] = (bf16_t)(pk2(a->in[I_PW][(size_t)l * 16384 + g * 4096 + c * 64 + d], 0.f) & 0xffffu); }
        for (int i = gt; i < NS * DM / 4; i += NGT) ((f32x4*)(ws + WS_XS))[i] = ((const f32x4*)a->in[I_XS])[i];
        for (int i = gt; i < (int)((WS_END - WS_ZS) / 16); i += NGT) ((f32x4*)(ws + WS_ZS))[i] = (f32x4){0.f, 0.f, 0.f, 0.f};
        for (int i = gt; i < NL * 3 * NS; i += NGT) ((float*)(ws + WS_SSQ))[i] = 0.f;
    PRO_T1(64); }
}

#ifndef MIXP
#define MIXP 15
#endif
#ifndef MIXSPIN
#define MIXSPIN 0
#endif
#define MIX_T0() const unsigned long long t_m0 = MIXSPIN ? __builtin_amdgcn_s_memrealtime() : 0ull
#define MIX_T1(bit) do { if (MIXSPIN & (bit)) { const unsigned long long t1_ = __builtin_amdgcn_s_memrealtime(), tg_ = t1_ + (t1_ - t_m0); while (__builtin_amdgcn_s_memrealtime() < tg_) __builtin_amdgcn_s_sleep(8); } } while (0)
constexpr int VNT_P = 136;
constexpr int TT_OFF = 69632, TT_P = 260;
constexpr int CW_OFF = 96256;
constexpr int PL_P = 264;

DI void tt_rows_out(LAS unsigned char* lds, bf16_t* Yrow0, const float* mog, int wave, int lane) {
    const LAS float* TT = (const LAS float*)(lds + TT_OFF);
    const f32x4 g = *(const f32x4*)(mog + 4 * lane);
#pragma unroll
    for (int i = 0; i < 8; ++i) {
        const int tt = 8 * wave + i;
        const f32x4 v = *(const LAS f32x4*)(TT + tt * TT_P + 4 * lane);
        const float r = rsqrtf(wave_sum(hsq4(v)) * (1.0f / DG) + EPS);
        st_bf4(Yrow0 + (size_t)tt * DM + 4 * lane, v * r * g);
    }
}

DI void mixer_unit(AP a, int l, int uidx, LAS unsigned char* lds, int wave, int lane) {
    unsigned char* ws = a->ws;
    const int b = uidx >> 5, ju = uidx & 31, t0 = ju * 64, off = t0 & 127, tc = t0 - off;
    const size_t R0 = (size_t)b * SEQ + t0;
    const bf16_t* Z = (const bf16_t*)(ws + WS_Z);
    bf16_t* Y = (bf16_t*)(ws + WS_Y);
    const float* mog = a->in[I_MOG] + l * DM;
    u32x2 gar[12], ggr[12];
    {
        int lq_ = lane; asm volatile("" : "+v"(lq_));
#pragma unroll
        for (int i = 0; i < 12; ++i) { const int rr = wave + 8 * i, t = t0 - 30 + rr; const int tcl = (rr < 94 && t >= 0) ? t : t0;
            const bf16_t* zr = Z + ((size_t)b * SEQ + tcl) * DIN; gar[i] = *(const u32x2*)(zr + 512 + 4 * lq_); ggr[i] = *(const u32x2*)(zr + 768 + 4 * lq_); }
    }
    { MIX_T0(); if (MIXP & 1) {
        int lq_ = lane; asm volatile("" : "+v"(lq_)); const int lane = lq_; const int fr = lane & 15, fq = lane >> 4; (void)fr; (void)fq;
        LAS bf16_t* VNT = (LAS bf16_t*)lds;
        const f32x4 lg = *(const f32x4*)(a->in[I_LNG] + l * DG + 4 * lane), lb = *(const f32x4*)(a->in[I_LNB] + l * DG + 4 * lane);
        const int nrow = off + 64;
        const bf16_t* Zv = Z + ((size_t)b * SEQ + tc + wave) * DIN + 256 + 4 * lane;
        u32x2 vr[16];
#pragma unroll
        for (int i = 0; i < 16; ++i) vr[i] = *(const u32x2*)(Zv + (size_t)(wave + 8 * i < nrow ? i : 0) * 8 * DIN);
        u32x2 ur[8];
#pragma unroll
        for (int i = 0; i < 8; ++i) ur[i] = *(const u32x2*)(Z + (R0 + 8 * wave + i) * DIN + 4 * lane);
        const int mt = wave & 3, hp = wave >> 2, tl0 = off + 16 * mt, nks = (tl0 + 16 + 31) >> 5;
        const bf16_t* GW = (const bf16_t*)(ws + WS_W + (size_t)l * W_LSTRIDE + W_GWS);
        bf16x8 af[2][4];
#pragma unroll
        for (int hh = 0; hh < 2; ++hh)
#pragma unroll
            for (int ks = 0; ks < 4; ++ks) af[hh][ks] = *(const bf16x8*)(GW + ((size_t)(2 * hp + hh) * 128 + tl0 + fr) * 128 + 32 * (ks < nks ? ks : 0) + 8 * fq);
        const int wsw = lane & 7;
#pragma unroll
        for (int i = 0; i < 16; ++i) if (wave + 8 * i < nrow) {
            const int s = wave + 8 * i;
            const f32x4 v = (f32x4){bflo(vr[i].x), bfhi(vr[i].x), bflo(vr[i].y), bfhi(vr[i].y)};
            const float mean = wave_sum(hsum4(v)) * (1.0f / DG); const f32x4 d = v - mean;
            const float rstd = rsqrtf(wave_sum(hsq4(d)) * (1.0f / DG) + EPS);
            const f32x4 vn = d * rstd * lg + lb;
            LAS bf16_t* wp = VNT + (4 * lane) * VNT_P + (((s >> 3) ^ wsw) << 3) + (s & 7);
#pragma unroll
            for (int k = 0; k < 4; ++k) wp[k * VNT_P] = (bf16_t)(pk2(vn[k], 0.f) & 0xffffu);
        }
        __syncthreads();
        LAS float* TT = (LAS float*)(lds + TT_OFF);
#pragma unroll
        for (int hh = 0; hh < 2; ++hh) {
            const int h = 2 * hp + hh;
            f32x4 acc[4];
#pragma unroll
            for (int dt = 0; dt < 4; ++dt) acc[dt] = (f32x4){0.f, 0.f, 0.f, 0.f};
#pragma unroll
            for (int ks = 0; ks < 4; ++ks) if (ks < nks) {
#pragma unroll
                for (int dt = 0; dt < 4; ++dt) {
                    const int d = h * 64 + dt * 16 + fr;
                    const bf16x8 bfr = *(const LAS bf16x8*)(VNT + d * VNT_P + (((4 * ks + fq) ^ ((d >> 2) & 7)) << 3));
                    acc[dt] = __builtin_amdgcn_mfma_f32_16x16x32_bf16(af[hh][ks], bfr, acc[dt], 0, 0, 0);
                }
            }
#pragma unroll
            for (int dt = 0; dt < 4; ++dt)
#pragma unroll
                for (int j = 0; j < 4; ++j) TT[(16 * mt + 4 * fq + j) * TT_P + h * 64 + dt * 16 + fr] = acc[dt][j];
        }
        __syncthreads();
        {
            const f32x4 g = *(const f32x4*)(mog + 4 * lane); const float* bsp = a->in[I_GBS] + (l * 4 + (lane >> 4)) * 128 + off + 8 * wave;
#pragma unroll
            for (int i = 0; i < 8; ++i) {
                const int tt = 8 * wave + i;
                const f32x4 gate = *(const LAS f32x4*)(TT + tt * TT_P + 4 * lane) + bsp[i];
                const f32x4 v = (f32x4){bflo(ur[i].x), bfhi(ur[i].x), bflo(ur[i].y), bfhi(ur[i].y)} * gate;
                const float r = rsqrtf(wave_sum(hsq4(v)) * (1.0f / DG) + EPS);
                st_bf4(Y + (R0 + tt) * DM + 4 * lane, v * r * g);
            }
        }
        __syncthreads();
    } MIX_T1(1); }
    { MIX_T0(); if (MIXP & 2) {
        int lq_ = lane; asm volatile("" : "+v"(lq_)); const int lane = lq_; const int fr = lane & 15, fq = lane >> 4; (void)fr; (void)fq;
        LAS float* G = (LAS float*)lds; LAS float* CW = (LAS float*)(lds + CW_OFF);
#pragma unroll
        for (int i = 0; i < 12; ++i) { const int rr = wave + 8 * i; if (rr < 94) {
            const int t = t0 - 30 + rr; f32x4 gl = {0.f, 0.f, 0.f, 0.f};
            if (t >= 0) { const f32x4 ga = (f32x4){bflo(gar[i].x), bfhi(gar[i].x), bflo(gar[i].y), bfhi(gar[i].y)}, gg = (f32x4){bflo(ggr[i].x), bfhi(ggr[i].x), bflo(ggr[i].y), bfhi(ggr[i].y)};
#pragma unroll
                for (int k = 0; k < 4; ++k) gl[k] = ga[k] * sigmoidf_(gg[k]); }
            *(LAS f32x4*)(G + rr * 256 + 4 * lane) = gl;
            if (ju == 31 && rr >= 64) *(f32x4*)(a->out + O_GLUP + ((size_t)(l * NB + b) * 30 + (rr - 64)) * DG + 4 * lane) = gl;
        } }
        for (int i = wave * 64 + lane; i < 31 * 64; i += NTHR) ((LAS f32x4*)CW)[i] = ((const f32x4*)(a->in[I_CDW] + (size_t)l * 31 * DG))[i];
        __syncthreads();
        f32x4 acc[8];
#pragma unroll
        for (int i = 0; i < 8; ++i) acc[i] = (f32x4){0.f, 0.f, 0.f, 0.f};
        f32x4 wj[8];
#pragma unroll
        for (int i = 0; i < 38; ++i) {
            const f32x4 g = *(const LAS f32x4*)(G + (8 * wave + i) * 256 + 4 * lane);
            if (i <= 30) wj[i & 7] = *(const LAS f32x4*)(CW + i * 256 + 4 * lane);
#pragma unroll
            for (int tt = 0; tt < 8; ++tt) { const int j = i - tt; if (j >= 0 && j <= 30) acc[tt] += wj[j & 7] * g; }
            if (i & 1) asm volatile("" ::: "memory");
        }
        const f32x4 cb = *(const f32x4*)(a->in[I_CDWB] + l * DG + 4 * lane), lg = *(const f32x4*)(a->in[I_CLNG] + l * DG + 4 * lane), lb = *(const f32x4*)(a->in[I_CLNB] + l * DG + 4 * lane);
        const f32x4 mg = *(const f32x4*)(mog + 1 * DG + 4 * lane);
#pragma unroll
        for (int tt = 0; tt < 8; ++tt) {
            const f32x4 x = acc[tt] + cb;
            const float mean = wave_sum(hsum4(x)) * (1.0f / DG); const f32x4 d = x - mean;
            const float rstd = rsqrtf(wave_sum(hsq4(d)) * (1.0f / DG) + EPS);
            f32x4 y = d * rstd * lg + lb;
#pragma unroll
            for (int i = 0; i < 4; ++i) y[i] = y[i] * sigmoidf_(y[i]);
            const float r = rsqrtf(wave_sum(hsq4(y)) * (1.0f / DG) + EPS);
            st_bf4(Y + (R0 + 8 * wave + tt) * DM + 1 * DG + 4 * lane, y * r * mg);
        }
        __syncthreads();
    } MIX_T1(2); }
    asm volatile("" ::: "memory");
    { MIX_T0(); if (MIXP & 4) {
        int lq_ = lane; asm volatile("" : "+v"(lq_)); const int lane = lq_; const int fr = lane & 15, fq = lane >> 4; (void)fr; (void)fq;
        const float* sw = a->in[I_SCDW] + (size_t)l * 3 * DG;
        const f32x4 w0 = *(const f32x4*)(sw + 4 * lane), w1 = *(const f32x4*)(sw + DG + 4 * lane), w2 = *(const f32x4*)(sw + 2 * DG + 4 * lane);
        const f32x4 mg = *(const f32x4*)(mog + 2 * DG + 4 * lane);
        f32x4 s[10];
#pragma unroll
        for (int i = 0; i < 10; ++i) {
            const int t = t0 + 8 * wave - 2 + i; s[i] = (f32x4){0.f, 0.f, 0.f, 0.f};
            if (t >= 0) { const bf16_t* zr = Z + ((size_t)b * SEQ + t) * DIN; s[i] = ld_bf4(zr + 1280 + 4 * lane) * ld_bf4(zr + 1536 + 4 * lane); }
        }
#pragma unroll
        for (int tt = 0; tt < 8; ++tt) {
            const int tl = 8 * wave + tt;
            const f32x4 sb = ld_bf4(Z + (R0 + tl) * DIN + 1024 + 4 * lane);
            const f32x4 y = sb * (w0 * s[tt] + w1 * s[tt + 1] + w2 * s[tt + 2]);
            const float r = rsqrtf(wave_sum(hsq4(y)) * (1.0f / DG) + EPS);
            st_bf4(Y + (R0 + tl) * DM + 2 * DG + 4 * lane, y * r * mg);
            if (ju == 31 && tl >= 62) *(f32x4*)(a->out + O_SHP + ((size_t)(l * NB + b) * 2 + (tl - 62)) * DG + 4 * lane) = s[tt + 2];
        }
    } MIX_T1(4); }
    asm volatile("s_waitcnt vmcnt(0)" ::: "memory");
    { MIX_T0(); if (MIXP & 8) {
        int lq_ = lane; asm volatile("" : "+v"(lq_)); const int lane = lq_; const int fr = lane & 15, fq = lane >> 4; (void)fr; (void)fq;
        LAS bf16_t* PL = (LAS bf16_t*)lds; LAS float* TT = (LAS float*)(lds + TT_OFF);
        const int g = lane >> 4, w = 2 << g;
        f32x4 px[23];
#pragma unroll
        for (int i = 0; i < 23; ++i) {
            const int t = t0 + 8 * wave - 15 + i; px[i] = (f32x4){0.f, 0.f, 0.f, 0.f};
            if (t >= 0) px[i] = ld_bf4(Z + ((size_t)b * SEQ + t) * DIN + 1792 + 4 * lane);
        }
#pragma unroll
        for (int tt = 0; tt < 8; ++tt) {
            const int tl = 8 * wave + tt, t = t0 + tl;
            f32x4 sum = {0.f, 0.f, 0.f, 0.f};
#pragma unroll
            for (int i = 0; i < 16; ++i) if (i < w) sum += px[15 + tt - i];
            const float icnt = __builtin_amdgcn_rcpf((float)min(w, t + 1));
            const f32x4 pooled = sum * icnt - px[15 + tt];
            u32x2 pw; pw.x = pk2(pooled.x, pooled.y); pw.y = pk2(pooled.z, pooled.w);
            *(LAS u32x2*)(PL + tl * PL_P + 4 * lane) = pw;
            if (ju == 31 && tl >= 49) *(f32x4*)(a->out + O_PLP + ((size_t)(l * NB + b) * 15 + (tl - 49)) * DG + 4 * lane) = px[15 + tt];
        }
        __syncthreads();
        const int mt = wave & 3, gp = wave >> 2;
        const bf16_t* PWT = (const bf16_t*)(ws + WS_W + (size_t)l * W_LSTRIDE + W_PWT);
#pragma unroll
        for (int gg = 0; gg < 2; ++gg) {
            const int gi = 2 * gp + gg;
#pragma unroll
            for (int nt = 0; nt < 4; ++nt) {
                f32x4 acc = {0.f, 0.f, 0.f, 0.f};
#pragma unroll
                for (int ks = 0; ks < 2; ++ks) {
                    const bf16x8 af = *(const LAS bf16x8*)(PL + (16 * mt + fr) * PL_P + gi * 64 + 32 * ks + 8 * fq);
                    const bf16x8 bfr = *(const bf16x8*)(PWT + ((size_t)gi * 64 + 16 * nt + fr) * 64 + 32 * ks + 8 * fq);
                    acc = __builtin_amdgcn_mfma_f32_16x16x32_bf16(af, bfr, acc, 0, 0, 0);
                }
                const int d = gi * 64 + 16 * nt + fr; const float sc = a->in[I_PSC][l * DG + d];
#pragma unroll
                for (int j = 0; j < 4; ++j) TT[(16 * mt + 4 * fq + j) * TT_P + d] = acc[j] * sc;
            }
        }
        __syncthreads();
        tt_rows_out(lds, Y + R0 * DM + 3 * DG, mog + 3 * DG, wave, lane);
        __syncthreads();
    } MIX_T1(8); }
}

DI void mixer_sample(AP a, int l, int bs, int part, LAS unsigned char* lds, int wave, int lane) {
    unsigned char* ws = a->ws;
    const float* z = (const float*)(ws + WS_ZS) + ((size_t)l * NS + bs) * DIN;
    const float zrs = rsqrtf(((const float*)(ws + WS_SSQ))[(l * 3 + 0) * NS + bs] * (1.0f / DM) + EPS);
    float* ys = (float*)(ws + WS_YS) + (size_t)bs * DM;
    const float* mog = a->in[I_MOG] + l * DM;
    const int c4 = 4 * lane;
    if (part == 0) {
        const f32x4 u = *(const f32x4*)(z + c4) * zrs, v = *(const f32x4*)(z + 256 + c4) * zrs;
        const f32x4 lg = *(const f32x4*)(a->in[I_LNG] + l * DG + c4), lb = *(const f32x4*)(a->in[I_LNB] + l * DG + c4);
        const float mean = wave_sum(hsum4(v)) * (1.0f / DG); const f32x4 d = v - mean;
        const float rstd = rsqrtf(wave_sum(hsq4(d)) * (1.0f / DG) + EPS);
        const f32x4 vn = d * rstd * lg + lb;
        *(f32x4*)(a->out + O_GV + ((size_t)l * NS + bs) * DG + c4) = vn;
        const int h = lane >> 4;
        const float w00 = a->in[I_GWS][((size_t)(l * 4 + h) * 128) * 128], b0 = a->in[I_GBS][(l * 4 + h) * 128];
        const f32x4 y = u * (vn * w00 + b0);
        const float r = rsqrtf(wave_sum(hsq4(y)) * (1.0f / DG) + EPS);
        *(f32x4*)(ys + c4) = y * r * *(const f32x4*)(mog + c4);
    }
    else if (part == 1) {
        const f32x4 ga = *(const f32x4*)(z + 512 + c4) * zrs, gg = *(const f32x4*)(z + 768 + c4) * zrs;
        f32x4 glu;
#pragma unroll
        for (int i = 0; i < 4; ++i) glu[i] = ga[i] * sigmoidf_(gg[i]);
        const float* st = a->in[I_SGLU] + ((size_t)(l * NS + bs) * 30) * DG + c4;
        float* so = a->out + O_GLUS + ((size_t)(l * NS + bs) * 30) * DG + c4;
        const float* cw = a->in[I_CDW] + (size_t)l * 31 * DG + c4;
        f32x4 acc = *(const f32x4*)(cw + 30 * DG) * glu;
#pragma unroll 10
        for (int j = 0; j < 30; ++j) { const f32x4 sv = *(const f32x4*)(st + j * DG); acc += *(const f32x4*)(cw + j * DG) * sv; if (j >= 1) *(f32x4*)(so + (j - 1) * DG) = sv; }
        *(f32x4*)(so + 29 * DG) = glu;
        const f32x4 x = acc + *(const f32x4*)(a->in[I_CDWB] + l * DG + c4);
        const float mean = wave_sum(hsum4(x)) * (1.0f / DG); const f32x4 d = x - mean;
        const float rstd = rsqrtf(wave_sum(hsq4(d)) * (1.0f / DG) + EPS);
        f32x4 y = d * rstd * *(const f32x4*)(a->in[I_CLNG] + l * DG + c4) + *(const f32x4*)(a->in[I_CLNB] + l * DG + c4);
#pragma unroll
        for (int i = 0; i < 4; ++i) y[i] = y[i] * sigmoidf_(y[i]);
        const float r = rsqrtf(wave_sum(hsq4(y)) * (1.0f / DG) + EPS);
        *(f32x4*)(ys + DG + c4) = y * r * *(const f32x4*)(mog + DG + c4);
    }
    else if (part == 2) {
        const f32x4 sb = *(const f32x4*)(z + 1024 + c4) * zrs, s = (*(const f32x4*)(z + 1280 + c4) * zrs) * (*(const f32x4*)(z + 1536 + c4) * zrs);
        const float* st = a->in[I_SSH] + ((size_t)(l * NS + bs) * 2) * DG + c4;
        float* so = a->out + O_SHS + ((size_t)(l * NS + bs) * 2) * DG + c4;
        const float* sw = a->in[I_SCDW] + (size_t)l * 3 * DG + c4;
        const f32x4 s0 = *(const f32x4*)st, s1 = *(const f32x4*)(st + DG);
        const f32x4 y = sb * (*(const f32x4*)sw * s0 + *(const f32x4*)(sw + DG) * s1 + *(const f32x4*)(sw + 2 * DG) * s);
        *(f32x4*)so = s1; *(f32x4*)(so + DG) = s;
        const float r = rsqrtf(wave_sum(hsq4(y)) * (1.0f / DG) + EPS);
        *(f32x4*)(ys + 2 * DG + c4) = y * r * *(const f32x4*)(mog + 2 * DG + c4);
    }
    else {
        const f32x4 px = *(const f32x4*)(z + 1792 + c4) * zrs;
        const float* st = a->in[I_SPL] + ((size_t)(l * NS + bs) * 15) * DG + c4;
        float* so = a->out + O_PLS + ((size_t)(l * NS + bs) * 15) * DG + c4;
        const int g = lane >> 4, w = 2 << g;
        f32x4 sum = px;
#pragma unroll
        for (int j = 0; j < 15; ++j) { const f32x4 sv = *(const f32x4*)(st + j * DG); if (15 - j < w) sum += sv; if (j >= 1) *(f32x4*)(so + (j - 1) * DG) = sv; }
        *(f32x4*)(so + 14 * DG) = px;
        const f32x4 pooled = sum / (float)w - px;
        LAS float* PLs = (LAS float*)(lds + wave * 1024);
        *(LAS f32x4*)(PLs + c4) = pooled;
        asm volatile("s_waitcnt lgkmcnt(0)" ::: "memory");
        const float* pw = a->in[I_PW] + (size_t)l * 16384 + (size_t)g * 4096 + 4 * (lane & 15);
        f32x4 acc = {0.f, 0.f, 0.f, 0.f};
#pragma unroll 16
        for (int c = 0; c < 64; ++c) acc += *(const f32x4*)(pw + c * 64) * PLs[g * 64 + c];
        const f32x4 y = acc * *(const f32x4*)(a->in[I_PSC] + l * DG + c4);
        const float r = rsqrtf(wave_sum(hsq4(y)) * (1.0f / DG) + EPS);
        *(f32x4*)(ys + 3 * DG + c4) = y * r * *(const f32x4*)(mog + 3 * DG + c4);
        asm volatile("s_waitcnt lgkmcnt(0)" ::: "memory");
    }
}

constexpr int KVP = 264;
DI void attn_unit(AP a, int l, int uidx, LAS unsigned char* lds, int wave, int lane) {
    unsigned char* ws = a->ws;
    const int b = uidx >> 5, h = (uidx >> 3) & 3, qt = uidx & 7;
    const int r32 = lane & 31, hi = lane >> 5, tid = wave * 64 + lane;
    LAS bf16_t* KV = (LAS bf16_t*)lds;
    const size_t q0 = (size_t)b * SEQ + qt * 256 + 32 * wave;
    const bf16_t* Qp = (const bf16_t*)(ws + WS_Q) + (q0 + r32) * DM + h * 256 + 8 * hi;
    const bf16_t* Kg = (const bf16_t*)(ws + WS_KP) + ((size_t)l * MM + b * 256) * DM + h * 256;
    const bf16_t* Vg = (const bf16_t*)(ws + WS_VT) + ((size_t)((l * NB + b) * 4 + h) * 256) * 256;
    const bf16_t* kgl = Kg + (size_t)(tid >> 5) * DM + (tid & 31) * 8; const bf16_t* vgl = Vg + (size_t)(tid >> 5) * 256 + (tid & 31) * 8;
    LAS bf16_t* kvl = KV + (tid >> 5) * KVP + (tid & 31) * 8;
    bf16x8 qf[16];
#pragma unroll
    for (int ks = 0; ks < 16; ++ks) qf[ks] = __builtin_nontemporal_load((const bf16x8*)(Qp + 16 * ks));
    u32x4 st[16];
#pragma unroll
    for (int i = 0; i < 16; ++i) st[i] = *(const u32x4*)(kgl + i * 16 * DM);
#pragma unroll
    for (int i = 0; i < 16; ++i) *(LAS u32x4*)(kvl + i * 16 * KVP) = st[i];
    __syncthreads();
    f32x16 S[8];
    __builtin_amdgcn_s_setprio(1);
#pragma unroll
    for (int kt = 0; kt < 8; ++kt) {
#pragma unroll
        for (int i = 0; i < 16; ++i) S[kt][i] = 0.f;
#pragma unroll
        for (int ks = 0; ks < 16; ++ks) {
            const bf16x8 kf = *(const LAS bf16x8*)(KV + (kt * 32 + r32) * KVP + 16 * ks + 8 * hi);
            S[kt] = __builtin_amdgcn_mfma_f32_32x32x16_bf16(kf, qf[ks], S[kt], 0, 0, 0);
        }
    }
    __builtin_amdgcn_s_setprio(0);
    asm volatile("" ::: "memory");
#pragma unroll
    for (int i = 0; i < 8; ++i) st[i] = *(const u32x4*)(vgl + i * 16 * 256);
    float mx = -3.0e38f;
#pragma unroll
    for (int kt = 0; kt < 8; ++kt)
#pragma unroll
        for (int i = 0; i < 16; ++i) mx = fmaxf(mx, S[kt][i]);
    mx = fmaxf(mx, __shfl_xor(mx, 32));
    float sum = 0.f; const float mxl = mx * 1.4426950408889634f;
    bf16x8 pf[16];
#pragma unroll
    for (int kt = 0; kt < 8; ++kt) {
#pragma unroll
        for (int i = 0; i < 16; ++i) { const float p = __builtin_amdgcn_exp2f(S[kt][i] * 1.4426950408889634f - mxl); S[kt][i] = p; sum += p; }
#pragma unroll
        for (int c = 0; c < 2; ++c) {
            u32x4 p; p.x = pk2(S[kt][8 * c + 0], S[kt][8 * c + 1]); p.y = pk2(S[kt][8 * c + 2], S[kt][8 * c + 3]); p.z = pk2(S[kt][8 * c + 4], S[kt][8 * c + 5]); p.w = pk2(S[kt][8 * c + 6], S[kt][8 * c + 7]);
            pf[2 * kt + c] = __builtin_bit_cast(bf16x8, p);
        }
    }
    sum += __shfl_xor(sum, 32);
    const float inv = 1.0f / sum;
    __syncthreads();
#pragma unroll
    for (int i = 0; i < 8; ++i) *(LAS u32x4*)(kvl + i * 16 * KVP) = st[i];
    asm volatile("" ::: "memory");
#pragma unroll
    for (int i = 0; i < 8; ++i) st[i] = *(const u32x4*)(vgl + (i + 8) * 16 * 256);
    __syncthreads();
    bf16_t* Op = (bf16_t*)(ws + WS_O) + (q0 + r32) * DM + h * 256 + 4 * hi;
#pragma unroll
    for (int dt = 0; dt < 8; ++dt) {
        if (dt == 4) {
#pragma unroll
            for (int i = 0; i < 8; ++i) *(LAS u32x4*)(kvl + (i + 8) * 16 * KVP) = st[i];
            __syncthreads();
        }
        f32x16 o;
#pragma unroll
        for (int i = 0; i < 16; ++i) o[i] = 0.f;
#pragma unroll
        for (int kc = 0; kc < 16; ++kc) {
            const LAS bf16_t* vp = KV + (dt * 32 + r32) * KVP + 16 * kc + 4 * hi;
            const u32x2 v0 = *(const LAS u32x2*)vp, v1 = *(const LAS u32x2*)(vp + 8);
            u32x4 vv; vv.x = v0.x; vv.y = v0.y; vv.z = v1.x; vv.w = v1.y;
            o = __builtin_amdgcn_mfma_f32_32x32x16_bf16(__builtin_bit_cast(bf16x8, vv), pf[kc], o, 0, 0, 0);
        }
#pragma unroll
        for (int rg = 0; rg < 4; ++rg) {
            u32x2 w; w.x = pk2(o[4 * rg] * inv, o[4 * rg + 1] * inv); w.y = pk2(o[4 * rg + 2] * inv, o[4 * rg + 3] * inv);
            ST8(Op + 32 * dt + 8 * rg, w);
        }
    }
    __syncthreads();
}

DI void attn_sample_unit(AP a, int l, int uidx, LAS unsigned char* lds, int wave, int lane) {
    unsigned char* ws = a->ws;
    const int bs = uidx >> 1, hp = uidx & 1, hh = lane >> 5;
    LAS float* ML = (LAS float*)lds;
    LAS float* RED = (LAS float*)(lds + 4096);
    const float* qp = (const float*)(ws + WS_QS) + ((size_t)l * NS + bs) * DM + hp * 512 + 8 * lane;
    const float qrs = 0.0625f * rsqrtf(((const float*)(ws + WS_SSQ))[(l * 3 + 1) * NS + bs] * (1.0f / DM) + EPS);
    const f32x4 q0 = *(const f32x4*)qp * qrs, q1 = *(const f32x4*)(qp + 4) * qrs;
    const float* Kb = a->in[I_CK] + ((size_t)(l * NS + bs) * MEM + 32 * wave) * DM + hp * 512 + 8 * lane;
    const float* Vb = a->in[I_CV] + ((size_t)(l * NS + bs) * MEM + 32 * wave) * DM + hp * 512 + 8 * lane;
    float mrun = -3.0e38f, lrun = 0.f; f32x4 o0 = {0.f, 0.f, 0.f, 0.f}, o1 = {0.f, 0.f, 0.f, 0.f};
    f32x4 k0[4], k1[4], v0[4], v1[4];
#pragma unroll
    for (int r = 0; r < 4; ++r) { const size_t ro = (size_t)r * DM; k0[r] = __builtin_nontemporal_load((const f32x4*)(Kb + ro)); k1[r] = __builtin_nontemporal_load((const f32x4*)(Kb + ro + 4)); v0[r] = __builtin_nontemporal_load((const f32x4*)(Vb + ro)); v1[r] = __builtin_nontemporal_load((const f32x4*)(Vb + ro + 4)); }
#pragma unroll 1
    for (int bt = 0; bt < 8; ++bt) {
        const float* Kn = Kb + (size_t)(bt < 7 ? 4 * (bt + 1) : 0) * DM; const float* Vn = Vb + (size_t)(bt < 7 ? 4 * (bt + 1) : 0) * DM;
        f32x4 nk0[4], nk1[4], nv0[4], nv1[4]; float sc[4];
#pragma unroll
        for (int r = 0; r < 4; ++r) { const size_t ro = (size_t)r * DM; nk0[r] = __builtin_nontemporal_load((const f32x4*)(Kn + ro)); nk1[r] = __builtin_nontemporal_load((const f32x4*)(Kn + ro + 4)); nv0[r] = __builtin_nontemporal_load((const f32x4*)(Vn + ro)); nv1[r] = __builtin_nontemporal_load((const f32x4*)(Vn + ro + 4)); }
        float bm = -3.0e38f;
#pragma unroll
        for (int r = 0; r < 4; ++r) {
            float d = hsum4(k0[r] * q0) + hsum4(k1[r] * q1);
            d = half_sum32(d, lane);
            sc[r] = d; bm = fmaxf(bm, d);
        }
        const float mnew = fmaxf(mrun, bm), resc = __expf(mrun - mnew);
        lrun *= resc; o0 = o0 * resc; o1 = o1 * resc; mrun = mnew;
#pragma unroll
        for (int r = 0; r < 4; ++r) { const float p = __expf(sc[r] - mnew); lrun += p; o0 += v0[r] * p; o1 += v1[r] * p; }
#pragma unroll
        for (int r = 0; r < 4; ++r) { k0[r] = nk0[r]; k1[r] = nk1[r]; v0[r] = nv0[r]; v1[r] = nv1[r]; }
    }
    if ((lane & 31) == 0) { ML[(wave * 2 + hh) * 2] = mrun; ML[(wave * 2 + hh) * 2 + 1] = lrun; }
    *(LAS f32x4*)(RED + wave * 512 + 8 * lane) = o0; *(LAS f32x4*)(RED + wave * 512 + 8 * lane + 4) = o1;
    __syncthreads();
    {
        const int t = wave * 64 + lane, h2 = t >> 8; float mx = -3.0e38f;
#pragma unroll
        for (int w = 0; w < 8; ++w) mx = fmaxf(mx, ML[(w * 2 + h2) * 2]);
        float num = 0.f, den = 0.f;
#pragma unroll
        for (int w = 0; w < 8; ++w) { const float e = __expf(ML[(w * 2 + h2) * 2] - mx); num += e * RED[w * 512 + t]; den += e * ML[(w * 2 + h2) * 2 + 1]; }
        ((float*)(ws + WS_OS))[(size_t)bs * DM + hp * 512 + t] = num / den;
    }
    __syncthreads();
}

#define XB_TMO      128
#define XB_XCNT(j)  (256  + 64 * (j))
#define XB_XSUB(j)  (1280 + 64 * (j))
#define XB_XGEN(j)  (2304 + 64 * (j))
#define XB_TOP      3328
#define XB_TOPGEN   3392
#define XCD_BAR_WORDS 3456
#define XB_SPIN_CAP (1u << 18)
DI unsigned xb_ld(unsigned* p)              { return __hip_atomic_load(p, __ATOMIC_RELAXED, __HIP_MEMORY_SCOPE_AGENT); }
DI unsigned xb_add(unsigned* p, unsigned v) { return __hip_atomic_fetch_add(p, v, __ATOMIC_RELAXED, __HIP_MEMORY_SCOPE_AGENT); }
DI unsigned xb_xcc_id() { return (unsigned)__builtin_amdgcn_s_getreg((3 << 11) | 20) & 0xFu; }
#define XB_SPIN(cond, bar) do { unsigned _sp = 0; while (cond) { __builtin_amdgcn_s_sleep(1); \
    if ((++_sp & 255u) == 0u) { if (xb_ld(&(bar)[XB_TMO])) break; if (_sp > XB_SPIN_CAP) { atomicAdd(&(bar)[XB_TMO], 1u); break; } } } } while (0)
struct XcdBarrier { unsigned* bar; unsigned x; volatile LAS unsigned* st; };
DI XcdBarrier xcd_barrier_post(unsigned* bar, volatile LAS unsigned* st) {
    XcdBarrier b; b.bar = bar; b.x = xb_xcc_id(); b.st = st;
    if (threadIdx.x == 0) (void)xb_add(&bar[XB_XCNT(b.x)], 1u);
    return b;
}
DI void xcd_barrier_complete(unsigned* bar, unsigned x, unsigned& nloc, unsigned& nx) {
    const unsigned G = gridDim.x * gridDim.y * gridDim.z;
    unsigned sum, cnt, mine, sp = 0u;
    for (;;) {
        sum = 0u; cnt = 0u; mine = 0u;
#pragma unroll
        for (unsigned j = 0; j < 16; ++j) { const unsigned c = xb_ld(&bar[XB_XCNT(j)]); sum += c; cnt += (c > 0u) ? 1u : 0u; mine = (j == x) ? c : mine; }
        if (sum == G) break;
        __builtin_amdgcn_s_sleep(1);
        if ((++sp & 255u) == 0u) { if (xb_ld(&bar[XB_TMO])) break; if (sp > XB_SPIN_CAP) { atomicAdd(&bar[XB_TMO], 1u); break; } }
    }
    nloc = mine > 0u ? mine : 1u; nx = cnt > 0u ? cnt : 1u;
}
DI void xcd_barrier(const XcdBarrier& b) {
    asm volatile("s_waitcnt vmcnt(0)" ::: "memory");
    __syncthreads();
    if (threadIdx.x == 0) {
        unsigned* bar = b.bar;
        __builtin_amdgcn_s_waitcnt(0);
        unsigned nloc = b.st[0], nx = b.st[1];
        if (nloc == 0u) { xcd_barrier_complete(bar, b.x, nloc, nx); b.st[0] = nloc; b.st[1] = nx; }
        const unsigned old = xb_add(&bar[XB_XSUB(b.x)], 1u);
        const unsigned gen = old / nloc;
        if (old + 1u == (gen + 1u) * nloc) {
            __builtin_amdgcn_fence(__ATOMIC_RELEASE, "agent");
            asm volatile("s_waitcnt vmcnt(0)" ::: "memory");
            const unsigned og = xb_add(&bar[XB_TOP], 1u);
            const unsigned tg = og / nx;
            if (og + 1u == (tg + 1u) * nx) xb_add(&bar[XB_TOPGEN], 1u);
            else XB_SPIN(xb_ld(&bar[XB_TOPGEN]) == tg, bar);
            __builtin_amdgcn_fence(__ATOMIC_ACQUIRE, "agent");
            xb_add(&bar[XB_XGEN(b.x)], 1u);
            asm volatile("s_waitcnt vmcnt(0)" ::: "memory");
        } else {
            XB_SPIN(xb_ld(&bar[XB_XGEN(b.x)]) == gen, bar);
            __builtin_amdgcn_fence(__ATOMIC_ACQUIRE, "agent");
            asm volatile("s_waitcnt vmcnt(0)" ::: "memory");
        }
    }
    __syncthreads();
}

template <int NLD> DI unsigned l2_touch(const bf16_t* panel, int share, int tid) {
    const char* p = (const char*)panel + ((size_t)share * NLD * NTHR + tid) * 128;
    unsigned v[NLD];
#pragma unroll
    for (int i = 0; i < NLD; ++i) v[i] = *(const unsigned*)(p + (size_t)i * NTHR * 128);
    unsigned acc = 0u;
#pragma unroll
    for (int i = 0; i < NLD; ++i) acc |= v[i];
    return acc;
}
template <int NR> DI void gemm_touch(const pg8::Gemm& g, const pg8::StaticOrder& S, int tid) {
    pg8::Unit u;
    if (!S.next(0, u)) return;
    unsigned acc = l2_touch<2>(g.A + (size_t)u.pm * 256 * g.K, u.pn & 3, tid);
#pragma unroll
    for (int i = 0; i < NR; ++i) { pg8::Unit w = u; S.next(i, w); acc |= l2_touch<1>(g.Bt + (size_t)w.pn * 256 * g.K, w.pm & 7, tid); }
    asm volatile("" :: "v"(acc));
}

#ifndef PMASK
#define PMASK 0xffff
#endif
#ifndef DUPMASK
#define DUPMASK 0
#endif
#ifndef TOUCH
#define TOUCH 0
#endif
#ifndef SPINSET
#define SPINSET 0
#endif
constexpr int N_PHASES = 18;
__global__ void __launch_bounds__(NTHR, 2) fwd_kernel(Args a_) {
    extern __shared__ __attribute__((aligned(16))) unsigned char lds_raw[];
    LAS unsigned char* lds = (LAS unsigned char*)lds_raw;
    cg::grid_group grid = cg::this_grid();
    volatile LAS unsigned* MISC = (volatile LAS unsigned*)(lds + LDS_BYTES - 256);
    if (threadIdx.x < 32) MISC[threadIdx.x] = 0u;
    __syncthreads();
    const XcdBarrier xbar = xcd_barrier_post((unsigned*)(a_.ws + WS_CTL), MISC + 8);
    const int ph_lo = a_.ph_lo, ph_hi = a_.ph_hi;
    for (int ph = ph_lo; ph < ph_hi; ++ph) {
        AP a = (AP)__builtin_amdgcn_kernarg_segment_ptr();
        asm volatile("" : "+s"(a));
        int tid = threadIdx.x; asm volatile("" : "+v"(tid));
        const int lane = tid & 63, wave = __builtin_amdgcn_readfirstlane(tid >> 6);
        int bx = blockIdx.x; asm volatile("" : "+s"(bx));
        const int G = gridDim.x;
        const unsigned long long t_ph0 = SPINSET ? __builtin_amdgcn_s_memrealtime() : 0ull;
        unsigned char* ws = a->ws;
        bf16_t* XB = (bf16_t*)(ws + WS_XB); float* SS = (float*)(ws + WS_SS); float* XF = a->out + O_YP;
        float* XS = (float*)(ws + WS_XS); float* YS = (float*)(ws + WS_YS); float* OS = (float*)(ws + WS_OS);
        if (ph == 0) {
            for (int rep = 0; rep < ((DUPMASK & 64) ? 2 : 1); ++rep) prologue(a, lds, wave, lane);
        } else if (ph == N_PHASES - 1) { if (PMASK & 2) {
            int lnf_ = lane; asm volatile("" : "+v"(lnf_)); const int lane = lnf_;
            const int gw = bx * NWAVES + wave, NGW = G * NWAVES;
            const float* gf = a->in[I_NFIN];
            for (int m0 = gw; m0 < MP; m0 += 4 * NGW) {
                u32x2 xv[4][4]; float rs[4];
#pragma unroll
                for (int k = 0; k < 4; ++k) { const int m = min(m0 + k * NGW, MP - 1); rs[k] = row_rs(SS + (size_t)m * 16);
#pragma unroll
                    for (int j = 0; j < 4; ++j) xv[k][j] = __builtin_nontemporal_load((const u32x2*)(XB + (size_t)m * DM + 4 * lane + 256 * j)); }
#pragma unroll
                for (int k = 0; k < 4; ++k) { const int m = m0 + k * NGW; if (m < MP) { f32x4* yr = (f32x4*)(XF + (size_t)m * DM) + lane;
#pragma unroll
                    for (int j = 0; j < 4; ++j) __builtin_nontemporal_store((f32x4){bflo(xv[k][j].x), bfhi(xv[k][j].x), bflo(xv[k][j].y), bfhi(xv[k][j].y)} * rs[k] * ((const f32x4*)gf)[lane + 64 * j], yr + 64 * j); } }
            }
            for (int m = MP + gw; m < MP + NS; m += NGW) {
                if (m < MP) {
                } else {
                    const int s = m - MP; const f32x4* xr = (const f32x4*)(XS + (size_t)s * DM) + lane; f32x4 v[4]; float sq = 0.f;
#pragma unroll
                    for (int j = 0; j < 4; ++j) { v[j] = xr[64 * j]; sq += hsq4(v[j]); }
                    const float rs = rsqrtf(wave_sum(sq) * (1.0f / DM) + EPS);
                    f32x4* yo = (f32x4*)(a->out + O_YS + (size_t)s * DM) + lane;
#pragma unroll
                    for (int j = 0; j < 4; ++j) yo[64 * j] = v[j] * rs * ((const f32x4*)gf)[lane + 64 * j];
                }
            }
        } } else {
            const int l = (ph - 1) >> 3, sub = (ph - 1) & 7;
            unsigned char* wl = ws + WS_W + (size_t)l * W_LSTRIDE;
            float* SSQ = (float*)(ws + WS_SSQ);
            if (sub == 1) {
                { const int gwr = (G - 1 - bx) * NWAVES + wave; if (gwr < 4 * NS) mixer_sample(a, l, gwr >> 2, gwr & 3, lds, wave, lane); }
                __syncthreads();
                { const int vcu = (G & 7) == 0 ? (bx & 7) * (G >> 3) + (bx >> 3) : bx; for (int u = vcu; u < 256; u += G) mixer_unit(a, l, u, lds, wave, lane); }
            } else if (sub == 4) {
                for (int u = bx; u < 256; u += G) attn_sample_unit(a, l, u, lds, wave, lane);
                { const int vcu = (G & 7) == 0 ? (bx & 7) * (G >> 3) + (bx >> 3) : bx; for (int u = vcu; u < 256; u += G) attn_unit(a, l, u, lds, wave, lane); }
            } else {
                if (sub == 0) sgemm_phase_p<0, true, 2, 2>(XS, DM, (const bf16_t*)(wl + W_IN), DIN, (float*)(ws + WS_ZS) + (size_t)l * NS * DIN, nullptr, SSQ + (l * 3 + 0) * NS, ws, bx, G, wave, lane);
                else if (sub == 2) sgemm_phase_p<0, false, 1, 2>(YS, DM, (const bf16_t*)(wl + W_OUT), DM, XS, nullptr, nullptr, ws, bx, G, wave, lane);
                else if (sub == 3) sgemm_phase_p<0, true, 1, 2>(XS, DM, (const bf16_t*)(wl + W_Q), DM, (float*)(ws + WS_QS) + (size_t)l * NS * DM, nullptr, SSQ + (l * 3 + 1) * NS, ws, bx, G, wave, lane);
                else if (sub == 5) sgemm_phase_p<0, false, 1, 2>(OS, DM, (const bf16_t*)(wl + W_O), DM, XS, nullptr, nullptr, ws, bx, G, wave, lane);
                else if (sub == 6) sgemm_phase_p<0, true, 4, 4>(XS, DM, (const bf16_t*)(wl + W_F1), DFF, (float*)(ws + WS_HS) + (size_t)l * NS * DFF, nullptr, SSQ + (l * 3 + 2) * NS, ws, bx, G, wave, lane);
                else sgemm_phase_p<1, false, 2, 4>((const float*)(ws + WS_HS) + (size_t)l * NS * DFF, DFF, (const bf16_t*)(wl + W_F2), DM, XS, SSQ + (l * 3 + 2) * NS, nullptr, ws, bx, G, wave, lane);
                const int ngemm = (sub == 0 && l == 0) ? 2 : 1;
                for (int gi = 0; gi < ngemm; ++gi) {
                    pg8::Gemm g; EpiAny E{};
                    if (gi == 1) { g = pg8::Gemm{(const bf16_t*)(ws + WS_MEMB), (const bf16_t*)(ws + WS_WKV), MM, 4096, DM};
                        E.mode = 3; E.mss = (const float*)(ws + WS_MEMSS); E.outK = a->out + O_MK; E.outV = a->out + O_MV; E.KP = (bf16_t*)(ws + WS_KP); E.VT = (bf16_t*)(ws + WS_VT); }
                    else if (sub == 0) { g = pg8::Gemm{XB, (const bf16_t*)(wl + W_IN), MP, DIN, DM}; E.mode = 0; E.O = (bf16_t*)(ws + WS_Z); E.ldc = DIN; E.ss = SS; }
                    else if (sub == 3) { g = pg8::Gemm{XB, (const bf16_t*)(wl + W_Q), MP, DM, DM}; E.mode = 1; E.O = (bf16_t*)(ws + WS_Q); E.ldc = DM; E.ss = SS; }
                    else if (sub == 6) { g = pg8::Gemm{XB, (const bf16_t*)(wl + W_F1), MP, DFF, DM}; E.mode = 2; E.O = (bf16_t*)(ws + WS_H); E.ldc = DFF; E.ss = SS; }
                    else { g = pg8::Gemm{(const bf16_t*)(ws + (sub == 2 ? WS_Y : sub == 5 ? WS_O : WS_H)), (const bf16_t*)(wl + (sub == 2 ? W_OUT : sub == 5 ? W_O : W_F2)), MP, DM, sub == 7 ? DFF : DM};
                        E.mode = 4; E.O = XB; E.ssw = SS; }
                    pg8::StaticOrder S; S.init(g.M, g.N, G, bx);
                    pg8::gemm_phase<EpiAny, pg8::StaticOrder, true, true>(lds, g, S, E);
                }
            }
        }
        if (ph + 1 < ph_hi) { if (ph >= N_PHASES) grid.sync();   else { PRO_T0(); xcd_barrier(xbar); PRO_T1(8192); if (DUPMASK & 16) xcd_barrier(xbar); } }
        if (SPINSET) {
            const int cls = ph == 0 ? 0 : ph == N_PHASES - 1 ? 9 : 1 + ((ph - 1) & 7);
            if ((SPINSET >> cls) & 1) { const unsigned long long t1 = __builtin_amdgcn_s_memrealtime(), tgt = t1 + (t1 - t_ph0); while (__builtin_amdgcn_s_memrealtime() < tgt) __builtin_amdgcn_s_sleep(8); }
        }
    }
}

#ifndef N_LAUNCH_MODE
#define N_LAUNCH_MODE 1
#endif
extern "C" void kernel_launch(void* const* d_in, const int* in_sizes, int n_in, void* d_out, int out_size, void* d_ws, size_t ws_size, hipStream_t stream) {
    static int grid = 0;
    if (grid == 0) {
        if (n_in != N_IN || (size_t)out_size != O_END || ws_size < WS_END + 106 * MiB) { fprintf(stderr, "kernel_launch: unexpected sizes n_in %d out %d ws %zu\n", n_in, out_size, ws_size); grid = -1; return; }
        int dev = 0, cus = 0, per_cu = 0;
        if (hipGetDevice(&dev) != hipSuccess || hipDeviceGetAttribute(&cus, hipDeviceAttributeMultiprocessorCount, dev) != hipSuccess) { grid = -1; return; }
        if (hipFuncSetAttribute((const void*)fwd_kernel, hipFuncAttributeMaxDynamicSharedMemorySize, LDS_BYTES) != hipSuccess) { fprintf(stderr, "kernel_launch: hipFuncSetAttribute failed\n"); grid = -1; return; }
        if (hipOccupancyMaxActiveBlocksPerMultiprocessor(&per_cu, (const void*)fwd_kernel, NTHR, LDS_BYTES) != hipSuccess || per_cu < 1) { fprintf(stderr, "kernel_launch: occupancy query says %d\n", per_cu); per_cu = 1; }
        (void)hipGetLastError();
        grid = cus;
    }
    if (grid < 0) return;
    if (hipMemsetAsync((char*)d_ws + WS_CTL, 0, CTL_ZERO_BYTES, stream) != hipSuccess) { fprintf(stderr, "kernel_launch: memset failed\n"); return; }
    Args a{};
    for (int i = 0; i < N_IN; ++i) a.in[i] = (const float*)d_in[i];
    a.out = (float*)d_out; a.ws = (unsigned char*)d_ws;
#if N_LAUNCH_MODE == 1
    a.ph_lo = 0; a.ph_hi = N_PHASES;
    void* args[] = {&a};
    hipError_t e = hipLaunchCooperativeKernel((const void*)fwd_kernel, dim3(grid), dim3(NTHR), args, LDS_BYTES, stream);
    if (e != hipSuccess) fprintf(stderr, "cooperative launch failed: %s (grid %d)\n", hipGetErrorString(e), grid);
#else
    for (int ph = 0; ph < N_PHASES; ++ph) {
        a.ph_lo = ph; a.ph_hi = ph + 1;
        hipLaunchKernelGGL(fwd_kernel, dim3(grid), dim3(NTHR), LDS_BYTES, stream, a);
    }
#endif
}
```

```cpp
#define DUPMASK 0
#define SPINSET 0
#define MIXSPIN 0
#include <hip/hip_runtime.h>
#include <hip/hip_cooperative_groups.h>
#include <cstdio>
#include <cstdint>
namespace cg = cooperative_groups;
namespace pg8 {
#define PG8_LAS __attribute__((address_space(3)))
typedef unsigned short bf16_t;
typedef short bf16x8 __attribute__((ext_vector_type(8)));
typedef float f32x4 __attribute__((ext_vector_type(4)));
typedef unsigned u32x4 __attribute__((ext_vector_type(4)));
constexpr int BM = 256, BK = 64, HALF = 128, HTB = HALF * BK * 2  , STAGE_BYTES = 8 * HTB, NXCD = 8, WGM = 8;

__host__ __device__ __forceinline__ int lds_byte(int r, int c) { const int st = (r >> 4) * 2 + (c >> 5), rr = r & 15, cc = c & 31, ob = rr * 64 + cc * 2; return st * 1024 + (ob ^ (((ob >> 9) & 1) << 5)); }
__host__ __device__ __forceinline__ void stage_rc(int b, int& R, int& C) { const int st = b / 1024, sb = b % 1024, swz = sb ^ (((sb >> 9) & 1) << 5); R = (st >> 1) * 16 + swz / 64; C = (st & 1) * 32 + (swz % 64) / 2; }
__host__ __device__ __forceinline__ int perm32(int rho) { const int n = rho >> 4, i = rho & 15; return 8 * (i >> 2) + 4 * n + (i & 3); }

struct Unit { int pm, pn; };
struct Gemm { const bf16_t* A; const bf16_t* Bt; int M, N, K; };

struct StaticOrder {
    int nM, nN, nwg, G, c;
    __host__ __device__ void init(int M, int N, int G_, int c_) { nM = M / BM; nN = N / BM; nwg = nM * nN; G = G_; c = c_; }
    __host__ __device__ bool next(int i, Unit& u) const {
        const long L = (long)i * G + c; if (L >= nwg) return false;
        int wgid = (int)L; { const int q = nwg / NXCD, r = nwg % NXCD, xcd = wgid % NXCD, off = wgid / NXCD; wgid = (xcd < r ? xcd * (q + 1) : r * (q + 1) + (xcd - r) * q) + off; }
        const int nig = WGM * nN, gid = wgid / nig, fm = gid * WGM, gsz = (nM - fm) < WGM ? (nM - fm) : WGM;
        u.pm = fm + ((wgid % nig) % gsz); u.pn = (wgid % nig) / gsz; return true;
    }
    __device__ __forceinline__ void a_ready(const Unit&) const {}
    __device__ __forceinline__ void done(const Unit&) const {}
};

__device__ __forceinline__ unsigned cvt_pk_bf16(float lo, float hi) { unsigned r; asm volatile("v_cvt_pk_bf16_f32 %0, %1, %2" : "=v"(r) : "v"(lo), "v"(hi)); return r; }
typedef float f32x2 __attribute__((ext_vector_type(2)));
template <class Epi, class Sched, bool ALIGN_EPI = false, bool SP2 = false>
__device__ __forceinline__ void gemm_phase(PG8_LAS unsigned char* lds, const Gemm g, const Sched& S, const Epi& E) {
    int tid = threadIdx.x; asm volatile("" : "+v"(tid)); const int wid = __builtin_amdgcn_readfirstlane(tid >> 6), lane = tid & 63, wr = wid >> 2, wc = wid & 3, fr = lane & 15, fq = lane >> 4;
    const int K = g.K, nt = K / BK;
    unsigned voffA[2], voffB[2];
#pragma unroll
    for (int i = 0; i < 2; ++i) { int R, C; stage_rc(tid * 16 + i * 8192, R, C); const int Rb = Epi::PERM ? ((R & ~31) + perm32(R & 31)) : R;
        voffA[i] = (unsigned)(R * K + C) * 2u; voffB[i] = (unsigned)(Rb * K + C) * 2u; }
    const size_t kstep = (size_t)(BK * 2);
    const size_t hstep = (size_t)HALF * K * 2;
    const size_t tstep = 2 * hstep;
    const unsigned ldsw = (unsigned)wid * 1024u;
    const int aoff = lds_byte(wr * 64 + fr, fq * 8), boff = lds_byte(wc * 32 + fr, fq * 8);
#define PG8_SA(b, h) (((b) * 2 + (h)) * HTB)
#define PG8_SB(b, h) ((4 + (b) * 2 + (h)) * HTB)
#define PG8_STAGE(bufoff, gbase, voff) do { _Pragma("unroll") for (int _i = 0; _i < 2; ++_i) \
        __builtin_amdgcn_global_load_lds((const unsigned*)((const char*)(gbase) + (voff)[_i]), (PG8_LAS unsigned*)(lds + (bufoff) + ldsw + _i * 8192), 16, 0, 0); } while (0)
#define PG8_LDA(dst, b, h) do { _Pragma("unroll") for (int m = 0; m < 4; ++m) _Pragma("unroll") for (int k = 0; k < 2; ++k) dst[m][k] = *(const PG8_LAS bf16x8*)(lds + PG8_SA(b, h) + aoff + m * 2048 + k * 1024); } while (0)
#define PG8_LDB(dst, b, h) do { _Pragma("unroll") for (int n = 0; n < 2; ++n) _Pragma("unroll") for (int k = 0; k < 2; ++k) dst[n][k] = *(const PG8_LAS bf16x8*)(lds + PG8_SB(b, h) + boff + n * 2048 + k * 1024); } while (0)
#define PG8_MMA(ai, bj, At, Bt) do { __builtin_amdgcn_s_setprio(1); _Pragma("unroll") for (int m = 0; m < 4; ++m) _Pragma("unroll") for (int n = 0; n < 2; ++n) _Pragma("unroll") for (int k = 0; k < 2; ++k) \
        acc[ai][bj][m][n] = __builtin_amdgcn_mfma_f32_16x16x32_bf16(Bt[n][k], At[m][k], acc[ai][bj][m][n], 0, 0, 0); __builtin_amdgcn_s_setprio(0); } while (0)
#define PG8_WAIT_V(n) asm volatile("s_waitcnt vmcnt(" #n ")" ::: "memory")
#define PG8_WAIT_L(n) asm volatile("s_waitcnt lgkmcnt(" #n ")" ::: "memory")
#define PG8_BAR __builtin_amdgcn_s_barrier()
#define PG8_SCHED __builtin_amdgcn_sched_barrier(0)
    Unit cur, nxt; int ui = 0;
    if (!S.next(0, cur)) return;
    f32x4 acc[2][2][4][2];
#pragma unroll
    for (int a = 0; a < 2; ++a)
#pragma unroll
        for (int b = 0; b < 2; ++b)
#pragma unroll
            for (int m = 0; m < 4; ++m)
#pragma unroll
                for (int n = 0; n < 2; ++n) acc[a][b][m][n] = (f32x4){0.f, 0.f, 0.f, 0.f};
    bf16x8 At[4][2], B0[2][2], B1[2][2];
    const char* cA = (const char*)g.A + (size_t)cur.pm * tstep; const char* cB = (const char*)g.Bt + (size_t)cur.pn * tstep;
    S.a_ready(cur);
    if constexpr (SP2) {
        PG8_STAGE(PG8_SB(0, 0), cB, voffB); PG8_STAGE(PG8_SB(0, 1), cB + hstep, voffB); PG8_STAGE(PG8_SA(0, 0), cA, voffA); PG8_STAGE(PG8_SA(0, 1), cA + hstep, voffA);
        if (wr == 1) PG8_BAR;
        PG8_WAIT_V(2); PG8_BAR;
        PG8_STAGE(PG8_SB(1, 0), cB + kstep, voffB); PG8_STAGE(PG8_SA(1, 0), cA + kstep, voffA); PG8_STAGE(PG8_SB(1, 1), cB + hstep + kstep, voffB);
        PG8_WAIT_V(6); PG8_BAR;
    } else {
        PG8_STAGE(PG8_SB(0, 0), cB, voffB); PG8_STAGE(PG8_SA(0, 0), cA, voffA); PG8_STAGE(PG8_SB(0, 1), cB + hstep, voffB); PG8_STAGE(PG8_SA(0, 1), cA + hstep, voffA);
        if (wr == 1) PG8_BAR;
        PG8_WAIT_V(4); PG8_BAR;
        PG8_STAGE(PG8_SB(1, 0), cB + kstep, voffB); PG8_STAGE(PG8_SA(1, 0), cA + kstep, voffA); PG8_STAGE(PG8_SB(1, 1), cB + hstep + kstep, voffB);
        PG8_WAIT_V(6); PG8_BAR;
    }
    for (;;) {
        const bool has_next = S.next(ui + 1, nxt);
        const char* nA = has_next ? (const char*)g.A + (size_t)nxt.pm * tstep : cA; const char* nB = has_next ? (const char*)g.Bt + (size_t)nxt.pn * tstep : cB;
        for (int t = 0; t < nt; t += 2) {
            const bool last = (t == nt - 2);
            const char* a1 = cA + (size_t)(t + 1) * kstep;
            const char* a2 = last ? nA : cA + (size_t)(t + 2) * kstep; const char* b2 = last ? nB : cB + (size_t)(t + 2) * kstep;
            const char* a3 = a2 + kstep; const char* b3 = b2 + kstep;
            if (last && has_next) S.a_ready(nxt);
            if constexpr (SP2) {
            PG8_LDB(B0, 0, 0); PG8_LDB(B1, 0, 1); PG8_SCHED; PG8_LDA(At, 0, 0); PG8_STAGE(PG8_SA(1, 1), a1 + hstep, voffA);
            PG8_WAIT_V(8); PG8_WAIT_L(0); PG8_BAR; PG8_MMA(0, 0, At, B0); PG8_MMA(0, 1, At, B1); PG8_BAR; PG8_SCHED;
            PG8_LDA(At, 0, 1); PG8_STAGE(PG8_SB(0, 0), b2, voffB); PG8_STAGE(PG8_SB(0, 1), b2 + hstep, voffB); PG8_STAGE(PG8_SA(0, 0), a2, voffA);
            PG8_WAIT_V(8); PG8_WAIT_L(0); PG8_BAR; PG8_MMA(1, 0, At, B0); PG8_MMA(1, 1, At, B1); PG8_BAR; PG8_SCHED;
            PG8_LDB(B0, 1, 0); PG8_LDB(B1, 1, 1); PG8_SCHED; PG8_LDA(At, 1, 0); PG8_STAGE(PG8_SA(0, 1), a2 + hstep, voffA);
            PG8_WAIT_V(8); PG8_WAIT_L(0); PG8_BAR; PG8_MMA(0, 0, At, B0); PG8_MMA(0, 1, At, B1); PG8_BAR; PG8_SCHED;
            PG8_LDA(At, 1, 1); PG8_STAGE(PG8_SB(1, 0), b3, voffB); PG8_STAGE(PG8_SB(1, 1), b3 + hstep, voffB); PG8_STAGE(PG8_SA(1, 0), a3, voffA);
            PG8_WAIT_V(8); PG8_WAIT_L(0); PG8_BAR; PG8_MMA(1, 0, At, B0); PG8_MMA(1, 1, At, B1); PG8_BAR; PG8_SCHED;
            } else {
            PG8_LDB(B0, 0, 0); PG8_SCHED; PG8_LDA(At, 0, 0); PG8_STAGE(PG8_SA(1, 1), a1 + hstep, voffA);
            PG8_WAIT_L(8); PG8_BAR; PG8_WAIT_L(0); PG8_MMA(0, 0, At, B0); PG8_BAR; PG8_SCHED;
            PG8_LDB(B1, 0, 1); PG8_STAGE(PG8_SB(0, 0), b2, voffB);
            PG8_BAR; PG8_WAIT_L(0); PG8_MMA(0, 1, At, B1); PG8_BAR;
            PG8_LDA(At, 0, 1); PG8_STAGE(PG8_SA(0, 0), a2, voffA);
            PG8_BAR; PG8_WAIT_L(0); PG8_MMA(1, 0, At, B0); PG8_BAR; PG8_SCHED;
            PG8_STAGE(PG8_SB(0, 1), b2 + hstep, voffB);
            PG8_WAIT_V(6); PG8_BAR; PG8_MMA(1, 1, At, B1); PG8_BAR;
            PG8_LDB(B0, 1, 0); PG8_SCHED; PG8_LDA(At, 1, 0); PG8_STAGE(PG8_SA(0, 1), a2 + hstep, voffA);
            PG8_WAIT_L(8); PG8_BAR; PG8_WAIT_L(0); PG8_MMA(0, 0, At, B0); PG8_BAR; PG8_SCHED;
            PG8_LDB(B1, 1, 1); PG8_STAGE(PG8_SB(1, 0), b3, voffB);
            PG8_BAR; PG8_WAIT_L(0); PG8_MMA(0, 1, At, B1); PG8_BAR;
            PG8_LDA(At, 1, 1); PG8_STAGE(PG8_SA(1, 0), a3, voffA);
            PG8_BAR; PG8_WAIT_L(0); PG8_MMA(1, 0, At, B0); PG8_BAR; PG8_SCHED;
            PG8_STAGE(PG8_SB(1, 1), b3 + hstep, voffB);
            PG8_WAIT_V(6); PG8_BAR; PG8_MMA(1, 1, At, B1); PG8_BAR;
            }
        }
        if constexpr (ALIGN_EPI) { if (wr == 0) PG8_BAR; }
        if constexpr (!Epi::AFTER_DRAIN) {
#if defined(MIXSPIN) && (MIXSPIN & 4096)
            const unsigned long long te0_ = __builtin_amdgcn_s_memrealtime();
#endif
            E(acc, cur, wr, wc, fr, fq); S.done(cur);
#if defined(MIXSPIN) && (MIXSPIN & 4096)
            { asm volatile("s_waitcnt vmcnt(0)" ::: "memory"); const unsigned long long te1_ = __builtin_amdgcn_s_memrealtime(), tg_ = te1_ + (te1_ - te0_); while (__builtin_amdgcn_s_memrealtime() < tg_) __builtin_amdgcn_s_sleep(8); }
#endif
        }
        if (!has_next) break;
#pragma unroll
        for (int a = 0; a < 2; ++a)
#pragma unroll
            for (int b = 0; b < 2; ++b)
#pragma unroll
                for (int m = 0; m < 4; ++m)
#pragma unroll
                    for (int n = 0; n < 2; ++n) acc[a][b][m][n] = (f32x4){0.f, 0.f, 0.f, 0.f};
        cur = nxt; cA = nA; cB = nB; ++ui;
        if constexpr (ALIGN_EPI) { if (wr == 1) PG8_BAR; }
    }
    PG8_WAIT_V(0);
    if constexpr (!ALIGN_EPI) { if (wr == 0) PG8_BAR; }
    PG8_BAR;
    if constexpr (Epi::AFTER_DRAIN) { E.fused(acc, cur, wr, wc, fr, fq, lds, wid, lane); S.done(cur); }
#undef PG8_SA
#undef PG8_SB
#undef PG8_STAGE
#undef PG8_LDA
#undef PG8_LDB
#undef PG8_MMA
#undef PG8_WAIT_V
#undef PG8_WAIT_L
#undef PG8_BAR
#undef PG8_SCHED
}
}

#define DI __device__ __forceinline__
#ifndef MIXSPIN
#define MIXSPIN 0
#endif
#define PRO_T0() const unsigned long long t_p0 = MIXSPIN ? __builtin_amdgcn_s_memrealtime() : 0ull
#define PRO_T1(bit) do { if (MIXSPIN & (bit)) { const unsigned long long t1_ = __builtin_amdgcn_s_memrealtime(), tg_ = t1_ + (t1_ - t_p0); while (__builtin_amdgcn_s_memrealtime() < tg_) __builtin_amdgcn_s_sleep(8); } } while (0)
#define LAS __attribute__((address_space(3)))
typedef unsigned short bf16_t;
typedef short bf16x8 __attribute__((ext_vector_type(8)));
typedef float f32x4 __attribute__((ext_vector_type(4)));
typedef float f32x16 __attribute__((ext_vector_type(16)));
typedef unsigned u32x4 __attribute__((ext_vector_type(4)));
typedef unsigned u32x2 __attribute__((ext_vector_type(2)));
typedef float f32x2_t __attribute__((ext_vector_type(2)));
typedef __bf16 bf16x2_t __attribute__((ext_vector_type(2)));

constexpr int DM = 1024, NB = 8, SEQ = 2048, MP = NB * SEQ, NL = 2, NS = 128, MEM = 256, MM = NB * MEM, DG = 256, DIN = 2048, DFF = 4096;
constexpr float EPS = 1e-6f;
constexpr int NWAVES = 8, NTHR = 512;
constexpr int LDS_BYTES = 147456;

constexpr size_t MiB = 1u << 20;
constexpr size_t WS_W = 2 * MiB, W_LSTRIDE = 28 * MiB;
constexpr size_t W_IN = 0, W_OUT = 4 * MiB, W_Q = 6 * MiB, W_O = 8 * MiB, W_F1 = 10 * MiB, W_F2 = 18 * MiB, W_GWS = 26 * MiB, W_PWT = 26 * MiB + 512 * 1024;
constexpr size_t WS_WKV = 58 * MiB;
constexpr size_t WS_MEMB = 66 * MiB;
constexpr size_t WS_MEMSS = 70 * MiB;
constexpr size_t WS_SS = 71 * MiB;
constexpr size_t WS_XB = 72 * MiB;
constexpr size_t WS_Z = 264 * MiB;
constexpr size_t WS_Y = 168 * MiB;
constexpr size_t WS_Q = WS_Y;
constexpr size_t WS_O = WS_Y;
constexpr size_t WS_H = 264 * MiB;
constexpr size_t WS_KP = 392 * MiB;
constexpr size_t WS_VT = 400 * MiB;
constexpr size_t WS_XS = 408 * MiB, WS_YS = 408 * MiB + 512 * 1024, WS_OS = 409 * MiB, WS_SSQ = 409 * MiB + 512 * 1024  , WS_ZS = 410 * MiB  , WS_QS = 412 * MiB  , WS_HS = 413 * MiB  , WS_END = 417 * MiB;
constexpr size_t WS_CTL = 0, CTL_ZERO_BYTES = 65536;

constexpr size_t O_YP = 0, O_YS = O_YP + (size_t)MP * DM, O_MK = O_YS + (size_t)NS * DM, O_MV = O_MK + (size_t)NL * MM * DM, O_GLUP = O_MV + (size_t)NL * MM * DM,
                 O_GLUS = O_GLUP + (size_t)NL * NB * 30 * DG, O_SHP = O_GLUS + (size_t)NL * NS * 30 * DG, O_SHS = O_SHP + (size_t)NL * NB * 2 * DG,
                 O_PLP = O_SHS + (size_t)NL * NS * 2 * DG, O_PLS = O_PLP + (size_t)NL * NB * 15 * DG, O_GV = O_PLS + (size_t)NL * NS * 15 * DG, O_END = O_GV + (size_t)NL * NS * DG;

enum { I_XP = 0, I_XS, I_MEM, I_CK, I_CV, I_SGLU, I_SSH, I_SPL, I_NMIX, I_WIN, I_LNG, I_LNB, I_GWS, I_GBS, I_CDW, I_CDWB, I_CLNG, I_CLNB, I_SCDW, I_PW, I_PSC, I_MOG, I_WOUT,
       I_NXA, I_NMEM, I_WQ, I_WK, I_WV, I_WO, I_NFF, I_WF1, I_WF2, I_NFIN, N_IN };

DI unsigned pk2(float lo, float hi) { f32x2_t v = {lo, hi}; bf16x2_t b = __builtin_convertvector(v, bf16x2_t); return __builtin_bit_cast(unsigned, b); }
DI float bf2f(unsigned short u) { return __uint_as_float((unsigned)u << 16); }
DI float bflo(unsigned u) { return __uint_as_float(u << 16); }
DI float bfhi(unsigned u) { return __uint_as_float(u & 0xffff0000u); }
DI f32x4 ld_bf4_nt(const bf16_t* p) { const u32x2 w = __builtin_nontemporal_load((const u32x2*)p); return (f32x4){bflo(w.x), bfhi(w.x), bflo(w.y), bfhi(w.y)}; }
DI f32x4 ld_bf4(const bf16_t* p) { const u32x2 w = *(const u32x2*)p; return (f32x4){bflo(w.x), bfhi(w.x), bflo(w.y), bfhi(w.y)}; }
#ifndef NTST
#define NTST 0
#endif
#if NTST == 2
DI void st_wt8(void* p, u32x2 v) { __hip_atomic_store((unsigned long long*)p, ((unsigned long long)v.y << 32) | v.x, __ATOMIC_RELAXED, __HIP_MEMORY_SCOPE_AGENT); }
#define ST16(p, v) do { const u32x4 v_ = (v); st_wt8((char*)(p), (u32x2){v_.x, v_.y}); st_wt8((char*)(p) + 8, (u32x2){v_.z, v_.w}); } while (0)
#define ST8(p, v) st_wt8((p), (v))
#elif NTST
#define ST16(p, v) __builtin_nontemporal_store((v), (u32x4*)(p))
#define ST8(p, v) __builtin_nontemporal_store((v), (u32x2*)(p))
#else
#define ST16(p, v) (*(u32x4*)(p) = (v))
#define ST8(p, v) (*(u32x2*)(p) = (v))
#endif
DI void st_bf4(bf16_t* p, f32x4 v) { u32x2 w; w.x = pk2(v.x, v.y); w.y = pk2(v.z, v.w); ST8(p, w); }
template <int CTRL> DI float dpp_f(float v) { return __int_as_float(__builtin_amdgcn_update_dpp(0, __float_as_int(v), CTRL, 0xf, 0xf, true)); }
DI float row_sum16(float v) {
    v += dpp_f<0xB1>(v);
    v += dpp_f<0x4E>(v);
    v += dpp_f<0x141>(v);
    v += dpp_f<0x140>(v);
    return v;
}
DI float rl_f(float v, int l) { return __int_as_float(__builtin_amdgcn_readlane(__float_as_int(v), l)); }
DI float wave_sum(float v) { v = row_sum16(v); return (rl_f(v, 0) + rl_f(v, 16)) + (rl_f(v, 32) + rl_f(v, 48)); }
DI float half_sum32(float v, int lane) { v = row_sum16(v); const float a = rl_f(v, 0) + rl_f(v, 16), b = rl_f(v, 32) + rl_f(v, 48); return lane < 32 ? a : b; }
DI float hsum4(f32x4 v) { return (v.x + v.y) + (v.z + v.w); }
DI float hsq4(f32x4 v) { return (v.x * v.x + v.y * v.y) + (v.z * v.z + v.w * v.w); }
DI float sigmoidf_(float x) { return __builtin_amdgcn_rcpf(1.0f + __builtin_amdgcn_exp2f(x * -1.4426950408889634f)); }
DI float row_rs(const float* ss16) {
    const f32x4* sp = (const f32x4*)ss16; const f32x4 a = sp[0], b = sp[1], c = sp[2], d = sp[3];
    const float s = (hsum4(a) + hsum4(b)) + (hsum4(c) + hsum4(d));
    return rsqrtf(s * (1.0f / DM) + EPS);
}

template <int MODE  > struct EpiScale {
    static constexpr bool PERM = true, AFTER_DRAIN = false;
    bf16_t* O; int ldc; const float* ss;
    DI void operator()(const f32x4 (&acc)[2][2][4][2], const pg8::Unit& u, int wr, int wc, int fr, int fq) const {
        const int row0 = u.pm * 256 + wr * 64 + fr, col0 = u.pn * 256 + wc * 32 + 8 * fq;
#pragma unroll
        for (int ai = 0; ai < 2; ++ai)
#pragma unroll
            for (int m = 0; m < 4; ++m) {
                const int row = row0 + ai * 128 + m * 16;
                float rs = row_rs(ss + (size_t)row * 16); if (MODE == 1) rs *= 0.0625f;
                bf16_t* rowp = O + (size_t)row * ldc + col0;
#pragma unroll
                for (int bj = 0; bj < 2; ++bj) {
                    f32x4 v0 = acc[ai][bj][m][0] * rs, v1 = acc[ai][bj][m][1] * rs;
                    if (MODE == 2) {
#pragma unroll
                        for (int j = 0; j < 4; ++j) { float a = fmaxf(v0[j], 0.f), b = fmaxf(v1[j], 0.f); v0[j] = a * a; v1[j] = b * b; }
                    }
                    u32x4 w; w.x = pk2(v0[0], v0[1]); w.y = pk2(v0[2], v0[3]); w.z = pk2(v1[0], v1[1]); w.w = pk2(v1[2], v1[3]);
                    ST16(rowp + bj * 128, w);
                }
            }
    }
};
struct EpiKV {
    static constexpr bool PERM = true, AFTER_DRAIN = false;
    const float* mss; float* outK; float* outV; bf16_t* KP; bf16_t* VT;
    DI void operator()(const f32x4 (&acc)[2][2][4][2], const pg8::Unit& u, int wr, int wc, int fr, int fq) const {
        const int l = u.pn >> 3, w8 = u.pn & 7, isV = w8 >> 2, h = w8 & 3, b = u.pm;
        const int row0 = u.pm * 256 + wr * 64 + fr, colh0 = h * 256 + wc * 32 + 8 * fq;
        float* outp = (isV ? outV : outK) + (size_t)l * MM * DM;
#pragma unroll
        for (int ai = 0; ai < 2; ++ai)
#pragma unroll
            for (int m = 0; m < 4; ++m) {
                const int row = row0 + ai * 128 + m * 16;
                const float rs = rsqrtf(mss[row] * (1.0f / DM) + EPS);
#pragma unroll
                for (int bj = 0; bj < 2; ++bj) {
                    const int colh = colh0 + bj * 128;
                    const f32x4 v0 = acc[ai][bj][m][0] * rs, v1 = acc[ai][bj][m][1] * rs;
                    __builtin_nontemporal_store(v0, (f32x4*)(outp + (size_t)row * DM + colh)); __builtin_nontemporal_store(v1, (f32x4*)(outp + (size_t)row * DM + colh + 4));
                    if (!isV) {
                        u32x4 w; w.x = pk2(v0[0], v0[1]); w.y = pk2(v0[2], v0[3]); w.z = pk2(v1[0], v1[1]); w.w = pk2(v1[2], v1[3]);
                        *(u32x4*)(KP + ((size_t)l * MM + row) * DM + colh) = w;
                    } else {
                        bf16_t* vt = VT + ((size_t)((l * NB + b) * 4 + h) * 256 + (colh & 255)) * 256 + (row & 255);
#pragma unroll
                        for (int j = 0; j < 4; ++j) { vt[(size_t)j * 256] = (bf16_t)(pk2(v0[j], 0.f) & 0xffffu); vt[(size_t)(j + 4) * 256] = (bf16_t)(pk2(v1[j], 0.f) & 0xffffu); }
                    }
                }
            }
    }
};
struct EpiRes {
    static constexpr bool PERM = true, AFTER_DRAIN = false;
    bf16_t* xb; float* ss;
    DI void operator()(const f32x4 (&acc)[2][2][4][2], const pg8::Unit& u, int wr, int wc, int fr, int fq) const {
        const int row0 = u.pm * 256 + wr * 64 + fr, col0 = u.pn * 256 + wc * 32 + 8 * fq;
        bf16_t* base = xb + (size_t)row0 * DM + col0;
        u32x4 ov[2][4][2];
#pragma unroll
        for (int ai = 0; ai < 2; ++ai)
#pragma unroll
            for (int m = 0; m < 4; ++m) { const bf16_t* rowp = base + (size_t)(ai * 128 + m * 16) * DM; ov[ai][m][0] = *(const u32x4*)rowp; ov[ai][m][1] = *(const u32x4*)(rowp + 128); }
#pragma unroll
        for (int ai = 0; ai < 2; ++ai)
#pragma unroll
            for (int m = 0; m < 4; ++m) {
                const int row = row0 + ai * 128 + m * 16; bf16_t* rowp = base + (size_t)(ai * 128 + m * 16) * DM;
                float sq = 0.f;
#pragma unroll
                for (int bj = 0; bj < 2; ++bj) {
                    const u32x4 o = ov[ai][m][bj];
                    f32x4 v0 = acc[ai][bj][m][0], v1 = acc[ai][bj][m][1];
                    v0.x += bflo(o.x); v0.y += bfhi(o.x); v0.z += bflo(o.y); v0.w += bfhi(o.y);
                    v1.x += bflo(o.z); v1.y += bfhi(o.z); v1.z += bflo(o.w); v1.w += bfhi(o.w);
                    sq += hsq4(v0) + hsq4(v1);
                    u32x4 w; w.x = pk2(v0[0], v0[1]); w.y = pk2(v0[2], v0[3]); w.z = pk2(v1[0], v1[1]); w.w = pk2(v1[2], v1[3]);
                    ST16(rowp + bj * 128, w);
                }
                sq += __shfl_xor(sq, 16); sq += __shfl_xor(sq, 32);
                if (fq == 0) ss[(size_t)row * 16 + u.pn * 4 + wc] = sq;
            }
    }
};

struct EpiAny {
    static constexpr bool PERM = true, AFTER_DRAIN = false;
    int mode;
    bf16_t* O; int ldc; const float* ss; float* ssw;
    const float* mss; float* outK; float* outV; bf16_t* KP; bf16_t* VT;
    DI void operator()(const f32x4 (&acc)[2][2][4][2], const pg8::Unit& u, int wr, int wc, int fr, int fq) const {
        if (mode == 0) EpiScale<0>{O, ldc, ss}(acc, u, wr, wc, fr, fq);
        else if (mode == 1) EpiScale<1>{O, ldc, ss}(acc, u, wr, wc, fr, fq);
        else if (mode == 2) EpiScale<2>{O, ldc, ss}(acc, u, wr, wc, fr, fq);
        else if (mode == 3) EpiKV{mss, outK, outV, KP, VT}(acc, u, wr, wc, fr, fq);
        else EpiRes{O, ssw}(acc, u, wr, wc, fr, fq);
    }
};

template <int AMODE, bool SSQ, int NSL, int MT> DI void sgemm_item(const float* A, int lda, const bf16_t* Bt, int ldb, int rowb, int ncol, int kbase, float* Out, int ldo, const float* ssq_in, float* ssq_out, int wave_, int lane) {
    const int r = lane & 15, q = lane >> 4;
    const int wave = (rowb >> 4) + (wave_ % MT), n0 = ncol + (wave_ / MT) * NSL * 16;
    const float* ap = A + (size_t)(16 * wave + r) * lda + kbase + 16 * q;
    const bf16_t* bp = Bt + (size_t)(n0 + r) * ldb + kbase + 16 * q;
    f32x4 av[4][4]; bf16x8 bv[NSL][4][2];
#pragma unroll
    for (int c = 0; c < 4; ++c)
#pragma unroll
        for (int i = 0; i < 4; ++i) av[c][i] = *(const f32x4*)(ap + 64 * c + 4 * i);
#pragma unroll
    for (int sl = 0; sl < NSL; ++sl)
#pragma unroll
        for (int c = 0; c < 4; ++c) { bv[sl][c][0] = *(const bf16x8*)(bp + (size_t)sl * 16 * ldb + 64 * c); bv[sl][c][1] = *(const bf16x8*)(bp + (size_t)sl * 16 * ldb + 64 * c + 8); }
    float rsA = 1.f; if (AMODE == 1) rsA = rsqrtf(ssq_in[16 * wave + r] * (1.0f / DM) + EPS);
    f32x4 acc[NSL]; float ssq = 0.f;
#pragma unroll
    for (int sl = 0; sl < NSL; ++sl) acc[sl] = (f32x4){0.f, 0.f, 0.f, 0.f};
#pragma unroll
    for (int c = 0; c < 4; ++c) {
        if (AMODE == 1) {
#pragma unroll
            for (int i = 0; i < 4; ++i)
#pragma unroll
                for (int j = 0; j < 4; ++j) { const float t = fmaxf(av[c][i][j] * rsA, 0.f); av[c][i][j] = t * t; }
        }
        if (SSQ) ssq += (hsq4(av[c][0]) + hsq4(av[c][1])) + (hsq4(av[c][2]) + hsq4(av[c][3]));
        u32x4 p0, p1; p0.x = pk2(av[c][0].x, av[c][0].y); p0.y = pk2(av[c][0].z, av[c][0].w); p0.z = pk2(av[c][1].x, av[c][1].y); p0.w = pk2(av[c][1].z, av[c][1].w);
        p1.x = pk2(av[c][2].x, av[c][2].y); p1.y = pk2(av[c][2].z, av[c][2].w); p1.z = pk2(av[c][3].x, av[c][3].y); p1.w = pk2(av[c][3].z, av[c][3].w);
#pragma unroll
        for (int sl = 0; sl < NSL; ++sl) {
            acc[sl] = __builtin_amdgcn_mfma_f32_16x16x32_bf16(__builtin_bit_cast(bf16x8, p0), bv[sl][c][0], acc[sl], 0, 0, 0);
            acc[sl] = __builtin_amdgcn_mfma_f32_16x16x32_bf16(__builtin_bit_cast(bf16x8, p1), bv[sl][c][1], acc[sl], 0, 0, 0);
        }
    }
    if (SSQ) { if (n0 == 0) { ssq += __shfl_xor(ssq, 16); ssq += __shfl_xor(ssq, 32); if (q == 0) unsafeAtomicAdd(ssq_out + 16 * wave + r, ssq); } }
#pragma unroll
    for (int sl = 0; sl < NSL; ++sl)
#pragma unroll
        for (int j = 0; j < 4; ++j) unsafeAtomicAdd(Out + (size_t)(16 * wave + 4 * q + j) * ldo + n0 + 16 * sl + r, acc[sl][j]);
}
template <int AMODE, bool SSQ, int NSL, int MT> DI void sgemm_phase(const float* A, int K, const bf16_t* Bt, int N, float* Out, const float* ssq_in, float* ssq_out, int bx, int G, int wave, int lane) {
    constexpr int W = 16 * NSL * (8 / MT), NRB = 8 / MT;
    const int ng = N / W, nit = NRB * ng * (K / 256);
    const int vcu = (G & 7) == 0 ? (bx & 7) * (G >> 3) + (bx >> 3) : bx;
    for (int it = vcu; it < nit; it += G) { const int rb = it % NRB, sg = (it / NRB) % ng, kp = it / (NRB * ng); sgemm_item<AMODE, SSQ, NSL, MT>(A, K, Bt, K, rb * 16 * MT, sg * W, kp * 256, Out, N, ssq_in, ssq_out, wave, lane); }
}
template <int AMODE, bool SSQ, int NSL, int MT> DI void sgemm_phase_p(const float* A, int K, const bf16_t* Bt, int N, float* Out, const float* ssq_in, float* ssq_out, unsigned char* ws, int bx, int G, int wave, int lane) {
    { PRO_T0(); sgemm_phase<AMODE, SSQ, NSL, MT>(A, K, Bt, N, Out, ssq_in, ssq_out, bx, G, wave, lane); if (MIXSPIN & 512) asm volatile("s_waitcnt vmcnt(0)" ::: "memory"); PRO_T1(512); }
    if (DUPMASK & 8) sgemm_phase<AMODE, SSQ, NSL, MT>(A, K, Bt, N, (float*)(ws + WS_END), ssq_in, (float*)(ws + WS_END) + 1024 * 1024, bx, G, wave, lane);
}

struct TrDesc { const float* W; const float* g; bf16_t* WT; int K, N, row_off, item; };
DI void tr_load(const TrDesc& d, f32x4 (&r)[8], float (&gv)[8], int lane) {
    const int nblk = d.N / 32, kb = d.item / nblk, nb = d.item % nblk, k0 = 64 * kb, n0 = 32 * nb;
    const float* p = d.W + (size_t)(k0 + (lane >> 3)) * d.N + n0 + 4 * (lane & 7);
#pragma unroll
    for (int i = 0; i < 8; ++i) { r[i] = __builtin_nontemporal_load((const f32x4*)(p + (size_t)i * 8 * d.N)); gv[i] = d.g ? d.g[k0 + (lane >> 3) + 8 * i] : 1.f; }
}
DI void tr_finish(const TrDesc& d, const f32x4 (&r)[8], const float (&gv)[8], LAS float* scr, int lane) {
    const int nblk = d.N / 32, kb = d.item / nblk, nb = d.item % nblk, k0 = 64 * kb, n0 = 32 * nb;
#pragma unroll
    for (int i = 0; i < 8; ++i) { LAS float* q = scr + ((lane >> 3) + 8 * i) * 33 + 4 * (lane & 7); const f32x4 v = r[i] * gv[i]; q[0] = v.x; q[1] = v.y; q[2] = v.z; q[3] = v.w; }
    asm volatile("s_waitcnt lgkmcnt(0)" ::: "memory");
    const int c = lane & 7;
#pragma unroll
    for (int j = 0; j < 4; ++j) { const int n = (lane >> 3) + 8 * j; const LAS float* s = scr + (8 * c) * 33 + n;
        u32x4 o; o.x = pk2(s[0 * 33], s[1 * 33]); o.y = pk2(s[2 * 33], s[3 * 33]); o.z = pk2(s[4 * 33], s[5 * 33]); o.w = pk2(s[6 * 33], s[7 * 33]);
        *(u32x4*)(d.WT + (size_t)(d.row_off + n0 + n) * d.K + k0 + 8 * c) = o; }
    asm volatile("s_waitcnt lgkmcnt(0)" ::: "memory");
}
DI float row_to_bf16(const float* xrow, bf16_t* orow, int lane) {
    const f32x4* xr = (const f32x4*)xrow + lane; float s = 0.f;
#pragma unroll
    for (int j = 0; j < 4; ++j) { const f32x4 v = __builtin_nontemporal_load(xr + 64 * j); s += hsq4(v); st_bf4(orow + 4 * lane + 256 * j, v); }
    return wave_sum(s);
}

struct Args { const float* in[N_IN]; float* out; unsigned char* ws; int ph_lo, ph_hi; };
typedef const __attribute__((address_space(4))) Args* AP;

DI void prologue(AP a, LAS unsigned char* lds, int wave, int lane_) {
    int lnp_ = lane_; asm volatile("" : "+v"(lnp_)); const int lane = lnp_;
    unsigned char* ws = a->ws;
    LAS float* scr = (LAS float*)(lds + wave * 16384);
    const int gw = blockIdx.x * NWAVES + wave, NGW = gridDim.x * NWAVES;
    constexpr int IT_IN = 16 * 64, IT_SQ = 16 * 32, IT_F1 = 16 * 128, IT_F2 = 64 * 32, IT_L = IT_IN + 5 * IT_SQ + IT_F1 + IT_F2;
    { PRO_T0();
    auto decode = [&](int it) -> TrDesc {
        const int l = it / IT_L; int r = it % IT_L;
        unsigned char* wl = ws + WS_W + (size_t)l * W_LSTRIDE; TrDesc d;
        if (r < IT_IN) { d = TrDesc{a->in[I_WIN] + (size_t)l * DM * DIN, a->in[I_NMIX] + l * DM, (bf16_t*)(wl + W_IN), DM, DIN, 0, r}; return d; } r -= IT_IN;
        if (r < IT_SQ) { d = TrDesc{a->in[I_WOUT] + (size_t)l * DM * DM, nullptr, (bf16_t*)(wl + W_OUT), DM, DM, 0, r}; return d; } r -= IT_SQ;
        if (r < IT_SQ) { d = TrDesc{a->in[I_WQ] + (size_t)l * DM * DM, a->in[I_NXA] + l * DM, (bf16_t*)(wl + W_Q), DM, DM, 0, r}; return d; } r -= IT_SQ;
        if (r < IT_SQ) { d = TrDesc{a->in[I_WK] + (size_t)l * DM * DM, a->in[I_NMEM] + l * DM, (bf16_t*)(ws + WS_WKV), DM, DM, l * 2048, r}; return d; } r -= IT_SQ;
        if (r < IT_SQ) { d = TrDesc{a->in[I_WV] + (size_t)l * DM * DM, a->in[I_NMEM] + l * DM, (bf16_t*)(ws + WS_WKV), DM, DM, l * 2048 + 1024, r}; return d; } r -= IT_SQ;
        if (r < IT_SQ) { d = TrDesc{a->in[I_WO] + (size_t)l * DM * DM, nullptr, (bf16_t*)(wl + W_O), DM, DM, 0, r}; return d; } r -= IT_SQ;
        if (r < IT_F1) { d = TrDesc{a->in[I_WF1] + (size_t)l * DM * DFF, a->in[I_NFF] + l * DM, (bf16_t*)(wl + W_F1), DM, DFF, 0, r}; return d; } r -= IT_F1;
        d = TrDesc{a->in[I_WF2] + (size_t)l * DFF * DM, nullptr, (bf16_t*)(wl + W_F2), DFF, DM, 0, r}; return d;
    };
    constexpr int NIT = NL * IT_L;
    int it = gw; TrDesc d0 = decode(min(it, NIT - 1)); f32x4 r0[8]; float g0[8]; tr_load(d0, r0, g0, lane);
    while (it < NIT) {
        const int itn = it + NGW; const TrDesc d1 = decode(min(itn, NIT - 1)); f32x4 r1[8]; float g1[8]; tr_load(d1, r1, g1, lane);
        tr_finish(d0, r0, g0, scr, lane);
        d0 = d1; it = itn;
#pragma unroll
        for (int i = 0; i < 8; ++i) { r0[i] = r1[i]; g0[i] = g1[i]; }
    }
    PRO_T1(16); }
    { PRO_T0();
        bf16_t* XB = (bf16_t*)(ws + WS_XB); float* SS = (float*)(ws + WS_SS);
        for (int m0 = gw; m0 < MP; m0 += 4 * NGW) {
            f32x4 v[4][4];
#pragma unroll
            for (int k = 0; k < 4; ++k) { const int m = min(m0 + k * NGW, MP - 1);
#pragma unroll
                for (int j = 0; j < 4; ++j) v[k][j] = __builtin_nontemporal_load((const f32x4*)(a->in[I_XP] + (size_t)m * DM) + lane + 64 * j); }
#pragma unroll
            for (int k = 0; k < 4; ++k) { const int m = m0 + k * NGW; if (m < MP) { float sq = 0.f;
#pragma unroll
                for (int j = 0; j < 4; ++j) { sq += hsq4(v[k][j]); st_bf4(XB + (size_t)m * DM + 4 * lane + 256 * j, v[k][j]); }
                sq = wave_sum(sq); if (lane < 16) SS[(size_t)m * 16 + lane] = lane == 0 ? sq : 0.f; } }
        }
        bf16_t* MB = (bf16_t*)(ws + WS_MEMB); float* MS = (float*)(ws + WS_MEMSS);
        for (int m = gw; m < MM; m += NGW) { const float s = row_to_bf16(a->in[I_MEM] + (size_t)m * DM, MB + (size_t)m * DM, lane); if (lane == 0) MS[m] = s; }
    PRO_T1(32); }
    { PRO_T0();
        const int gt = blockIdx.x * NTHR + wave * 64 + lane, NGT = gridDim.x * NTHR;
        for (int i = gt; i < NL * 4 * 128 * 128; i += NGT) { const int l = i >> 16, r = i & 65535, t = (r >> 7) & 127, s = r & 127;
            ((bf16_t*)(ws + WS_W + (size_t)l * W_LSTRIDE + W_GWS))[r] = (bf16_t)(pk2(s <= t ? a->in[I_GWS][i] : 0.f, 0.f) & 0xffffu); }
        for (int i = gt; i < NL * 4 * 64 * 64; i += NGT) { const int l = i >> 14, r = i & 16383, g = r >> 12, d = (r >> 6) & 63, c = r & 63;
            ((bf16_t*)(ws + WS_W + (size_t)l * W_LSTRIDE + W_PWT))[r] = (bf16_t)(pk2(a->in[I_PW][(size_t)l * 16384 + g * 4096 + c * 64 + d], 0.f) & 0xffffu); }
        for (int i = gt; i < NS * DM / 4; i += NGT) ((f32x4*)(ws + WS_XS))[i] = ((const f32x4*)a->in[I_XS])[i];
        for (int i = gt; i < (int)((WS_END - WS_ZS) / 16); i += NGT) ((f32x4*)(ws + WS_ZS))[i] = (f32x4){0.f, 0.f, 0.f, 0.f};
        for (int i = gt; i < NL * 3 * NS; i += NGT) ((float*)(ws + WS_SSQ))[i] = 0.f;
    PRO_T1(64); }
}

#ifndef MIXP
#define MIXP 15
#endif
#ifndef MIXSPIN
#define MIXSPIN 0
#endif
#define MIX_T0() const unsigned long long t_m0 = MIXSPIN ? __builtin_amdgcn_s_memrealtime() : 0ull
#define MIX_T1(bit) do { if (MIXSPIN & (bit)) { const unsigned long long t1_ = __builtin_amdgcn_s_memrealtime(), tg_ = t1_ + (t1_ - t_m0); while (__builtin_amdgcn_s_memrealtime() < tg_) __builtin_amdgcn_s_sleep(8); } } while (0)
constexpr int VNT_P = 136;
constexpr int TT_OFF = 69632, TT_P = 260;
constexpr int CW_OFF = 96256;
constexpr int PL_P = 264;

DI void tt_rows_out(LAS unsigned char* lds, bf16_t* Yrow0, const float* mog, int wave, int lane) {
    const LAS float* TT = (const LAS float*)(lds + TT_OFF);
    const f32x4 g = *(const f32x4*)(mog + 4 * lane);
#pragma unroll
    for (int i = 0; i < 8; ++i) {
        const int tt = 8 * wave + i;
        const f32x4 v = *(const LAS f32x4*)(TT + tt * TT_P + 4 * lane);
        const float r = rsqrtf(wave_sum(hsq4(v)) * (1.0f / DG) + EPS);
        st_bf4(Yrow0 + (size_t)tt * DM + 4 * lane, v * r * g);
    }
}

DI void mixer_unit(AP a, int l, int uidx, LAS unsigned char* lds, int wave, int lane) {
    unsigned char* ws = a->ws;
    const int b = uidx >> 5, ju = uidx & 31, t0 = ju * 64, off = t0 & 127, tc = t0 - off;
    const size_t R0 = (size_t)b * SEQ + t0;
    const bf16_t* Z = (const bf16_t*)(ws + WS_Z);
    bf16_t* Y = (bf16_t*)(ws + WS_Y);
    const float* mog = a->in[I_MOG] + l * DM;
    u32x2 gar[12], ggr[12];
    {
        int lq_ = lane; asm volatile("" : "+v"(lq_));
#pragma unroll
        for (int i = 0; i < 12; ++i) { const int rr = wave + 8 * i, t = t0 - 30 + rr; const int tcl = (rr < 94 && t >= 0) ? t : t0;
            const bf16_t* zr = Z + ((size_t)b * SEQ + tcl) * DIN; gar[i] = *(const u32x2*)(zr + 512 + 4 * lq_); ggr[i] = *(const u32x2*)(zr + 768 + 4 * lq_); }
    }
    { MIX_T0(); if (MIXP & 1) {
        int lq_ = lane; asm volatile("" : "+v"(lq_)); const int lane = lq_; const int fr = lane & 15, fq = lane >> 4; (void)fr; (void)fq;
        LAS bf16_t* VNT = (LAS bf16_t*)lds;
        const f32x4 lg = *(const f32x4*)(a->in[I_LNG] + l * DG + 4 * lane), lb = *(const f32x4*)(a->in[I_LNB] + l * DG + 4 * lane);
        const int nrow = off + 64;
        const bf16_t* Zv = Z + ((size_t)b * SEQ + tc + wave) * DIN + 256 + 4 * lane;
        u32x2 vr[16];
#pragma unroll
        for (int i = 0; i < 16; ++i) vr[i] = *(const u32x2*)(Zv + (size_t)(wave + 8 * i < nrow ? i : 0) * 8 * DIN);
        u32x2 ur[8];
#pragma unroll
        for (int i = 0; i < 8; ++i) ur[i] = *(const u32x2*)(Z + (R0 + 8 * wave + i) * DIN + 4 * lane);
        const int mt = wave & 3, hp = wave >> 2, tl0 = off + 16 * mt, nks = (tl0 + 16 + 31) >> 5;
        const bf16_t* GW = (const bf16_t*)(ws + WS_W + (size_t)l * W_LSTRIDE + W_GWS);
        bf16x8 af[2][4];
#pragma unroll
        for (int hh = 0; hh < 2; ++hh)
#pragma unroll
            for (int ks = 0; ks < 4; ++ks) af[hh][ks] = *(const bf16x8*)(GW + ((size_t)(2 * hp + hh) * 128 + tl0 + fr) * 128 + 32 * (ks < nks ? ks : 0) + 8 * fq);
        const int wsw = lane & 7;
#pragma unroll
        for (int i = 0; i < 16; ++i) if (wave + 8 * i < nrow) {
            const int s = wave + 8 * i;
            const f32x4 v = (f32x4){bflo(vr[i].x), bfhi(vr[i].x), bflo(vr[i].y), bfhi(vr[i].y)};
            const float mean = wave_sum(hsum4(v)) * (1.0f / DG); const f32x4 d = v - mean;
            const float rstd = rsqrtf(wave_sum(hsq4(d)) * (1.0f / DG) + EPS);
            const f32x4 vn = d * rstd * lg + lb;
            LAS bf16_t* wp = VNT + (4 * lane) * VNT_P + (((s >> 3) ^ wsw) << 3) + (s & 7);
#pragma unroll
            for (int k = 0; k < 4; ++k) wp[k * VNT_P] = (bf16_t)(pk2(vn[k], 0.f) & 0xffffu);
        }
        __syncthreads();
        LAS float* TT = (LAS float*)(lds + TT_OFF);
#pragma unroll
        for (int hh = 0; hh < 2; ++hh) {
            const int h = 2 * hp + hh;
            f32x4 acc[4];
#pragma unroll
            for (int dt = 0; dt < 4; ++dt) acc[dt] = (f32x4){0.f, 0.f, 0.f, 0.f};
#pragma unroll
            for (int ks = 0; ks < 4; ++ks) if (ks < nks) {
#pragma unroll
                for (int dt = 0; dt < 4; ++dt) {
                    const int d = h * 64 + dt * 16 + fr;
                    const bf16x8 bfr = *(const LAS bf16x8*)(VNT + d * VNT_P + (((4 * ks + fq) ^ ((d >> 2) & 7)) << 3));
                    acc[dt] = __builtin_amdgcn_mfma_f32_16x16x32_bf16(af[hh][ks], bfr, acc[dt], 0, 0, 0);
                }
            }
#pragma unroll
            for (int dt = 0; dt < 4; ++dt)
#pragma unroll
                for (int j = 0; j < 4; ++j) TT[(16 * mt + 4 * fq + j) * TT_P + h * 64 + dt * 16 + fr] = acc[dt][j];
        }
        __syncthreads();
        {
            const f32x4 g = *(const f32x4*)(mog + 4 * lane); const float* bsp = a->in[I_GBS] + (l * 4 + (lane >> 4)) * 128 + off + 8 * wave;
#pragma unroll
            for (int i = 0; i < 8; ++i) {
                const int tt = 8 * wave + i;
                const f32x4 gate = *(const LAS f32x4*)(TT + tt * TT_P + 4 * lane) + bsp[i];
                const f32x4 v = (f32x4){bflo(ur[i].x), bfhi(ur[i].x), bflo(ur[i].y), bfhi(ur[i].y)} * gate;
                const float r = rsqrtf(wave_sum(hsq4(v)) * (1.0f / DG) + EPS);
                st_bf4(Y + (R0 + tt) * DM + 4 * lane, v * r * g);
            }
        }
        __syncthreads();
    } MIX_T1(1); }
    { MIX_T0(); if (MIXP & 2) {
        int lq_ = lane; asm volatile("" : "+v"(lq_)); const int lane = lq_; const int fr = lane & 15, fq = lane >> 4; (void)fr; (void)fq;
        LAS float* G = (LAS float*)lds; LAS float* CW = (LAS float*)(lds + CW_OFF);
#pragma unroll
        for (int i = 0; i < 12; ++i) { const int rr = wave + 8 * i; if (rr < 94) {
            const int t = t0 - 30 + rr; f32x4 gl = {0.f, 0.f, 0.f, 0.f};
            if (t >= 0) { const f32x4 ga = (f32x4){bflo(gar[i].x), bfhi(gar[i].x), bflo(gar[i].y), bfhi(gar[i].y)}, gg = (f32x4){bflo(ggr[i].x), bfhi(ggr[i].x), bflo(ggr[i].y), bfhi(ggr[i].y)};
#pragma unroll
                for (int k = 0; k < 4; ++k) gl[k] = ga[k] * sigmoidf_(gg[k]); }
            *(LAS f32x4*)(G + rr * 256 + 4 * lane) = gl;
            if (ju == 31 && rr >= 64) *(f32x4*)(a->out + O_GLUP + ((size_t)(l * NB + b) * 30 + (rr - 64)) * DG + 4 * lane) = gl;
        } }
        for (int i = wave * 64 + lane; i < 31 * 64; i += NTHR) ((LAS f32x4*)CW)[i] = ((const f32x4*)(a->in[I_CDW] + (size_t)l * 31 * DG))[i];
        __syncthreads();
        f32x4 acc[8];
#pragma unroll
        for (int i = 0; i < 8; ++i) acc[i] = (f32x4){0.f, 0.f, 0.f, 0.f};
        f32x4 wj[8];
#pragma unroll
        for (int i = 0; i < 38; ++i) {
            const f32x4 g = *(const LAS f32x4*)(G + (8 * wave + i) * 256 + 4 * lane);
            if (i <= 30) wj[i & 7] = *(const LAS f32x4*)(CW + i * 256 + 4 * lane);
#pragma unroll
            for (int tt = 0; tt < 8; ++tt) { const int j = i - tt; if (j >= 0 && j <= 30) acc[tt] += wj[j & 7] * g; }
            if (i & 1) asm volatile("" ::: "memory");
        }
        const f32x4 cb = *(const f32x4*)(a->in[I_CDWB] + l * DG + 4 * lane), lg = *(const f32x4*)(a->in[I_CLNG] + l * DG + 4 * lane), lb = *(const f32x4*)(a->in[I_CLNB] + l * DG + 4 * lane);
        const f32x4 mg = *(const f32x4*)(mog + 1 * DG + 4 * lane);
#pragma unroll
        for (int tt = 0; tt < 8; ++tt) {
            const f32x4 x = acc[tt] + cb;
            const float mean = wave_sum(hsum4(x)) * (1.0f / DG); const f32x4 d = x - mean;
            const float rstd = rsqrtf(wave_sum(hsq4(d)) * (1.0f / DG) + EPS);
            f32x4 y = d * rstd * lg + lb;
#pragma unroll
            for (int i = 0; i < 4; ++i) y[i] = y[i] * sigmoidf_(y[i]);
            const float r = rsqrtf(wave_sum(hsq4(y)) * (1.0f / DG) + EPS);
            st_bf4(Y + (R0 + 8 * wave + tt) * DM + 1 * DG + 4 * lane, y * r * mg);
        }
        __syncthreads();
    } MIX_T1(2); }
    asm volatile("" ::: "memory");
    { MIX_T0(); if (MIXP & 4) {
        int lq_ = lane; asm volatile("" : "+v"(lq_)); const int lane = lq_; const int fr = lane & 15, fq = lane >> 4; (void)fr; (void)fq;
        const float* sw = a->in[I_SCDW] + (size_t)l * 3 * DG;
        const f32x4 w0 = *(const f32x4*)(sw + 4 * lane), w1 = *(const f32x4*)(sw + DG + 4 * lane), w2 = *(const f32x4*)(sw + 2 * DG + 4 * lane);
        const f32x4 mg = *(const f32x4*)(mog + 2 * DG + 4 * lane);
        f32x4 s[10];
#pragma unroll
        for (int i = 0; i < 10; ++i) {
            const int t = t0 + 8 * wave - 2 + i; s[i] = (f32x4){0.f, 0.f, 0.f, 0.f};
            if (t >= 0) { const bf16_t* zr = Z + ((size_t)b * SEQ + t) * DIN; s[i] = ld_bf4(zr + 1280 + 4 * lane) * ld_bf4(zr + 1536 + 4 * lane); }
        }
#pragma unroll
        for (int tt = 0; tt < 8; ++tt) {
            const int tl = 8 * wave + tt;
            const f32x4 sb = ld_bf4(Z + (R0 + tl) * DIN + 1024 + 4 * lane);
            const f32x4 y = sb * (w0 * s[tt] + w1 * s[tt + 1] + w2 * s[tt + 2]);
            const float r = rsqrtf(wave_sum(hsq4(y)) * (1.0f / DG) + EPS);
            st_bf4(Y + (R0 + tl) * DM + 2 * DG + 4 * lane, y * r * mg);
            if (ju == 31 && tl >= 62) *(f32x4*)(a->out + O_SHP + ((size_t)(l * NB + b) * 2 + (tl - 62)) * DG + 4 * lane) = s[tt + 2];
        }
    } MIX_T1(4); }
    asm volatile("s_waitcnt vmcnt(0)" ::: "memory");
    { MIX_T0(); if (MIXP & 8) {
        int lq_ = lane; asm volatile("" : "+v"(lq_)); const int lane = lq_; const int fr = lane & 15, fq = lane >> 4; (void)fr; (void)fq;
        LAS bf16_t* PL = (LAS bf16_t*)lds; LAS float* TT = (LAS float*)(lds + TT_OFF);
        const int g = lane >> 4, w = 2 << g;
        f32x4 px[23];
#pragma unroll
        for (int i = 0; i < 23; ++i) {
            const int t = t0 + 8 * wave - 15 + i; px[i] = (f32x4){0.f, 0.f, 0.f, 0.f};
            if (t >= 0) px[i] = ld_bf4(Z + ((size_t)b * SEQ + t) * DIN + 1792 + 4 * lane);
        }
#pragma unroll
        for (int tt = 0; tt < 8; ++tt) {
            const int tl = 8 * wave + tt, t = t0 + tl;
            f32x4 sum = {0.f, 0.f, 0.f, 0.f};
#pragma unroll
            for (int i = 0; i < 16; ++i) if (i < w) sum += px[15 + tt - i];
            const float icnt = __builtin_amdgcn_rcpf((float)min(w, t + 1));
            const f32x4 pooled = sum * icnt - px[15 + tt];
            u32x2 pw; pw.x = pk2(pooled.x, pooled.y); pw.y = pk2(pooled.z, pooled.w);
            *(LAS u32x2*)(PL + tl * PL_P + 4 * lane) = pw;
            if (ju == 31 && tl >= 49) *(f32x4*)(a->out + O_PLP + ((size_t)(l * NB + b) * 15 + (tl - 49)) * DG + 4 * lane) = px[15 + tt];
        }
        __syncthreads();
        const int mt = wave & 3, gp = wave >> 2;
        const bf16_t* PWT = (const bf16_t*)(ws + WS_W + (size_t)l * W_LSTRIDE + W_PWT);
#pragma unroll
        for (int gg = 0; gg < 2; ++gg) {
            const int gi = 2 * gp + gg;
#pragma unroll
            for (int nt = 0; nt < 4; ++nt) {
                f32x4 acc = {0.f, 0.f, 0.f, 0.f};
#pragma unroll
                for (int ks = 0; ks < 2; ++ks) {
                    const bf16x8 af = *(const LAS bf16x8*)(PL + (16 * mt + fr) * PL_P + gi * 64 + 32 * ks + 8 * fq);
                    const bf16x8 bfr = *(const bf16x8*)(PWT + ((size_t)gi * 64 + 16 * nt + fr) * 64 + 32 * ks + 8 * fq);
                    acc = __builtin_amdgcn_mfma_f32_16x16x32_bf16(af, bfr, acc, 0, 0, 0);
                }
                const int d = gi * 64 + 16 * nt + fr; const float sc = a->in[I_PSC][l * DG + d];
#pragma unroll
                for (int j = 0; j < 4; ++j) TT[(16 * mt + 4 * fq + j) * TT_P + d] = acc[j] * sc;
            }
        }
        __syncthreads();
        tt_rows_out(lds, Y + R0 * DM + 3 * DG, mog + 3 * DG, wave, lane);
        __syncthreads();
    } MIX_T1(8); }
}

DI void mixer_sample(AP a, int l, int bs, int part, LAS unsigned char* lds, int wave, int lane) {
    unsigned char* ws = a->ws;
    const float* z = (const float*)(ws + WS_ZS) + ((size_t)l * NS + bs) * DIN;
    const float zrs = rsqrtf(((const float*)(ws + WS_SSQ))[(l * 3 + 0) * NS + bs] * (1.0f / DM) + EPS);
    float* ys = (float*)(ws + WS_YS) + (size_t)bs * DM;
    const float* mog = a->in[I_MOG] + l * DM;
    const int c4 = 4 * lane;
    if (part == 0) {
        const f32x4 u = *(const f32x4*)(z + c4) * zrs, v = *(const f32x4*)(z + 256 + c4) * zrs;
        const f32x4 lg = *(const f32x4*)(a->in[I_LNG] + l * DG + c4), lb = *(const f32x4*)(a->in[I_LNB] + l * DG + c4);
        const float mean = wave_sum(hsum4(v)) * (1.0f / DG); const f32x4 d = v - mean;
        const float rstd = rsqrtf(wave_sum(hsq4(d)) * (1.0f / DG) + EPS);
        const f32x4 vn = d * rstd * lg + lb;
        *(f32x4*)(a->out + O_GV + ((size_t)l * NS + bs) * DG + c4) = vn;
        const int h = lane >> 4;
        const float w00 = a->in[I_GWS][((size_t)(l * 4 + h) * 128) * 128], b0 = a->in[I_GBS][(l * 4 + h) * 128];
        const f32x4 y = u * (vn * w00 + b0);
        const float r = rsqrtf(wave_sum(hsq4(y)) * (1.0f / DG) + EPS);
        *(f32x4*)(ys + c4) = y * r * *(const f32x4*)(mog + c4);
    }
    else if (part == 1) {
        const f32x4 ga = *(const f32x4*)(z + 512 + c4) * zrs, gg = *(const f32x4*)(z + 768 + c4) * zrs;
        f32x4 glu;
#pragma unroll
        for (int i = 0; i < 4; ++i) glu[i] = ga[i] * sigmoidf_(gg[i]);
        const float* st = a->in[I_SGLU] + ((size_t)(l * NS + bs) * 30) * DG + c4;
        float* so = a->out + O_GLUS + ((size_t)(l * NS + bs) * 30) * DG + c4;
        const float* cw = a->in[I_CDW] + (size_t)l * 31 * DG + c4;
        f32x4 acc = *(const f32x4*)(cw + 30 * DG) * glu;
#pragma unroll 10
        for (int j = 0; j < 30; ++j) { const f32x4 sv = *(const f32x4*)(st + j * DG); acc += *(const f32x4*)(cw + j * DG) * sv; if (j >= 1) *(f32x4*)(so + (j - 1) * DG) = sv; }
        *(f32x4*)(so + 29 * DG) = glu;
        const f32x4 x = acc + *(const f32x4*)(a->in[I_CDWB] + l * DG + c4);
        const float mean = wave_sum(hsum4(x)) * (1.0f / DG); const f32x4 d = x - mean;
        const float rstd = rsqrtf(wave_sum(hsq4(d)) * (1.0f / DG) + EPS);
        f32x4 y = d * rstd * *(const f32x4*)(a->in[I_CLNG] + l * DG + c4) + *(const f32x4*)(a->in[I_CLNB] + l * DG + c4);
#pragma unroll
        for (int i = 0; i < 4; ++i) y[i] = y[i] * sigmoidf_(y[i]);
        const float r = rsqrtf(wave_sum(hsq4(y)) * (1.0f / DG) + EPS);
        *(f32x4*)(ys + DG + c4) = y * r * *(const f32x4*)(mog + DG + c4);
    }
    else if (part == 2) {
        const f32x4 sb = *(const f32x4*)(z + 1024 + c4) * zrs, s = (*(const f32x4*)(z + 1280 + c4) * zrs) * (*(const f32x4*)(z + 1536 + c4) * zrs);
        const float* st = a->in[I_SSH] + ((size_t)(l * NS + bs) * 2) * DG + c4;
        float* so = a->out + O_SHS + ((size_t)(l * NS + bs) * 2) * DG + c4;
        const float* sw = a->in[I_SCDW] + (size_t)l * 3 * DG + c4;
        const f32x4 s0 = *(const f32x4*)st, s1 = *(const f32x4*)(st + DG);
        const f32x4 y = sb * (*(const f32x4*)sw * s0 + *(const f32x4*)(sw + DG) * s1 + *(const f32x4*)(sw + 2 * DG) * s);
        *(f32x4*)so = s1; *(f32x4*)(so + DG) = s;
        const float r = rsqrtf(wave_sum(hsq4(y)) * (1.0f / DG) + EPS);
        *(f32x4*)(ys + 2 * DG + c4) = y * r * *(const f32x4*)(mog + 2 * DG + c4);
    }
    else {
        const f32x4 px = *(const f32x4*)(z + 1792 + c4) * zrs;
        const float* st = a->in[I_SPL] + ((size_t)(l * NS + bs) * 15) * DG + c4;
        float* so = a->out + O_PLS + ((size_t)(l * NS + bs) * 15) * DG + c4;
        const int g = lane >> 4, w = 2 << g;
        f32x4 sum = px;
#pragma unroll
        for (int j = 0; j < 15; ++j) { const f32x4 sv = *(const f32x4*)(st + j * DG); if (15 - j < w) sum += sv; if (j >= 1) *(f32x4*)(so + (j - 1) * DG) = sv; }
        *(f32x4*)(so + 14 * DG) = px;
        const f32x4 pooled = sum / (float)w - px;
        LAS float* PLs = (LAS float*)(lds + wave * 1024);
        *(LAS f32x4*)(PLs + c4) = pooled;
        asm volatile("s_waitcnt lgkmcnt(0)" ::: "memory");
        const float* pw = a->in[I_PW] + (size_t)l * 16384 + (size_t)g * 4096 + 4 * (lane & 15);
        f32x4 acc = {0.f, 0.f, 0.f, 0.f};
#pragma unroll 16
        for (int c = 0; c < 64; ++c) acc += *(const f32x4*)(pw + c * 64) * PLs[g * 64 + c];
        const f32x4 y = acc * *(const f32x4*)(a->in[I_PSC] + l * DG + c4);
        const float r = rsqrtf(wave_sum(hsq4(y)) * (1.0f / DG) + EPS);
        *(f32x4*)(ys + 3 * DG + c4) = y * r * *(const f32x4*)(mog + 3 * DG + c4);
        asm volatile("s_waitcnt lgkmcnt(0)" ::: "memory");
    }
}

constexpr int KVP = 264;
DI void attn_unit(AP a, int l, int uidx, LAS unsigned char* lds, int wave, int lane) {
    unsigned char* ws = a->ws;
    const int b = uidx >> 5, h = (uidx >> 3) & 3, qt = uidx & 7;
    const int r32 = lane & 31, hi = lane >> 5, tid = wave * 64 + lane;
    LAS bf16_t* KV = (LAS bf16_t*)lds;
    const size_t q0 = (size_t)b * SEQ + qt * 256 + 32 * wave;
    const bf16_t* Qp = (const bf16_t*)(ws + WS_Q) + (q0 + r32) * DM + h * 256 + 8 * hi;
    const bf16_t* Kg = (const bf16_t*)(ws + WS_KP) + ((size_t)l * MM + b * 256) * DM + h * 256;
    const bf16_t* Vg = (const bf16_t*)(ws + WS_VT) + ((size_t)((l * NB + b) * 4 + h) * 256) * 256;
    const bf16_t* kgl = Kg + (size_t)(tid >> 5) * DM + (tid & 31) * 8; const bf16_t* vgl = Vg + (size_t)(tid >> 5) * 256 + (tid & 31) * 8;
    LAS bf16_t* kvl = KV + (tid >> 5) * KVP + (tid & 31) * 8;
    bf16x8 qf[16];
#pragma unroll
    for (int ks = 0; ks < 16; ++ks) qf[ks] = __builtin_nontemporal_load((const bf16x8*)(Qp + 16 * ks));
    u32x4 st[16];
#pragma unroll
    for (int i = 0; i < 16; ++i) st[i] = *(const u32x4*)(kgl + i * 16 * DM);
#pragma unroll
    for (int i = 0; i < 16; ++i) *(LAS u32x4*)(kvl + i * 16 * KVP) = st[i];
    __syncthreads();
    f32x16 S[8];
    __builtin_amdgcn_s_setprio(1);
#pragma unroll
    for (int kt = 0; kt < 8; ++kt) {
#pragma unroll
        for (int i = 0; i < 16; ++i) S[kt][i] = 0.f;
#pragma unroll
        for (int ks = 0; ks < 16; ++ks) {
            const bf16x8 kf = *(const LAS bf16x8*)(KV + (kt * 32 + r32) * KVP + 16 * ks + 8 * hi);
            S[kt] = __builtin_amdgcn_mfma_f32_32x32x16_bf16(kf, qf[ks], S[kt], 0, 0, 0);
        }
    }
    __builtin_amdgcn_s_setprio(0);
    asm volatile("" ::: "memory");
#pragma unroll
    for (int i = 0; i < 8; ++i) st[i] = *(const u32x4*)(vgl + i * 16 * 256);
    float mx = -3.0e38f;
#pragma unroll
    for (int kt = 0; kt < 8; ++kt)
#pragma unroll
        for (int i = 0; i < 16; ++i) mx = fmaxf(mx, S[kt][i]);
    mx = fmaxf(mx, __shfl_xor(mx, 32));
    float sum = 0.f; const float mxl = mx * 1.4426950408889634f;
    bf16x8 pf[16];
#pragma unroll
    for (int kt = 0; kt < 8; ++kt) {
#pragma unroll
        for (int i = 0; i < 16; ++i) { const float p = __builtin_amdgcn_exp2f(S[kt][i] * 1.4426950408889634f - mxl); S[kt][i] = p; sum += p; }
#pragma unroll
        for (int c = 0; c < 2; ++c) {
            u32x4 p; p.x = pk2(S[kt][8 * c + 0], S[kt][8 * c + 1]); p.y = pk2(S[kt][8 * c + 2], S[kt][8 * c + 3]); p.z = pk2(S[kt][8 * c + 4], S[kt][8 * c + 5]); p.w = pk2(S[kt][8 * c + 6], S[kt][8 * c + 7]);
            pf[2 * kt + c] = __builtin_bit_cast(bf16x8, p);
        }
    }
    sum += __shfl_xor(sum, 32);
    const float inv = 1.0f / sum;
    __syncthreads();
#pragma unroll
    for (int i = 0; i < 8; ++i) *(LAS u32x4*)(kvl + i * 16 * KVP) = st[i];
    asm volatile("" ::: "memory");
#pragma unroll
    for (int i = 0; i < 8; ++i) st[i] = *(const u32x4*)(vgl + (i + 8) * 16 * 256);
    __syncthreads();
    bf16_t* Op = (bf16_t*)(ws + WS_O) + (q0 + r32) * DM + h * 256 + 4 * hi;
#pragma unroll
    for (int dt = 0; dt < 8; ++dt) {
        if (dt == 4) {
#pragma unroll
            for (int i = 0; i < 8; ++i) *(LAS u32x4*)(kvl + (i + 8) * 16 * KVP) = st[i];
            __syncthreads();
        }
        f32x16 o;
#pragma unroll
        for (int i = 0; i < 16; ++i) o[i] = 0.f;
        __builtin_amdgcn_s_setprio(1);
#pragma unroll
        for (int kc = 0; kc < 16; ++kc) {
            const LAS bf16_t* vp = KV + (dt * 32 + r32) * KVP + 16 * kc + 4 * hi;
            const u32x2 v0 = *(const LAS u32x2*)vp, v1 = *(const LAS u32x2*)(vp + 8);
            u32x4 vv; vv.x = v0.x; vv.y = v0.y; vv.z = v1.x; vv.w = v1.y;
            o = __builtin_amdgcn_mfma_f32_32x32x16_bf16(__builtin_bit_cast(bf16x8, vv), pf[kc], o, 0, 0, 0);
        }
        __builtin_amdgcn_s_setprio(0);
#pragma unroll
        for (int rg = 0; rg < 4; ++rg) {
            u32x2 w; w.x = pk2(o[4 * rg] * inv, o[4 * rg + 1] * inv); w.y = pk2(o[4 * rg + 2] * inv, o[4 * rg + 3] * inv);
            ST8(Op + 32 * dt + 8 * rg, w);
        }
    }
    __syncthreads();
}

DI void attn_sample_unit(AP a, int l, int uidx, LAS unsigned char* lds, int wave, int lane) {
    unsigned char* ws = a->ws;
    const int bs = uidx >> 1, hp = uidx & 1, hh = lane >> 5;
    LAS float* ML = (LAS float*)lds;
    LAS float* RED = (LAS float*)(lds + 4096);
    const float* qp = (const float*)(ws + WS_QS) + ((size_t)l * NS + bs) * DM + hp * 512 + 8 * lane;
    const float qrs = 0.0625f * rsqrtf(((const float*)(ws + WS_SSQ))[(l * 3 + 1) * NS + bs] * (1.0f / DM) + EPS);
    const f32x4 q0 = *(const f32x4*)qp * qrs, q1 = *(const f32x4*)(qp + 4) * qrs;
    const float* Kb = a->in[I_CK] + ((size_t)(l * NS + bs) * MEM + 32 * wave) * DM + hp * 512 + 8 * lane;
    const float* Vb = a->in[I_CV] + ((size_t)(l * NS + bs) * MEM + 32 * wave) * DM + hp * 512 + 8 * lane;
    float mrun = -3.0e38f, lrun = 0.f; f32x4 o0 = {0.f, 0.f, 0.f, 0.f}, o1 = {0.f, 0.f, 0.f, 0.f};
    f32x4 k0[4], k1[4], v0[4], v1[4];
#pragma unroll
    for (int r = 0; r < 4; ++r) { const size_t ro = (size_t)r * DM; k0[r] = __builtin_nontemporal_load((const f32x4*)(Kb + ro)); k1[r] = __builtin_nontemporal_load((const f32x4*)(Kb + ro + 4)); v0[r] = __builtin_nontemporal_load((const f32x4*)(Vb + ro)); v1[r] = __builtin_nontemporal_load((const f32x4*)(Vb + ro + 4)); }
#pragma unroll 1
    for (int bt = 0; bt < 8; ++bt) {
        const float* Kn = Kb + (size_t)(bt < 7 ? 4 * (bt + 1) : 0) * DM; const float* Vn = Vb + (size_t)(bt < 7 ? 4 * (bt + 1) : 0) * DM;
        f32x4 nk0[4], nk1[4], nv0[4], nv1[4]; float sc[4];
#pragma unroll
        for (int r = 0; r < 4; ++r) { const size_t ro = (size_t)r * DM; nk0[r] = __builtin_nontemporal_load((const f32x4*)(Kn + ro)); nk1[r] = __builtin_nontemporal_load((const f32x4*)(Kn + ro + 4)); nv0[r] = __builtin_nontemporal_load((const f32x4*)(Vn + ro)); nv1[r] = __builtin_nontemporal_load((const f32x4*)(Vn + ro + 4)); }
        float bm = -3.0e38f;
#pragma unroll
        for (int r = 0; r < 4; ++r) {
            float d = hsum4(k0[r] * q0) + hsum4(k1[r] * q1);
            d = half_sum32(d, lane);
            sc[r] = d; bm = fmaxf(bm, d);
        }
        const float mnew = fmaxf(mrun, bm), resc = __expf(mrun - mnew);
        lrun *= resc; o0 = o0 * resc; o1 = o1 * resc; mrun = mnew;
#pragma unroll
        for (int r = 0; r < 4; ++r) { const float p = __expf(sc[r] - mnew); lrun += p; o0 += v0[r] * p; o1 += v1[r] * p; }
#pragma unroll
        for (int r = 0; r < 4; ++r) { k0[r] = nk0[r]; k1[r] = nk1[r]; v0[r] = nv0[r]; v1[r] = nv1[r]; }
    }
    if ((lane & 31) == 0) { ML[(wave * 2 + hh) * 2] = mrun; ML[(wave * 2 + hh) * 2 + 1] = lrun; }
    *(LAS f32x4*)(RED + wave * 512 + 8 * lane) = o0; *(LAS f32x4*)(RED + wave * 512 + 8 * lane + 4) = o1;
    __syncthreads();
    {
        const int t = wave * 64 + lane, h2 = t >> 8; float mx = -3.0e38f;
#pragma unroll
        for (int w = 0; w < 8; ++w) mx = fmaxf(mx, ML[(w * 2 + h2) * 2]);
        float num = 0.f, den = 0.f;
#pragma unroll
        for (int w = 0; w < 8; ++w) { const float e = __expf(ML[(w * 2 + h2) * 2] - mx); num += e * RED[w * 512 + t]; den += e * ML[(w * 2 + h2) * 2 + 1]; }
        ((float*)(ws + WS_OS))[(size_t)bs * DM + hp * 512 + t] = num / den;
    }
    __syncthreads();
}

#define XB_TMO      128
#define XB_XCNT(j)  (256  + 64 * (j))
#define XB_XSUB(j)  (1280 + 64 * (j))
#define XB_XGEN(j)  (2304 + 64 * (j))
#define XB_TOP      3328
#define XB_TOPGEN   3392
#define XCD_BAR_WORDS 3456
#define XB_SPIN_CAP (1u << 18)
DI unsigned xb_ld(unsigned* p)              { return __hip_atomic_load(p, __ATOMIC_RELAXED, __HIP_MEMORY_SCOPE_AGENT); }
DI unsigned xb_add(unsigned* p, unsigned v) { return __hip_atomic_fetch_add(p, v, __ATOMIC_RELAXED, __HIP_MEMORY_SCOPE_AGENT); }
DI unsigned xb_xcc_id() { return (unsigned)__builtin_amdgcn_s_getreg((3 << 11) | 20) & 0xFu; }
#define XB_SPIN(cond, bar) do { unsigned _sp = 0; while (cond) { __builtin_amdgcn_s_sleep(1); \
    if ((++_sp & 255u) == 0u) { if (xb_ld(&(bar)[XB_TMO])) break; if (_sp > XB_SPIN_CAP) { atomicAdd(&(bar)[XB_TMO], 1u); break; } } } } while (0)
struct XcdBarrier { unsigned* bar; unsigned x; volatile LAS unsigned* st; };
DI XcdBarrier xcd_barrier_post(unsigned* bar, volatile LAS unsigned* st) {
    XcdBarrier b; b.bar = bar; b.x = xb_xcc_id(); b.st = st;
    if (threadIdx.x == 0) (void)xb_add(&bar[XB_XCNT(b.x)], 1u);
    return b;
}
DI void xcd_barrier_complete(unsigned* bar, unsigned x, unsigned& nloc, unsigned& nx) {
    const unsigned G = gridDim.x * gridDim.y * gridDim.z;
    unsigned sum, cnt, mine, sp = 0u;
    for (;;) {
        sum = 0u; cnt = 0u; mine = 0u;
#pragma unroll
        for (unsigned j = 0; j < 16; ++j) { const unsigned c = xb_ld(&bar[XB_XCNT(j)]); sum += c; cnt += (c > 0u) ? 1u : 0u; mine = (j == x) ? c : mine; }
        if (sum == G) break;
        __builtin_amdgcn_s_sleep(1);
        if ((++sp & 255u) == 0u) { if (xb_ld(&bar[XB_TMO])) break; if (sp > XB_SPIN_CAP) { atomicAdd(&bar[XB_TMO], 1u); break; } }
    }
    nloc = mine > 0u ? mine : 1u; nx = cnt > 0u ? cnt : 1u;
}
DI void xcd_barrier(const XcdBarrier& b) {
    asm volatile("s_waitcnt vmcnt(0)" ::: "memory");
    __syncthreads();
    if (threadIdx.x == 0) {
        unsigned* bar = b.bar;
        __builtin_amdgcn_s_waitcnt(0);
        unsigned nloc = b.st[0], nx = b.st[1];
        if (nloc == 0u) { xcd_barrier_complete(bar, b.x, nloc, nx); b.st[0] = nloc; b.st[1] = nx; }
        const unsigned old = xb_add(&bar[XB_XSUB(b.x)], 1u);
        const unsigned gen = old / nloc;
        if (old + 1u == (gen + 1u) * nloc) {
            __builtin_amdgcn_fence(__ATOMIC_RELEASE, "agent");
            asm volatile("s_waitcnt vmcnt(0)" ::: "memory");
            const unsigned og = xb_add(&bar[XB_TOP], 1u);
            const unsigned tg = og / nx;
            if (og + 1u == (tg + 1u) * nx) xb_add(&bar[XB_TOPGEN], 1u);
            else XB_SPIN(xb_ld(&bar[XB_TOPGEN]) == tg, bar);
            __builtin_amdgcn_fence(__ATOMIC_ACQUIRE, "agent");
            xb_add(&bar[XB_XGEN(b.x)], 1u);
            asm volatile("s_waitcnt vmcnt(0)" ::: "memory");
        } else {
            XB_SPIN(xb_ld(&bar[XB_XGEN(b.x)]) == gen, bar);
            __builtin_amdgcn_fence(__ATOMIC_ACQUIRE, "agent");
            asm volatile("s_waitcnt vmcnt(0)" ::: "memory");
        }
    }
    __syncthreads();
}

template <int NLD> DI unsigned l2_touch(const bf16_t* panel, int share, int tid) {
    const char* p = (const char*)panel + ((size_t)share * NLD * NTHR + tid) * 128;
    unsigned v[NLD];
#pragma unroll
    for (int i = 0; i < NLD; ++i) v[i] = *(const unsigned*)(p + (size_t)i * NTHR * 128);
    unsigned acc = 0u;
#pragma unroll
    for (int i = 0; i < NLD; ++i) acc |= v[i];
    return acc;
}
template <int NR> DI void gemm_touch(const pg8::Gemm& g, const pg8::StaticOrder& S, int tid) {
    pg8::Unit u;
    if (!S.next(0, u)) return;
    unsigned acc = l2_touch<2>(g.A + (size_t)u.pm * 256 * g.K, u.pn & 3, tid);
#pragma unroll
    for (int i = 0; i < NR; ++i) { pg8::Unit w = u; S.next(i, w); acc |= l2_touch<1>(g.Bt + (size_t)w.pn * 256 * g.K, w.pm & 7, tid); }
    asm volatile("" :: "v"(acc));
}

#ifndef PMASK
#define PMASK 0xffff
#endif
#ifndef DUPMASK
#define DUPMASK 0
#endif
#ifndef TOUCH
#define TOUCH 0
#endif
#ifndef SPINSET
#define SPINSET 0
#endif
constexpr int N_PHASES = 18;
__global__ void __launch_bounds__(NTHR, 2) fwd_kernel(Args a_) {
    extern __shared__ __attribute__((aligned(16))) unsigned char lds_raw[];
    LAS unsigned char* lds = (LAS unsigned char*)lds_raw;
    cg::grid_group grid = cg::this_grid();
    volatile LAS unsigned* MISC = (volatile LAS unsigned*)(lds + LDS_BYTES - 256);
    if (threadIdx.x < 32) MISC[threadIdx.x] = 0u;
    __syncthreads();
    const XcdBarrier xbar = xcd_barrier_post((unsigned*)(a_.ws + WS_CTL), MISC + 8);
    const int ph_lo = a_.ph_lo, ph_hi = a_.ph_hi;
    for (int ph = ph_lo; ph < ph_hi; ++ph) {
        AP a = (AP)__builtin_amdgcn_kernarg_segment_ptr();
        asm volatile("" : "+s"(a));
        int tid = threadIdx.x; asm volatile("" : "+v"(tid));
        const int lane = tid & 63, wave = __builtin_amdgcn_readfirstlane(tid >> 6);
        int bx = blockIdx.x; asm volatile("" : "+s"(bx));
        const int G = gridDim.x;
        const unsigned long long t_ph0 = SPINSET ? __builtin_amdgcn_s_memrealtime() : 0ull;
        unsigned char* ws = a->ws;
        bf16_t* XB = (bf16_t*)(ws + WS_XB); float* SS = (float*)(ws + WS_SS); float* XF = a->out + O_YP;
        float* XS = (float*)(ws + WS_XS); float* YS = (float*)(ws + WS_YS); float* OS = (float*)(ws + WS_OS);
        if (ph == 0) {
            for (int rep = 0; rep < ((DUPMASK & 64) ? 2 : 1); ++rep) prologue(a, lds, wave, lane);
        } else if (ph == N_PHASES - 1) { if (PMASK & 2) {
            int lnf_ = lane; asm volatile("" : "+v"(lnf_)); const int lane = lnf_;
            const int gw = bx * NWAVES + wave, NGW = G * NWAVES;
            const float* gf = a->in[I_NFIN];
            for (int m0 = gw; m0 < MP; m0 += 4 * NGW) {
                u32x2 xv[4][4]; float rs[4];
#pragma unroll
                for (int k = 0; k < 4; ++k) { const int m = min(m0 + k * NGW, MP - 1); rs[k] = row_rs(SS + (size_t)m * 16);
#pragma unroll
                    for (int j = 0; j < 4; ++j) xv[k][j] = __builtin_nontemporal_load((const u32x2*)(XB + (size_t)m * DM + 4 * lane + 256 * j)); }
#pragma unroll
                for (int k = 0; k < 4; ++k) { const int m = m0 + k * NGW; if (m < MP) { f32x4* yr = (f32x4*)(XF + (size_t)m * DM) + lane;
#pragma unroll
                    for (int j = 0; j < 4; ++j) __builtin_nontemporal_store((f32x4){bflo(xv[k][j].x), bfhi(xv[k][j].x), bflo(xv[k][j].y), bfhi(xv[k][j].y)} * rs[k] * ((const f32x4*)gf)[lane + 64 * j], yr + 64 * j); } }
            }
            for (int m = MP + gw; m < MP + NS; m += NGW) {
                if (m < MP) {
                } else {
                    const int s = m - MP; const f32x4* xr = (const f32x4*)(XS + (size_t)s * DM) + lane; f32x4 v[4]; float sq = 0.f;
#pragma unroll
                    for (int j = 0; j < 4; ++j) { v[j] = xr[64 * j]; sq += hsq4(v[j]); }
                    const float rs = rsqrtf(wave_sum(sq) * (1.0f / DM) + EPS);
                    f32x4* yo = (f32x4*)(a->out + O_YS + (size_t)s * DM) + lane;
#pragma unroll
                    for (int j = 0; j < 4; ++j) yo[64 * j] = v[j] * rs * ((const f32x4*)gf)[lane + 64 * j];
                }
            }
        } } else {
            const int l = (ph - 1) >> 3, sub = (ph - 1) & 7;
            unsigned char* wl = ws + WS_W + (size_t)l * W_LSTRIDE;
            float* SSQ = (float*)(ws + WS_SSQ);
            if (sub == 1) {
                { const int gwr = (G - 1 - bx) * NWAVES + wave; if (gwr < 4 * NS) mixer_sample(a, l, gwr >> 2, gwr & 3, lds, wave, lane); }
                __syncthreads();
                { const int vcu = (G & 7) == 0 ? (bx & 7) * (G >> 3) + (bx >> 3) : bx; for (int u = vcu; u < 256; u += G) mixer_unit(a, l, u, lds, wave, lane); }
            } else if (sub == 4) {
                for (int u = bx; u < 256; u += G) attn_sample_unit(a, l, u, lds, wave, lane);
                { const int vcu = (G & 7) == 0 ? (bx & 7) * (G >> 3) + (bx >> 3) : bx; for (int u = vcu; u < 256; u += G) attn_unit(a, l, u, lds, wave, lane); }
            } else {
                if (sub == 0) sgemm_phase_p<0, true, 2, 2>(XS, DM, (const bf16_t*)(wl + W_IN), DIN, (float*)(ws + WS_ZS) + (size_t)l * NS * DIN, nullptr, SSQ + (l * 3 + 0) * NS, ws, bx, G, wave, lane);
                else if (sub == 2) sgemm_phase_p<0, false, 1, 2>(YS, DM, (const bf16_t*)(wl + W_OUT), DM, XS, nullptr, nullptr, ws, bx, G, wave, lane);
                else if (sub == 3) sgemm_phase_p<0, true, 1, 2>(XS, DM, (const bf16_t*)(wl + W_Q), DM, (float*)(ws + WS_QS) + (size_t)l * NS * DM, nullptr, SSQ + (l * 3 + 1) * NS, ws, bx, G, wave, lane);
                else if (sub == 5) sgemm_phase_p<0, false, 1, 2>(OS, DM, (const bf16_t*)(wl + W_O), DM, XS, nullptr, nullptr, ws, bx, G, wave, lane);
                else if (sub == 6) sgemm_phase_p<0, true, 4, 4>(XS, DM, (const bf16_t*)(wl + W_F1), DFF, (float*)(ws + WS_HS) + (size_t)l * NS * DFF, nullptr, SSQ + (l * 3 + 2) * NS, ws, bx, G, wave, lane);
                else sgemm_phase_p<1, false, 2, 4>((const float*)(ws + WS_HS) + (size_t)l * NS * DFF, DFF, (const bf16_t*)(wl + W_F2), DM, XS, SSQ + (l * 3 + 2) * NS, nullptr, ws, bx, G, wave, lane);
                const int ngemm = (sub == 0 && l == 0) ? 2 : 1;
                for (int gi = 0; gi < ngemm; ++gi) {
                    pg8::Gemm g; EpiAny E{};
                    if (gi == 1) { g = pg8::Gemm{(const bf16_t*)(ws + WS_MEMB), (const bf16_t*)(ws + WS_WKV), MM, 4096, DM};
                        E.mode = 3; E.mss = (const float*)(ws + WS_MEMSS); E.outK = a->out + O_MK; E.outV = a->out + O_MV; E.KP = (bf16_t*)(ws + WS_KP); E.VT = (bf16_t*)(ws + WS_VT); }
                    else if (sub == 0) { g = pg8::Gemm{XB, (const bf16_t*)(wl + W_IN), MP, DIN, DM}; E.mode = 0; E.O = (bf16_t*)(ws + WS_Z); E.ldc = DIN; E.ss = SS; }
                    else if (sub == 3) { g = pg8::Gemm{XB, (const bf16_t*)(wl + W_Q), MP, DM, DM}; E.mode = 1; E.O = (bf16_t*)(ws + WS_Q); E.ldc = DM; E.ss = SS; }
                    else if (sub == 6) { g = pg8::Gemm{XB, (const bf16_t*)(wl + W_F1), MP, DFF, DM}; E.mode = 2; E.O = (bf16_t*)(ws + WS_H); E.ldc = DFF; E.ss = SS; }
                    else { g = pg8::Gemm{(const bf16_t*)(ws + (sub == 2 ? WS_Y : sub == 5 ? WS_O : WS_H)), (const bf16_t*)(wl + (sub == 2 ? W_OUT : sub == 5 ? W_O : W_F2)), MP, DM, sub == 7 ? DFF : DM};
                        E.mode = 4; E.O = XB; E.ssw = SS; }
                    pg8::StaticOrder S; S.init(g.M, g.N, G, bx);
                    pg8::gemm_phase<EpiAny, pg8::StaticOrder, true, true>(lds, g, S, E);
                }
            }
        }
        if (ph + 1 < ph_hi) { if (ph >= N_PHASES) grid.sync();   else { PRO_T0(); xcd_barrier(xbar); PRO_T1(8192); if (DUPMASK & 16) xcd_barrier(xbar); } }
        if (SPINSET) {
            const int cls = ph == 0 ? 0 : ph == N_PHASES - 1 ? 9 : 1 + ((ph - 1) & 7);
            if ((SPINSET >> cls) & 1) { const unsigned long long t1 = __builtin_amdgcn_s_memrealtime(), tgt = t1 + (t1 - t_ph0); while (__builtin_amdgcn_s_memrealtime() < tgt) __builtin_amdgcn_s_sleep(8); }
        }
    }
}

#ifndef N_LAUNCH_MODE
#define N_LAUNCH_MODE 1
#endif
extern "C" void kernel_launch(void* const* d_in, const int* in_sizes, int n_in, void* d_out, int out_size, void* d_ws, size_t ws_size, hipStream_t stream) {
    static int grid = 0;
    if (grid == 0) {
        if (n_in != N_IN || (size_t)out_size != O_END || ws_size < WS_END + 106 * MiB) { fprintf(stderr, "kernel_launch: unexpected sizes n_in %d out %d ws %zu\n", n_in, out_size, ws_size); grid = -1; return; }
        int dev = 0, cus = 0, per_cu = 0;
        if (hipGetDevice(&dev) != hipSuccess || hipDeviceGetAttribute(&cus, hipDeviceAttributeMultiprocessorCount, dev) != hipSuccess) { grid = -1; return; }
        if (hipFuncSetAttribute((const void*)fwd_kernel, hipFuncAttributeMaxDynamicSharedMemorySize, LDS_BYTES) != hipSuccess) { fprintf(stderr, "kernel_launch: hipFuncSetAttribute failed\n"); grid = -1; return; }
        if (hipOccupancyMaxActiveBlocksPerMultiprocessor(&per_cu, (const void*)fwd_kernel, NTHR, LDS_BYTES) != hipSuccess || per_cu < 1) { fprintf(stderr, "kernel_launch: occupancy query says %d\n", per_cu); per_cu = 1; }
        (void)hipGetLastError();
        grid = cus;
    }
    if (grid < 0) return;
    if (hipMemsetAsync((char*)d_ws + WS_CTL, 0, CTL_ZERO_BYTES, stream) != hipSuccess) { fprintf(stderr, "kernel_launch: memset failed\n"); return; }
    Args a{};
    for (int i = 0; i < N_IN; ++i) a.in[i] = (const float*)d_in[i];
    a.out = (float*)d_out; a.ws = (unsigned char*)d_ws;
#if N_LAUNCH_MODE == 1
    a.ph_lo = 0; a.ph_hi = N_PHASES;
    void* args[] = {&a};
    hipError_t e = hipLaunchCooperativeKernel((const void*)fwd_kernel, dim3(grid), dim3(NTHR), args, LDS_BYTES, stream);
    if (e != hipSuccess) fprintf(stderr, "cooperative launch failed: %s (grid %d)\n", hipGetErrorString(e), grid);
#else
    for (int ph = 0; ph < N_PHASES; ++ph) {
        a.ph_lo = ph; a.ph_hi = ph + 1;
        hipLaunchKernelGGL(fwd_kernel, dim3(grid), dim3(NTHR), LDS_BYTES, stream, a);
    }
#endif
}
```
